# Optimizing an MI355X kernel written in HIP

```python
import math
import jax, jax.numpy as jnp
from jax import lax
import numpy as np

D_MODEL = 1024
BATCH = 1
SEQ = 16384
DEPTH = 1

PLE_DIM = 256
SSM_WIDTH = D_MODEL // 2
SSM_GROUP = 16
SSM_GROUPS = SSM_WIDTH // SSM_GROUP
SSM_STATE = 64
CONV_WIDTH = D_MODEL
CONV_K = 3
DT_MIN = 1e-3
DT_MAX = 1e-1
RMS_EPS = 1e-6
IN_SPLITS = (SSM_WIDTH, SSM_WIDTH, CONV_WIDTH, CONV_WIDTH, CONV_WIDTH, CONV_WIDTH, D_MODEL, D_MODEL)
IN_WIDTH = sum(IN_SPLITS)

kernel_name = "hybrid_s5_shortconv_gated_block"


def rms_norm(x, gain):
    xf = x.astype(jnp.float32)
    y = xf * lax.rsqrt(jnp.mean(xf * xf, axis=-1, keepdims=True) + RMS_EPS)
    return (y * gain.astype(jnp.float32)).astype(x.dtype)


def _complex_affine_combine(e1, e2):
    a1r, a1i, b1r, b1i = e1
    a2r, a2i, b2r, b2i = e2
    ar = a1r * a2r - a1i * a2i
    ai = a1r * a2i + a1i * a2r
    br = a2r * b1r - a2i * b1i + b2r
    bi = a2r * b1i + a2i * b1r + b2i
    return (ar, ai, br, bi)


def s5_ssm(u, a_re, a_im, log_step, b_re, b_im, c_re, c_im, d_skip):
    f32 = jnp.float32
    bsz, seqlen, _ = u.shape
    uf = u.astype(f32).reshape(bsz, seqlen, SSM_GROUPS, SSM_GROUP)
    a_re = a_re.astype(f32); a_im = a_im.astype(f32)
    dt = jnp.exp(log_step.astype(f32))[:, None]
    mag = jnp.exp(a_re * dt)
    abar_r = mag * jnp.cos(a_im * dt)
    abar_i = mag * jnp.sin(a_im * dt)
    den = a_re * a_re + a_im * a_im
    nr = abar_r - 1.0
    fr = (nr * a_re + abar_i * a_im) / den
    fi = (abar_i * a_re - nr * a_im) / den
    b_re = b_re.astype(f32); b_im = b_im.astype(f32)
    bbar_r = fr[..., None] * b_re - fi[..., None] * b_im
    bbar_i = fr[..., None] * b_im + fi[..., None] * b_re
    bu_r = jnp.einsum('gph,blgh->blgp', bbar_r, uf)
    bu_i = jnp.einsum('gph,blgh->blgp', bbar_i, uf)
    ar = jnp.broadcast_to(abar_r, bu_r.shape)
    ai = jnp.broadcast_to(abar_i, bu_i.shape)
    _, _, s_r, s_i = lax.associative_scan(_complex_affine_combine, (ar, ai, bu_r, bu_i), axis=1)
    c_re = c_re.astype(f32); c_im = c_im.astype(f32)
    y = (jnp.einsum('ghp,blgp->blgh', c_re, s_r)
         - jnp.einsum('ghp,blgp->blgh', c_im, s_i)
         + d_skip.astype(f32).reshape(SSM_GROUPS, SSM_GROUP) * uf)
    return y.reshape(bsz, seqlen, SSM_WIDTH).astype(u.dtype)


def causal_dwconv(v, w):
    c = v.shape[-1]
    return lax.conv_general_dilated(
        v, w.astype(v.dtype)[:, None, :], window_strides=(1,), padding=[(CONV_K - 1, 0)],
        dimension_numbers=('NWC', 'WIO', 'NWC'), feature_group_count=c)


def setup_inputs(seed: int = 0) -> dict:
    key = jax.random.key(seed)
    ks = jax.random.split(key, 32)
    f32 = jnp.float32
    nrm = lambda k, s, sc: jax.random.normal(k, s, f32) * sc
    gain = lambda k, s: 1.0 + 0.02 * jax.random.normal(k, s, f32)
    G, P, H = SSM_GROUPS, SSM_STATE, SSM_GROUP
    n_idx = jnp.arange(P, dtype=f32)[None, :]
    return {
        "x": nrm(ks[0], (BATCH, SEQ, D_MODEL), 1.0),
        "p": nrm(ks[1], (DEPTH, BATCH, SEQ, PLE_DIM), 1.0),
        "pre_norm": gain(ks[2], (DEPTH, D_MODEL)),
        "w_in": nrm(ks[3], (DEPTH, D_MODEL, IN_WIDTH), D_MODEL ** -0.5),
        "a_re": -0.5 + 0.01 * jax.random.normal(ks[4], (DEPTH, G, P), f32),
        "a_im": math.pi * n_idx + 0.01 * jax.random.normal(ks[5], (DEPTH, G, P), f32),
        "log_step": jax.random.uniform(ks[6], (DEPTH, G), f32, math.log(DT_MIN), math.log(DT_MAX)),
        "b_re": nrm(ks[7], (DEPTH, G, P, H), (2.0 * H) ** -0.5),
        "b_im": nrm(ks[8], (DEPTH, G, P, H), (2.0 * H) ** -0.5),
        "c_re": nrm(ks[9], (DEPTH, G, H, P), (2.0 * P) ** -0.5),
        "c_im": nrm(ks[10], (DEPTH, G, H, P), (2.0 * P) ** -0.5),
        "d_skip": nrm(ks[11], (DEPTH, SSM_WIDTH), 1.0),
        "w_glu": nrm(ks[12], (DEPTH, SSM_WIDTH, SSM_WIDTH), SSM_WIDTH ** -0.5),
        "b_glu": nrm(ks[13], (DEPTH, SSM_WIDTH), 0.01),
        "w_ssm_out": nrm(ks[14], (DEPTH, SSM_WIDTH, D_MODEL), SSM_WIDTH ** -0.5),
        "conv_w": nrm(ks[15], (DEPTH, CONV_K, CONV_WIDTH), CONV_K ** -0.5),
        "w_conv_out": nrm(ks[16], (DEPTH, CONV_WIDTH, D_MODEL), CONV_WIDTH ** -0.5),
        "w_o": nrm(ks[17], (DEPTH, D_MODEL, D_MODEL), D_MODEL ** -0.5),
        "post_norm": gain(ks[18], (DEPTH, D_MODEL)),
        "w_ple": nrm(ks[19], (DEPTH, PLE_DIM, D_MODEL), PLE_DIM ** -0.5),
        "w_ple_gate": nrm(ks[20], (DEPTH, D_MODEL, D_MODEL), D_MODEL ** -0.5),
        "ple_norm": gain(ks[21], (DEPTH, D_MODEL)),
    }


def reference(x, p, pre_norm, w_in, a_re, a_im, log_step, b_re, b_im, c_re, c_im, d_skip,
              w_glu, b_glu, w_ssm_out, conv_w, w_conv_out, w_o, post_norm,
              w_ple, w_ple_gate, ple_norm):
    split_pts = list(np.cumsum(IN_SPLITS)[:-1])
    for i in range(DEPTH):
        h = rms_norm(x, pre_norm[i])
        proj = jnp.einsum('bld,de->ble', h, w_in[i])
        u_ssm, g_ssm, xc, bc, cc, g_conv, r_ssm, r_conv = jnp.split(proj, split_pts, axis=-1)

        y = s5_ssm(u_ssm, a_re[i], a_im[i], log_step[i], b_re[i], b_im[i], c_re[i], c_im[i], d_skip[i])
        y = jax.nn.gelu(y)
        y = y * jax.nn.sigmoid(jnp.einsum('blc,ce->ble', y, w_glu[i]) + b_glu[i])
        y = y * jax.nn.silu(g_ssm)
        y_a = jnp.einsum('blc,cd->bld', y, w_ssm_out[i])

        z = bc * causal_dwconv(cc * xc, conv_w[i])
        z = z * jax.nn.silu(g_conv)
        y_b = jnp.einsum('blc,cd->bld', z, w_conv_out[i])

        merged = jax.nn.sigmoid(r_ssm) * y_a + jax.nn.sigmoid(r_conv) * y_b
        o = jnp.einsum('bld,de->ble', merged, w_o[i])
        x = x + rms_norm(o, post_norm[i])

        e = jnp.einsum('blk,kd->bld', p[i], w_ple[i]) * jax.nn.sigmoid(
            jnp.einsum('bld,de->ble', x, w_ple_gate[i]))
        x = x + rms_norm(e, ple_norm[i])
    return x
```

```cpp
#include <hip/hip_runtime.h>
#include <hip/hip_cooperative_groups.h>
#include <cstdio>
namespace cg = cooperative_groups;

#ifndef ONE_LAUNCH
#define ONE_LAUNCH 1
#endif

#define LAS __attribute__((address_space(3)))
typedef unsigned short bf16_t;
typedef short bf16x8 __attribute__((ext_vector_type(8)));
typedef float f32x4 __attribute__((ext_vector_type(4)));
typedef unsigned u32x4 __attribute__((ext_vector_type(4)));
typedef unsigned u32x2 __attribute__((ext_vector_type(2)));

constexpr int L_ = 16384, D_ = 1024, PLE_ = 256, SW_ = 512, NG_ = 32, CWID_ = 1024, INW_ = 7168;
constexpr int T_ = 32, NCH_ = L_ / T_  , KU_ = T_ * 16  , LDU_ = KU_ + 128  ;
constexpr float EPS_ = 1e-6f;
constexpr size_t MiB = 1024 * 1024;
constexpr size_t WS_WGLU = 0, WS_WSSO = WS_WGLU + 512 * 512 * 2, WS_WCO = WS_WSSO + 1024 * 512 * 2, WS_WO = WS_WCO + 2 * MiB, WS_WPLE = WS_WO + 2 * MiB,
                 WS_WG = WS_WPLE + 1024 * 256 * 2, WS_WIN = 8 * MiB, WS_MC = WS_WIN + 14 * MiB, WS_WST = WS_MC + 20 * MiB, WS_PBF = WS_WST + 8 * MiB,
                 WS_U = WS_PBF + 8 * MiB, WS_SLOC = WS_U + 20 * MiB, WS_SG = WS_SLOC + 8 * MiB, WS_W = WS_SG + 16 * MiB, WS_SR = WS_W + 32 * MiB,
                 WS_SC = WS_SR + 32 * MiB, WS_Z = WS_SC + 32 * MiB, WS_MISC = WS_Z + 32 * MiB, WS_END = WS_MISC + 3 * MiB;
constexpr size_t WS_ABT = WS_MISC + 2 * MiB, WS_BAR = WS_MISC + 2 * MiB + 64 * 1024, WS_CNT = WS_BAR + 16384;
constexpr size_t WS_PE = WS_W, WS_MERGED = WS_MC, WS_O = WS_SR, WS_X1BF = WS_SC, WS_E = WS_Z;
constexpr int NPH = 8;

struct Params {
    const float *x, *p, *pre_norm, *w_in, *a_re, *a_im, *log_step, *b_re, *b_im, *c_re, *c_im, *d_skip, *w_glu, *b_glu, *w_ssm_out, *conv_w, *w_conv_out, *w_o,
        *post_norm, *w_ple, *w_ple_gate, *ple_norm;
    float* out; unsigned char* ws; int ph_lo, ph_hi;
};

typedef __bf16 bf16x2_t __attribute__((ext_vector_type(2)));
typedef float f32x2_t __attribute__((ext_vector_type(2)));
__device__ __forceinline__ unsigned cvt_pk_bf16(float lo, float hi) { f32x2_t v = {lo, hi}; bf16x2_t b = __builtin_convertvector(v, bf16x2_t); return __builtin_bit_cast(unsigned, b); }
__device__ __forceinline__ float bflo(unsigned w) { return __uint_as_float(w << 16); }
__device__ __forceinline__ float bfhi(unsigned w) { return __uint_as_float(w & 0xffff0000u); }
__device__ __forceinline__ f32x4 bf4lo(u32x4 w) { return (f32x4){bflo(w.x), bfhi(w.x), bflo(w.y), bfhi(w.y)}; }
__device__ __forceinline__ f32x4 bf4hi(u32x4 w) { return (f32x4){bflo(w.z), bfhi(w.z), bflo(w.w), bfhi(w.w)}; }
__device__ __forceinline__ u32x4 pack8(f32x4 a, f32x4 b) { u32x4 w; w.x = cvt_pk_bf16(a[0], a[1]); w.y = cvt_pk_bf16(a[2], a[3]); w.z = cvt_pk_bf16(b[0], b[1]); w.w = cvt_pk_bf16(b[2], b[3]); return w; }
__device__ __forceinline__ float sigm(float x) { return __builtin_amdgcn_rcpf(1.f + __expf(-x)); }
__device__ __forceinline__ f32x4 sigm4(f32x4 v) { return (f32x4){sigm(v[0]), sigm(v[1]), sigm(v[2]), sigm(v[3])}; }
__device__ __forceinline__ float gelu_t(float x) { return x * sigm(1.5957691216f * (x + 0.044715f * x * x * x)); }
__device__ __forceinline__ f32x4 gelu4(f32x4 v) { return (f32x4){gelu_t(v[0]), gelu_t(v[1]), gelu_t(v[2]), gelu_t(v[3])}; }

#define XB_TMO      128
#define XB_XCNT(j)  (256  + 64 * (j))
#define XB_XSUB(j)  (1280 + 64 * (j))
#define XB_XGEN(j)  (2304 + 64 * (j))
#define XB_TOP      3328
#define XB_TOPGEN   3392
#define XCD_BAR_WORDS 3456
#define XB_SPIN_CAP (1u << 18)
__device__ __forceinline__ unsigned xb_ld(unsigned* p)              { return __hip_atomic_load(p, __ATOMIC_RELAXED, __HIP_MEMORY_SCOPE_AGENT); }
__device__ __forceinline__ unsigned xb_add(unsigned* p, unsigned v) { return __hip_atomic_fetch_add(p, v, __ATOMIC_RELAXED, __HIP_MEMORY_SCOPE_AGENT); }
__device__ __forceinline__ unsigned xb_xcc_id() { return (unsigned)__builtin_amdgcn_s_getreg((3 << 11) | 20) & 0xFu; }
#define XB_SPIN(cond, bar) do { unsigned _sp = 0; while (cond) { __builtin_amdgcn_s_sleep(1); \
    if ((++_sp & 255u) == 0u) { if (xb_ld(&(bar)[XB_TMO])) break; if (_sp > XB_SPIN_CAP) { atomicAdd(&(bar)[XB_TMO], 1u); break; } } } } while (0)

struct XcdBarrier {
    unsigned* bar; unsigned x;
    volatile LAS unsigned* st;
};

__device__ __forceinline__ XcdBarrier xcd_barrier_post(unsigned* bar, volatile LAS unsigned* st) {
    XcdBarrier b; b.bar = bar; b.x = xb_xcc_id(); b.st = st;
    if (threadIdx.x == 0) (void)xb_add(&bar[XB_XCNT(b.x)], 1u);
    return b;
}
__device__ __forceinline__ void xcd_barrier_complete(unsigned* bar, unsigned x, unsigned& nloc, unsigned& nx) {
    const unsigned G = gridDim.x * gridDim.y * gridDim.z;
    unsigned sum, cnt, mine, sp = 0u;
    for (;;) {
        sum = 0u; cnt = 0u; mine = 0u;
#pragma unroll
        for (unsigned j = 0; j < 16; ++j) { const unsigned c = xb_ld(&bar[XB_XCNT(j)]); sum += c; cnt += (c > 0u) ? 1u : 0u; mine = (j == x) ? c : mine; }
        if (sum == G) break;
        __builtin_amdgcn_s_sleep(1);
        if ((++sp & 255u) == 0u) { if (xb_ld(&bar[XB_TMO])) break; if (sp > XB_SPIN_CAP) { atomicAdd(&bar[XB_TMO], 1u); break; } }
    }
    nloc = mine > 0u ? mine : 1u; nx = cnt > 0u ? cnt : 1u;
}

__device__ __forceinline__ void xcd_barrier(const XcdBarrier& b) {
    asm volatile("s_waitcnt vmcnt(0)" ::: "memory");
    __syncthreads();
    if (threadIdx.x == 0) {
        unsigned* bar = b.bar;
        __builtin_amdgcn_s_waitcnt(0);
        unsigned nloc = b.st[0], nx = b.st[1];
        if (nloc == 0u) { xcd_barrier_complete(bar, b.x, nloc, nx); b.st[0] = nloc; b.st[1] = nx; }
        const unsigned old = xb_add(&bar[XB_XSUB(b.x)], 1u);
        const unsigned gen = old / nloc;
        if (old + 1u == (gen + 1u) * nloc) {
            __builtin_amdgcn_fence(__ATOMIC_RELEASE, "agent");
            asm volatile("s_waitcnt vmcnt(0)" ::: "memory");
            const unsigned og = xb_add(&bar[XB_TOP], 1u);
            const unsigned tg = og / nx;
            if (og + 1u == (tg + 1u) * nx) xb_add(&bar[XB_TOPGEN], 1u);
            else XB_SPIN(xb_ld(&bar[XB_TOPGEN]) == tg, bar);
            __builtin_amdgcn_fence(__ATOMIC_ACQUIRE, "agent");
            xb_add(&bar[XB_XGEN(b.x)], 1u);
            asm volatile("s_waitcnt vmcnt(0)" ::: "memory");
        } else {
            XB_SPIN(xb_ld(&bar[XB_XGEN(b.x)]) == gen, bar);
            __builtin_amdgcn_fence(__ATOMIC_ACQUIRE, "agent");
            asm volatile("s_waitcnt vmcnt(0)" ::: "memory");
        }
    }
    __syncthreads();
}

namespace pg8 {
constexpr int BM = 256, BK = 64, HALF = 128, HTB = HALF * BK * 2, STAGE_BYTES = 8 * HTB, NXCD = 8, WGM = 8;
__device__ __forceinline__ int lds_byte(int r, int c) { const int st = (r >> 4) * 2 + (c >> 5), rr = r & 15, cc = c & 31, ob = rr * 64 + cc * 2; return st * 1024 + (ob ^ (((ob >> 9) & 1) << 5)); }
__device__ __forceinline__ void stage_rc(int b, int& R, int& C) { const int st = b / 1024, sb = b % 1024, swz = sb ^ (((sb >> 9) & 1) << 5); R = (st >> 1) * 16 + swz / 64; C = (st & 1) * 32 + (swz % 64) / 2; }
__device__ __forceinline__ int perm32(int rho) { const int n = rho >> 4, i = rho & 15; return 8 * (i >> 2) + 4 * n + (i & 3); }
struct Unit { int pm, pn; };
struct Gemm { const bf16_t* A; const bf16_t* Bt; int lda, ldb, K; };

struct StaticOrder {
    int nM, nN, nwg, G, c;
    __device__ void init(int M, int N, int G_, int c_) { nM = M / BM; nN = N / BM; nwg = nM * nN; G = G_; c = c_; }
    __device__ bool next(int i, Unit& u) const {
        const long Lx = (long)i * G + c; if (c < 0 || Lx >= nwg) return false;
        int wgid = (int)Lx; { const int q = nwg / NXCD, r = nwg % NXCD, xcd = wgid % NXCD, off = wgid / NXCD; wgid = (xcd < r ? xcd * (q + 1) : r * (q + 1) + (xcd - r) * q) + off; }
        const int nig = WGM * nN, gid = wgid / nig, fm = gid * WGM, gsz = (nM - fm) < WGM ? (nM - fm) : WGM;
        u.pm = fm + ((wgid % nig) % gsz); u.pn = (wgid % nig) / gsz; return true;
    }
};
struct BatchOrder {
    int nunits, G, c, mode;
    __device__ bool next(int i, Unit& u) const {
        const int Lx = i * G + c; if (c < 0 || Lx >= nunits) return false;
        const int xcd = Lx & 7, slot = Lx >> 3;
        if (mode == 1) { const int g = xcd * 4 + (slot >> 1); u.pm = 2 * g + (slot & 1); u.pn = g; }
        else { const int g = xcd * 4 + (slot >> 2); u.pm = 2 * g + ((slot >> 1) & 1); u.pn = 2 * g + (slot & 1); }
        return true;
    }
};

template <class Epi, class Sched>
__device__ __forceinline__ void gemm_phase(LAS unsigned char* lds, const Gemm g, const Sched& S, const Epi& E) {
    const int tid = threadIdx.x, wid = __builtin_amdgcn_readfirstlane(tid >> 6), lane = tid & 63, wr = wid >> 2, wc = wid & 3, fr = lane & 15, fq = lane >> 4;
    const int K = g.K, nt = K / BK;
    unsigned voffA[2], voffB[2];
#pragma unroll
    for (int i = 0; i < 2; ++i) { int R, C; stage_rc(tid * 16 + i * 8192, R, C); const int Rb = Epi::PERM ? ((R & ~31) + perm32(R & 31)) : R;
        voffA[i] = (unsigned)(R * g.lda + C) * 2u; voffB[i] = (unsigned)(Rb * g.ldb + C) * 2u; }
    const size_t kstep = (size_t)(BK * 2);
    const size_t hstepA = (size_t)HALF * g.lda * 2, hstepB = (size_t)HALF * g.ldb * 2;
    const size_t tstepA = 2 * hstepA, tstepB = 2 * hstepB;
    const unsigned ldsw = (unsigned)wid * 1024u;
    const int aoff = lds_byte(wr * 64 + fr, fq * 8), boff = lds_byte(wc * 32 + fr, fq * 8);
#define PG8_SA(b, h) (((b) * 2 + (h)) * HTB)
#define PG8_SB(b, h) ((4 + (b) * 2 + (h)) * HTB)
#define PG8_STAGE(bufoff, gbase, voff) do { _Pragma("unroll") for (int _i = 0; _i < 2; ++_i) \
        __builtin_amdgcn_global_load_lds((const unsigned*)((const char*)(gbase) + (voff)[_i]), (LAS unsigned*)(lds + (bufoff) + ldsw + _i * 8192), 16, 0, 0); } while (0)
#define PG8_LDA(dst, b, h) do { _Pragma("unroll") for (int m = 0; m < 4; ++m) _Pragma("unroll") for (int k = 0; k < 2; ++k) dst[m][k] = *(const LAS bf16x8*)(lds + PG8_SA(b, h) + aoff + m * 2048 + k * 1024); } while (0)
#define PG8_LDB(dst, b, h) do { _Pragma("unroll") for (int n = 0; n < 2; ++n) _Pragma("unroll") for (int k = 0; k < 2; ++k) dst[n][k] = *(const LAS bf16x8*)(lds + PG8_SB(b, h) + boff + n * 2048 + k * 1024); } while (0)
#define PG8_MMA(ai, bj, At, Bt) do { __builtin_amdgcn_s_setprio(1); _Pragma("unroll") for (int m = 0; m < 4; ++m) _Pragma("unroll") for (int n = 0; n < 2; ++n) _Pragma("unroll") for (int k = 0; k < 2; ++k) \
        acc[ai][bj][m][n] = __builtin_amdgcn_mfma_f32_16x16x32_bf16(Bt[n][k], At[m][k], acc[ai][bj][m][n], 0, 0, 0); __builtin_amdgcn_s_setprio(0); } while (0)
#define PG8_WAIT_V(n) asm volatile("s_waitcnt vmcnt(" #n ")" ::: "memory")
#define PG8_WAIT_L(n) asm volatile("s_waitcnt lgkmcnt(" #n ")" ::: "memory")
#define PG8_BAR __builtin_amdgcn_s_barrier()
#define PG8_SCHED __builtin_amdgcn_sched_barrier(0)
    Unit cur, nxt; int ui = 0;
    if (!S.next(0, cur)) return;
    f32x4 acc[2][2][4][2];
#pragma unroll
    for (int a = 0; a < 2; ++a)
#pragma unroll
        for (int b = 0; b < 2; ++b)
#pragma unroll
            for (int m = 0; m < 4; ++m)
#pragma unroll
                for (int n = 0; n < 2; ++n) acc[a][b][m][n] = (f32x4){0.f, 0.f, 0.f, 0.f};
    bf16x8 At[4][2], B0[2][2], B1[2][2];
    const char* cA = (const char*)g.A + (size_t)cur.pm * tstepA; const char* cB = (const char*)g.Bt + (size_t)cur.pn * tstepB;
    PG8_STAGE(PG8_SB(0, 0), cB, voffB); PG8_STAGE(PG8_SB(0, 1), cB + hstepB, voffB); PG8_STAGE(PG8_SA(0, 0), cA, voffA); PG8_STAGE(PG8_SA(0, 1), cA + hstepA, voffA);
    if (wr == 1) PG8_BAR;
    PG8_WAIT_V(2); PG8_BAR;
    PG8_STAGE(PG8_SB(1, 0), cB + kstep, voffB); PG8_STAGE(PG8_SA(1, 0), cA + kstep, voffA); PG8_STAGE(PG8_SB(1, 1), cB + hstepB + kstep, voffB);
    PG8_WAIT_V(6); PG8_BAR;
    for (;;) {
        const bool has_next = S.next(ui + 1, nxt);
        const char* nA = has_next ? (const char*)g.A + (size_t)nxt.pm * tstepA : cA; const char* nB = has_next ? (const char*)g.Bt + (size_t)nxt.pn * tstepB : cB;
#pragma unroll 1
        for (int t = 0; t < nt; t += 2) {
            const bool last = (t == nt - 2);
            const char* a1 = cA + (size_t)(t + 1) * kstep;
            const char* a2 = last ? nA : cA + (size_t)(t + 2) * kstep; const char* b2 = last ? nB : cB + (size_t)(t + 2) * kstep;
            const char* a3 = a2 + kstep; const char* b3 = b2 + kstep;
            PG8_LDB(B0, 0, 0); PG8_LDB(B1, 0, 1); PG8_SCHED; PG8_LDA(At, 0, 0); PG8_STAGE(PG8_SA(1, 1), a1 + hstepA, voffA);
            PG8_WAIT_V(8); PG8_WAIT_L(0); PG8_BAR; PG8_MMA(0, 0, At, B0); PG8_MMA(0, 1, At, B1); PG8_BAR; PG8_SCHED;
            PG8_LDA(At, 0, 1); PG8_STAGE(PG8_SB(0, 0), b2, voffB); PG8_STAGE(PG8_SB(0, 1), b2 + hstepB, voffB); PG8_STAGE(PG8_SA(0, 0), a2, voffA);
            PG8_WAIT_V(8); PG8_WAIT_L(0); PG8_BAR; PG8_MMA(1, 0, At, B0); PG8_MMA(1, 1, At, B1); PG8_BAR; PG8_SCHED;
            PG8_LDB(B0, 1, 0); PG8_LDB(B1, 1, 1); PG8_SCHED; PG8_LDA(At, 1, 0); PG8_STAGE(PG8_SA(0, 1), a2 + hstepA, voffA);
            PG8_WAIT_V(8); PG8_WAIT_L(0); PG8_BAR; PG8_MMA(0, 0, At, B0); PG8_MMA(0, 1, At, B1); PG8_BAR; PG8_SCHED;
            PG8_LDA(At, 1, 1); PG8_STAGE(PG8_SB(1, 0), b3, voffB); PG8_STAGE(PG8_SB(1, 1), b3 + hstepB, voffB); PG8_STAGE(PG8_SA(1, 0), a3, voffA);
            PG8_WAIT_V(8); PG8_WAIT_L(0); PG8_BAR; PG8_MMA(1, 0, At, B0); PG8_MMA(1, 1, At, B1); PG8_BAR; PG8_SCHED;
        }
        if (wr == 0) PG8_BAR;
        if constexpr (!Epi::AFTER_DRAIN) E(acc, cur, wr, wc, fr, fq);
        if (!has_next) break;
#pragma unroll
        for (int a = 0; a < 2; ++a)
#pragma unroll
            for (int b = 0; b < 2; ++b)
#pragma unroll
                for (int m = 0; m < 4; ++m)
#pragma unroll
                    for (int n = 0; n < 2; ++n) acc[a][b][m][n] = (f32x4){0.f, 0.f, 0.f, 0.f};
        cur = nxt; cA = nA; cB = nB; ++ui;
        if (wr == 1) PG8_BAR;
    }
    PG8_WAIT_V(0);
    PG8_BAR;
    if constexpr (Epi::AFTER_DRAIN) E(acc, cur, wr, wc, fr, fq);
#undef PG8_SA
#undef PG8_SB
#undef PG8_STAGE
#undef PG8_LDA
#undef PG8_LDB
#undef PG8_MMA
#undef PG8_WAIT_V
#undef PG8_WAIT_L
#undef PG8_BAR
#undef PG8_SCHED
}
}
using pg8::Unit;
typedef f32x4 Acc[2][2][4][2];

#define EPI_ROWS(...) _Pragma("unroll") for (int ai = 0; ai < 2; ++ai) _Pragma("unroll") for (int m = 0; m < 4; ++m) { const int row = row0 + ai * 128 + m * 16; __VA_ARGS__ }

struct EpiG1 {
    static constexpr bool PERM = true, AFTER_DRAIN = false;
    bf16_t *U, *SG, *V, *W, *SR, *SC;
    __device__ __forceinline__ void operator()(const Acc& acc, const Unit& u, int wr, int wc, int fr, int fq) const {
        const int row0 = u.pm * 256 + wr * 64 + fr, cw = wc * 32 + 8 * fq, pn = u.pn;
        if (pn < 2) {
            EPI_ROWS(
                const int c = row >> 5, tt = row & 31;
                _Pragma("unroll") for (int bj = 0; bj < 2; ++bj) { const int col = pn * 256 + bj * 128 + cw; const int g = col >> 4, h0 = col & 15;
                    *(u32x4*)(U + ((size_t)(g * NCH_ + c)) * LDU_ + tt * 16 + h0) = pack8(acc[ai][bj][m][0], acc[ai][bj][m][1]); } )
        } else if (pn < 4) {
            EPI_ROWS(
                _Pragma("unroll") for (int bj = 0; bj < 2; ++bj) { const int col = (pn - 2) * 256 + bj * 128 + cw; const f32x4 a = acc[ai][bj][m][0], b = acc[ai][bj][m][1];
                    *(u32x4*)(SG + (size_t)row * SW_ + col) = pack8(a * sigm4(a), b * sigm4(b)); } )
        } else if (pn < 12) {
            EPI_ROWS(
                const int col = (pn - 4) * 128 + cw;
                *(u32x4*)(V + (size_t)row * CWID_ + col) = pack8(acc[ai][0][m][0] * acc[ai][1][m][0], acc[ai][0][m][1] * acc[ai][1][m][1]); )
        } else if (pn < 20) {
            EPI_ROWS(
                const int col = (pn - 12) * 128 + cw; const f32x4 ga = acc[ai][1][m][0], gb = acc[ai][1][m][1];
                *(u32x4*)(W + (size_t)row * CWID_ + col) = pack8(acc[ai][0][m][0] * (ga * sigm4(ga)), acc[ai][0][m][1] * (gb * sigm4(gb))); )
        } else {
            bf16_t* dst = pn < 24 ? SR : SC; const int pb = pn < 24 ? pn - 20 : pn - 24;
            EPI_ROWS(
                _Pragma("unroll") for (int bj = 0; bj < 2; ++bj) { const int col = pb * 256 + bj * 128 + cw;
                    *(u32x4*)(dst + (size_t)row * D_ + col) = pack8(acc[ai][bj][m][0], acc[ai][bj][m][1]); } )
        }
    }
};
__device__ void carry_group(const Params& P, int g, unsigned char* smem);
struct EpiS1 {
    static constexpr bool PERM = false, AFTER_DRAIN = true;
    float* SLOC; unsigned* gcnt; const Params* P; unsigned char* smem;
    __device__ __forceinline__ void operator()(const Acc& acc, const Unit& u, int wr, int wc, int fr, int fq) const {
        const int row0 = u.pm * 256 + wr * 64 + fr;
        EPI_ROWS(
            float* rp = SLOC + (size_t)row * 128 + wc * 32 + 4 * fq; *(f32x4*)rp = acc[ai][0][m][0]; *(f32x4*)(rp + 16) = acc[ai][0][m][1]; )
        asm volatile("s_waitcnt vmcnt(0)" ::: "memory");
        __syncthreads();
        unsigned* flag = (unsigned*)smem;
        if (threadIdx.x == 0) {
            __builtin_amdgcn_fence(__ATOMIC_RELEASE, "agent");
            asm volatile("s_waitcnt vmcnt(0)" ::: "memory");
            const unsigned old = __hip_atomic_fetch_add(gcnt + 64 * u.pn, 1u, __ATOMIC_RELAXED, __HIP_MEMORY_SCOPE_AGENT);
            if (old == 1u) { __builtin_amdgcn_fence(__ATOMIC_ACQUIRE, "agent"); asm volatile("s_waitcnt vmcnt(0)" ::: "memory"); }
            flag[0] = old;
        }
        __syncthreads();
        const unsigned old = flag[0];
        __syncthreads();
        if (old == 1u) carry_group(*P, u.pn, smem);
    }
};
struct EpiS2 {
    static constexpr bool PERM = true, AFTER_DRAIN = false;
    bf16_t* YG;
    __device__ __forceinline__ void operator()(const Acc& acc, const Unit& u, int wr, int wc, int fr, int fq) const {
        const int g = u.pm >> 1, c0 = (u.pm & 1) * 256 + wr * 64 + fr, n0 = (u.pn & 1) * 256 + wc * 32 + 8 * fq;
#pragma unroll
        for (int ai = 0; ai < 2; ++ai)
#pragma unroll
            for (int m = 0; m < 4; ++m) { const int c = c0 + ai * 128 + m * 16;
#pragma unroll
                for (int bj = 0; bj < 2; ++bj) { const int n = n0 + bj * 128, t = n >> 4, h0 = n & 15;
                    *(u32x4*)(YG + (size_t)(c * T_ + t) * SW_ + g * 16 + h0) = pack8(gelu4(acc[ai][bj][m][0]), gelu4(acc[ai][bj][m][1])); } }
    }
};
struct EpiStore {
    static constexpr bool PERM = true, AFTER_DRAIN = false;
    bf16_t* O; int ldc;
    __device__ __forceinline__ void operator()(const Acc& acc, const Unit& u, int wr, int wc, int fr, int fq) const {
        const int row0 = u.pm * 256 + wr * 64 + fr, col0 = u.pn * 256 + wc * 32 + 8 * fq;
        EPI_ROWS(
            _Pragma("unroll") for (int bj = 0; bj < 2; ++bj) *(u32x4*)(O + (size_t)row * ldc + col0 + bj * 128) = pack8(acc[ai][bj][m][0], acc[ai][bj][m][1]); )
    }
};
struct EpiGlu {
    static constexpr bool PERM = true, AFTER_DRAIN = false;
    const bf16_t *YG, *SG; const float* bglu; bf16_t* Y3;
    __device__ __forceinline__ void operator()(const Acc& acc, const Unit& u, int wr, int wc, int fr, int fq) const {
        const int row0 = u.pm * 256 + wr * 64 + fr, col0 = u.pn * 256 + wc * 32 + 8 * fq;
        f32x4 b0[2], b1[2];
#pragma unroll
        for (int bj = 0; bj < 2; ++bj) { b0[bj] = *(const f32x4*)(bglu + col0 + bj * 128); b1[bj] = *(const f32x4*)(bglu + col0 + bj * 128 + 4); }
#pragma unroll
        for (int ai = 0; ai < 2; ++ai) {
            u32x4 yw[4][2], sw[4][2];
#pragma unroll
            for (int m = 0; m < 4; ++m)
#pragma unroll
                for (int bj = 0; bj < 2; ++bj) { const size_t off = (size_t)(row0 + ai * 128 + m * 16) * SW_ + col0 + bj * 128; yw[m][bj] = *(const u32x4*)(YG + off); sw[m][bj] = *(const u32x4*)(SG + off); }
#pragma unroll
            for (int m = 0; m < 4; ++m)
#pragma unroll
                for (int bj = 0; bj < 2; ++bj) { const size_t off = (size_t)(row0 + ai * 128 + m * 16) * SW_ + col0 + bj * 128;
                    *(u32x4*)(Y3 + off) = pack8(bf4lo(yw[m][bj]) * sigm4(acc[ai][bj][m][0] + b0[bj]) * bf4lo(sw[m][bj]), bf4hi(yw[m][bj]) * sigm4(acc[ai][bj][m][1] + b1[bj]) * bf4hi(sw[m][bj])); }
        }
    }
};
template <int MODE> struct EpiMerge {
    static constexpr bool PERM = true, AFTER_DRAIN = false;
    const bf16_t *S, *TMPI; bf16_t* O;
    __device__ __forceinline__ void operator()(const Acc& acc, const Unit& u, int wr, int wc, int fr, int fq) const {
        const int row0 = u.pm * 256 + wr * 64 + fr, col0 = u.pn * 256 + wc * 32 + 8 * fq;
        if (MODE == 0) {
            u32x4 sw[2][4][2];
#pragma unroll
            for (int ai = 0; ai < 2; ++ai)
#pragma unroll
                for (int m = 0; m < 4; ++m)
#pragma unroll
                    for (int bj = 0; bj < 2; ++bj) sw[ai][m][bj] = *(const u32x4*)(S + (size_t)(row0 + ai * 128 + m * 16) * D_ + col0 + bj * 128);
#pragma unroll
            for (int ai = 0; ai < 2; ++ai)
#pragma unroll
                for (int m = 0; m < 4; ++m)
#pragma unroll
                    for (int bj = 0; bj < 2; ++bj) { const size_t off = (size_t)(row0 + ai * 128 + m * 16) * D_ + col0 + bj * 128;
                        *(u32x4*)(O + off) = pack8(sigm4(bf4lo(sw[ai][m][bj])) * acc[ai][bj][m][0], sigm4(bf4hi(sw[ai][m][bj])) * acc[ai][bj][m][1]); }
            return;
        }
#pragma unroll
        for (int ai = 0; ai < 2; ++ai) {
            u32x4 sw[4][2], tw[4][2];
#pragma unroll
            for (int m = 0; m < 4; ++m)
#pragma unroll
                for (int bj = 0; bj < 2; ++bj) { const size_t off = (size_t)(row0 + ai * 128 + m * 16) * D_ + col0 + bj * 128; sw[m][bj] = *(const u32x4*)(S + off); tw[m][bj] = *(const u32x4*)(TMPI + off); }
#pragma unroll
            for (int m = 0; m < 4; ++m)
#pragma unroll
                for (int bj = 0; bj < 2; ++bj) { const size_t off = (size_t)(row0 + ai * 128 + m * 16) * D_ + col0 + bj * 128;
                    const f32x4 a = sigm4(bf4lo(sw[m][bj])) * acc[ai][bj][m][0] + bf4lo(tw[m][bj]), b = sigm4(bf4hi(sw[m][bj])) * acc[ai][bj][m][1] + bf4hi(tw[m][bj]);
                    *(u32x4*)(O + off) = pack8(a, b); }
        }
    }
};
struct PanelX { float* part; unsigned* cnt; };
__device__ __forceinline__ void panel_rstd(const PanelX& px, const Unit& u, int wr, int wc, int fr, int fq, float (&s)[2][4]) {
    const int row0 = u.pm * 256 + wr * 64 + fr;
#pragma unroll
    for (int ai = 0; ai < 2; ++ai)
#pragma unroll
        for (int m = 0; m < 4; ++m) { float t = s[ai][m]; t += __shfl_xor(t, 16); t += __shfl_xor(t, 32);
            if (fq == 0) __hip_atomic_store(px.part + (size_t)(row0 + ai * 128 + m * 16) * 16 + u.pn * 4 + wc, t, __ATOMIC_RELAXED, __HIP_MEMORY_SCOPE_AGENT); }
    asm volatile("s_waitcnt vmcnt(0)" ::: "memory");
    __builtin_amdgcn_s_barrier();
    if (threadIdx.x == 0) {
        unsigned* c = px.cnt + 64 * u.pm;
        __hip_atomic_fetch_add(c, 1u, __ATOMIC_RELAXED, __HIP_MEMORY_SCOPE_AGENT);
        unsigned spins = 0;
        while (__hip_atomic_load(c, __ATOMIC_RELAXED, __HIP_MEMORY_SCOPE_AGENT) < 4u) { __builtin_amdgcn_s_sleep(4); if (++spins > (1u << 20)) break; }
    }
    asm volatile("s_waitcnt vmcnt(0) lgkmcnt(0)" ::: "memory");
    __builtin_amdgcn_s_barrier();
    asm volatile("" ::: "memory");
    __builtin_amdgcn_fence(__ATOMIC_ACQUIRE, "agent");
    asm volatile("s_waitcnt vmcnt(0)" ::: "memory");
#pragma unroll
    for (int ai = 0; ai < 2; ++ai)
#pragma unroll
        for (int m = 0; m < 4; ++m) { float* q = px.part + (size_t)(row0 + ai * 128 + m * 16) * 16 + fq * 4;
            const float q0 = __hip_atomic_load(q, __ATOMIC_RELAXED, __HIP_MEMORY_SCOPE_AGENT), q1 = __hip_atomic_load(q + 1, __ATOMIC_RELAXED, __HIP_MEMORY_SCOPE_AGENT),
                        q2 = __hip_atomic_load(q + 2, __ATOMIC_RELAXED, __HIP_MEMORY_SCOPE_AGENT), q3 = __hip_atomic_load(q + 3, __ATOMIC_RELAXED, __HIP_MEMORY_SCOPE_AGENT);
            float t = (q0 + q1) + (q2 + q3); t += __shfl_xor(t, 16); t += __shfl_xor(t, 32);
            s[ai][m] = rsqrtf(t * (1.0f / D_) + EPS_); }
}
__device__ __forceinline__ float sq8(f32x4 a, f32x4 b) { return ((a[0] * a[0] + a[1] * a[1]) + (a[2] * a[2] + a[3] * a[3])) + ((b[0] * b[0] + b[1] * b[1]) + (b[2] * b[2] + b[3] * b[3])); }
struct EpiX1 {
    static constexpr bool PERM = true, AFTER_DRAIN = true;
    const float *x, *gain; bf16_t* X1B; PanelX px;
    __device__ __forceinline__ void operator()(Acc& acc, const Unit& u, int wr, int wc, int fr, int fq) const {
        const int row0 = u.pm * 256 + wr * 64 + fr, col0 = u.pn * 256 + wc * 32 + 8 * fq;
        float s[2][4];
#pragma unroll
        for (int ai = 0; ai < 2; ++ai)
#pragma unroll
            for (int m = 0; m < 4; ++m) s[ai][m] = sq8(acc[ai][0][m][0], acc[ai][0][m][1]) + sq8(acc[ai][1][m][0], acc[ai][1][m][1]);
        panel_rstd(px, u, wr, wc, fr, fq, s);
        f32x4 g0[2], g1[2];
#pragma unroll
        for (int bj = 0; bj < 2; ++bj) { g0[bj] = *(const f32x4*)(gain + col0 + bj * 128); g1[bj] = *(const f32x4*)(gain + col0 + bj * 128 + 4); }
#pragma unroll
        for (int ai = 0; ai < 2; ++ai) {
            f32x4 xa[4][2], xb[4][2];
#pragma unroll
            for (int m = 0; m < 4; ++m)
#pragma unroll
                for (int bj = 0; bj < 2; ++bj) { const size_t off = (size_t)(row0 + ai * 128 + m * 16) * D_ + col0 + bj * 128; xa[m][bj] = *(const f32x4*)(x + off); xb[m][bj] = *(const f32x4*)(x + off + 4); }
#pragma unroll
            for (int m = 0; m < 4; ++m) { const float rs = s[ai][m];
#pragma unroll
                for (int bj = 0; bj < 2; ++bj) { const size_t off = (size_t)(row0 + ai * 128 + m * 16) * D_ + col0 + bj * 128;
                    const f32x4 ya = xa[m][bj] + acc[ai][bj][m][0] * rs * g0[bj], yb = xb[m][bj] + acc[ai][bj][m][1] * rs * g1[bj];
                    *(u32x4*)(X1B + off) = pack8(ya, yb); } }
        }
    }
};
struct EpiOut {
    static constexpr bool PERM = true, AFTER_DRAIN = true;
    const bf16_t *PE, *X1B; const float* gain; float* OUT; PanelX px;
    __device__ __forceinline__ void operator()(Acc& acc, const Unit& u, int wr, int wc, int fr, int fq) const {
        const int row0 = u.pm * 256 + wr * 64 + fr, col0 = u.pn * 256 + wc * 32 + 8 * fq;
        float s[2][4];
#pragma unroll
        for (int ai = 0; ai < 2; ++ai) {
            u32x4 pw[4][2];
#pragma unroll
            for (int m = 0; m < 4; ++m)
#pragma unroll
                for (int bj = 0; bj < 2; ++bj) pw[m][bj] = *(const u32x4*)(PE + (size_t)(row0 + ai * 128 + m * 16) * D_ + col0 + bj * 128);
#pragma unroll
            for (int m = 0; m < 4; ++m) { float t = 0.f;
#pragma unroll
                for (int bj = 0; bj < 2; ++bj) { acc[ai][bj][m][0] = bf4lo(pw[m][bj]) * sigm4(acc[ai][bj][m][0]); acc[ai][bj][m][1] = bf4hi(pw[m][bj]) * sigm4(acc[ai][bj][m][1]);
                    t += sq8(acc[ai][bj][m][0], acc[ai][bj][m][1]); }
                s[ai][m] = t; }
        }
        panel_rstd(px, u, wr, wc, fr, fq, s);
        f32x4 g0[2], g1[2];
#pragma unroll
        for (int bj = 0; bj < 2; ++bj) { g0[bj] = *(const f32x4*)(gain + col0 + bj * 128); g1[bj] = *(const f32x4*)(gain + col0 + bj * 128 + 4); }
        u32x4 xw[2][4][2];
#pragma unroll
        for (int ai = 0; ai < 2; ++ai)
#pragma unroll
            for (int m = 0; m < 4; ++m)
#pragma unroll
                for (int bj = 0; bj < 2; ++bj) xw[ai][m][bj] = *(const u32x4*)(X1B + (size_t)(row0 + ai * 128 + m * 16) * D_ + col0 + bj * 128);
#pragma unroll
        for (int ai = 0; ai < 2; ++ai)
#pragma unroll
            for (int m = 0; m < 4; ++m) { const float rs = s[ai][m];
#pragma unroll
                for (int bj = 0; bj < 2; ++bj) { const size_t off = (size_t)(row0 + ai * 128 + m * 16) * D_ + col0 + bj * 128;
                    *(f32x4*)(OUT + off) = bf4lo(xw[ai][m][bj]) + acc[ai][bj][m][0] * rs * g0[bj]; *(f32x4*)(OUT + off + 4) = bf4hi(xw[ai][m][bj]) + acc[ai][bj][m][1] * rs * g1[bj]; } }
    }
};

__device__ __forceinline__ void tconv_tile(const float* __restrict__ src, int lds_, int sc0, int k0, bf16_t* __restrict__ dst, int ldd, int n0, float* tile  ) {
    const int tid = threadIdx.x;
    { const int nn = tid & 63, kb = tid >> 6; const float* pp = src + (size_t)(k0 + kb) * lds_ + sc0 + nn; const size_t step = (size_t)8 * lds_;
#pragma unroll 1
      for (int hb = 0; hb < 2; ++hb) { float v[16];
#pragma unroll
        for (int i = 0; i < 16; ++i) { v[i] = *pp; pp += step; }
#pragma unroll
        for (int i = 0; i < 16; ++i) tile[(kb + 8 * (hb * 16 + i)) * 65 + nn] = v[i]; } }
    __syncthreads();
#pragma unroll
    for (int i = 0; i < 4; ++i) { const int pidx = tid + 512 * i, kk2 = (pidx & 31) * 8, nn2 = pidx >> 5;
      f32x4 a, b;
#pragma unroll
      for (int j = 0; j < 4; ++j) { a[j] = tile[(kk2 + j) * 65 + nn2]; b[j] = tile[(kk2 + 4 + j) * 65 + nn2]; }
      *(u32x4*)(dst + (size_t)(n0 + nn2) * ldd + k0 + kk2) = pack8(a, b); }
    __syncthreads();
}
__device__ __forceinline__ int win_srccol(int n0) {
    const int pn = n0 >> 8, j = n0 & 255;
    if (pn < 2) return 256 * pn + j;
    if (pn < 4) return 512 + 256 * (pn - 2) + j;
    if (pn < 12) { const int i = pn - 4; return j < 128 ? 1024 + 128 * i + j : 3072 + 128 * i + (j - 128); }
    if (pn < 20) { const int i = pn - 12; return j < 128 ? 2048 + 128 * i + j : 4096 + 128 * i + (j - 128); }
    if (pn < 24) return 5120 + 256 * (pn - 20) + j;
    return 6144 + 256 * (pn - 24) + j;
}
__device__ void ssm_prep(const Params& P, int g, int r, unsigned char* smem) {
    float2* s_ab = (float2*)smem;
    float2* s_Bb = s_ab + 64;
    float2* s_C = s_Bb + 1024;
    float2* s_pw = s_C + 1024;
    float* s_Kd = (float*)(s_pw + 64 * 33);
    const int tid = threadIdx.x;
    bf16_t* MC = (bf16_t*)(P.ws + WS_MC); bf16_t* WST = (bf16_t*)(P.ws + WS_WST); float2* abT = (float2*)(P.ws + WS_ABT);
    if (tid < 64) {
        const int p = tid; const float dt = expf(P.log_step[g]); const float ar = P.a_re[g * 64 + p], ai = P.a_im[g * 64 + p];
        const float mag = expf(ar * dt), th = ai * dt; const float abr = mag * cosf(th), abi = mag * sinf(th);
        const float den = ar * ar + ai * ai, nr = abr - 1.0f; const float fr = (nr * ar + abi * ai) / den, fi = (abi * ar - nr * ai) / den;
        s_ab[p] = make_float2(abr, abi);
#pragma unroll 1
        for (int h = 0; h < 16; ++h) { const float br = P.b_re[(g * 64 + p) * 16 + h], bi = P.b_im[(g * 64 + p) * 16 + h]; s_Bb[p * 16 + h] = make_float2(fr * br - fi * bi, fr * bi + fi * br); }
        float cr = 1.f, ci = 0.f;
#pragma unroll 1
        for (int d = 0; d <= T_; ++d) { s_pw[p * 33 + d] = make_float2(cr, ci); const float nr2 = cr * abr - ci * abi, ni2 = cr * abi + ci * abr; cr = nr2; ci = ni2; }
        if (r == 0) abT[g * 64 + p] = s_pw[p * 33 + T_];
    }
    for (int i = tid; i < 1024; i += 512) { const int h = i >> 6, p = i & 63; s_C[i] = make_float2(P.c_re[(g * 16 + h) * 64 + p], P.c_im[(g * 16 + h) * 64 + p]); }
    __syncthreads();
#pragma unroll 1
    for (int i = 0; i < 4; ++i) { const int idx = tid + 512 * i, d = idx >> 6, hh = (idx >> 4) & 3, hp = idx & 15, h = 4 * r + hh; float a = 0.f;
#pragma unroll 4
        for (int p = 0; p < 64; ++p) { const float2 c = s_C[h * 64 + p], w = s_pw[p * 33 + d], b = s_Bb[p * 16 + hp]; const float xr = c.x * w.x - c.y * w.y, xi = c.x * w.y + c.y * w.x; a += xr * b.x - xi * b.y; }
        if (d == 0 && h == hp) a += P.d_skip[g * 16 + h];
        s_Kd[idx] = a; }
    __syncthreads();
#pragma unroll 1
    for (int i = 0; i < 20; ++i) { const int pidx = tid + 512 * i, rowi = pidx / 80, col8 = (pidx % 80) * 8, t = rowi >> 2, hh = rowi & 3, h = 4 * r + hh;
        f32x4 a = {0.f, 0.f, 0.f, 0.f}, b = {0.f, 0.f, 0.f, 0.f};
        if (col8 < KU_) { const int k = col8 >> 4, h0 = col8 & 15;
            if (k <= t) { const float* kd = s_Kd + (t - k) * 64 + hh * 16 + h0; a = (f32x4){kd[0], kd[1], kd[2], kd[3]}; b = (f32x4){kd[4], kd[5], kd[6], kd[7]}; } }
        else { const int q0 = col8 - KU_, im = q0 >= 64, p0 = q0 & 63;
#pragma unroll
            for (int j = 0; j < 8; ++j) { const float2 c = s_C[h * 64 + p0 + j], w = s_pw[(p0 + j) * 33 + t + 1]; const float v = im ? -(c.x * w.y + c.y * w.x) : (c.x * w.x - c.y * w.y); if (j < 4) a[j] = v; else b[j - 4] = v; } }
        *(u32x4*)(MC + ((size_t)(g * KU_ + t * 16 + h)) * LDU_ + col8) = pack8(a, b); }
#pragma unroll 1
    for (int i = 0; i < 4; ++i) { const int pidx = tid + 512 * i, q = 32 * r + (pidx >> 6), col8 = (pidx & 63) * 8, k = col8 >> 4, h0 = col8 & 15, p = q & 63, im = q >= 64;
        const float2 w = s_pw[p * 33 + (T_ - 1 - k)]; f32x4 a, b;
#pragma unroll
        for (int j = 0; j < 8; ++j) { const float2 bb = s_Bb[p * 16 + h0 + j]; const float v = im ? (w.x * bb.y + w.y * bb.x) : (w.x * bb.x - w.y * bb.y); if (j < 4) a[j] = v; else b[j - 4] = v; }
        *(u32x4*)(WST + ((size_t)(g * 256 + q)) * KU_ + col8) = pack8(a, b); }
    __syncthreads();
}

__device__ __forceinline__ void do_job(const Params& P, unsigned char* smem, int job) {
    const int tid = threadIdx.x;
    unsigned char* ws = P.ws;
    constexpr int J_SSM = 128, J_TC = 704, J_RMS = 512;
    {
        int j = job;
        if (j < J_SSM) { ssm_prep(P, j >> 2, j & 3, smem); return; }
        j -= J_SSM;
        if (j < J_TC) {
            const float* src; bf16_t* dst; int K, N, off; bool perm = false;
            if (j < 448) { src = P.w_in; dst = (bf16_t*)(ws + WS_WIN); K = 1024; N = INW_; perm = true; }
            else if ((off = j - 448) < 16) { j = off; src = P.w_glu; dst = (bf16_t*)(ws + WS_WGLU); K = 512; N = 512; }
            else if ((off = j - 464) < 32) { j = off; src = P.w_ssm_out; dst = (bf16_t*)(ws + WS_WSSO); K = 512; N = 1024; }
            else if ((off = j - 496) < 64) { j = off; src = P.w_conv_out; dst = (bf16_t*)(ws + WS_WCO); K = 1024; N = 1024; }
            else if ((off = j - 560) < 64) { j = off; src = P.w_o; dst = (bf16_t*)(ws + WS_WO); K = 1024; N = 1024; }
            else if ((off = j - 624) < 16) { j = off; src = P.w_ple; dst = (bf16_t*)(ws + WS_WPLE); K = 256; N = 1024; }
            else { j = j - 640; src = P.w_ple_gate; dst = (bf16_t*)(ws + WS_WG); K = 1024; N = 1024; }
            const int nkt = K >> 8, ntile = j / nkt, ktile = j % nkt, n0 = ntile * 64, k0 = ktile * 256;
            const int sc0 = perm ? win_srccol(n0) : n0;
            tconv_tile(src, N, sc0, k0, dst, K, n0, (float*)smem);
            return;
        }
        j -= J_TC;
        if (j < J_RMS) {
            const int lane = tid & 63, rowb = j * 32 + (tid >> 6) * 4;
            f32x4 v[4][4]; float s[4];
#pragma unroll
            for (int rr = 0; rr < 4; ++rr)
#pragma unroll
                for (int i = 0; i < 4; ++i) v[rr][i] = *(const f32x4*)(P.x + (size_t)(rowb + rr) * D_ + i * 256 + lane * 4);
#pragma unroll
            for (int rr = 0; rr < 4; ++rr) { float t = 0.f;
#pragma unroll
                for (int i = 0; i < 4; ++i) t += (v[rr][i][0] * v[rr][i][0] + v[rr][i][1] * v[rr][i][1]) + (v[rr][i][2] * v[rr][i][2] + v[rr][i][3] * v[rr][i][3]);
#pragma unroll
                for (int o = 32; o >= 1; o >>= 1) t += __shfl_xor(t, o);
                s[rr] = rsqrtf(t * (1.0f / D_) + EPS_); }
#pragma unroll
            for (int i = 0; i < 4; ++i) { const f32x4 gn = *(const f32x4*)(P.pre_norm + i * 256 + lane * 4);
#pragma unroll
                for (int rr = 0; rr < 4; ++rr) { const f32x4 y = v[rr][i] * s[rr] * gn; u32x2 w; w.x = cvt_pk_bf16(y[0], y[1]); w.y = cvt_pk_bf16(y[2], y[3]);
                    *(u32x2*)((bf16_t*)P.out + (size_t)(rowb + rr) * D_ + i * 256 + lane * 4) = w; } }
            return;
        }
        j -= J_RMS;
        {
            const size_t e0 = (size_t)j * 8192 + tid * 8;
            const f32x4 a0 = *(const f32x4*)(P.p + e0), b0 = *(const f32x4*)(P.p + e0 + 4), a1 = *(const f32x4*)(P.p + e0 + 4096), b1 = *(const f32x4*)(P.p + e0 + 4100);
            *(u32x4*)((bf16_t*)(ws + WS_PBF) + e0) = pack8(a0, b0); *(u32x4*)((bf16_t*)(ws + WS_PBF) + e0 + 4096) = pack8(a1, b1);
        }
    }
}

__device__ void phase_z(const Params& P, int b0, int nbz) {
    const bf16_t* V = (const bf16_t*)P.out + (size_t)L_ * D_;
    const bf16_t* W = (const bf16_t*)(P.ws + WS_W); bf16_t* Z = (bf16_t*)(P.ws + WS_Z);
    const int nthreads = nbz * 512;
    for (int idx = (blockIdx.x - b0) * 512 + threadIdx.x; idx < (L_ / 16) * 128; idx += nthreads) {
        const int oct = idx & 127, tb = idx >> 7, t0 = tb * 16, c0 = oct * 8;
        const f32x4 k0a = *(const f32x4*)(P.conv_w + c0), k0b = *(const f32x4*)(P.conv_w + c0 + 4);
        const f32x4 k1a = *(const f32x4*)(P.conv_w + CWID_ + c0), k1b = *(const f32x4*)(P.conv_w + CWID_ + c0 + 4);
        const f32x4 k2a = *(const f32x4*)(P.conv_w + 2 * CWID_ + c0), k2b = *(const f32x4*)(P.conv_w + 2 * CWID_ + c0 + 4);
        f32x4 m2a = {0.f, 0.f, 0.f, 0.f}, m2b = m2a, m1a = m2a, m1b = m2a;
        if (t0 > 0) { const u32x4 w2 = *(const u32x4*)(V + (size_t)(t0 - 2) * CWID_ + c0), w1 = *(const u32x4*)(V + (size_t)(t0 - 1) * CWID_ + c0);
            m2a = bf4lo(w2); m2b = bf4hi(w2); m1a = bf4lo(w1); m1b = bf4hi(w1); }
#pragma unroll
        for (int t = 0; t < 16; ++t) { const size_t off = (size_t)(t0 + t) * CWID_ + c0;
            const u32x4 vw = *(const u32x4*)(V + off), ww = *(const u32x4*)(W + off);
            const f32x4 va = bf4lo(vw), vb = bf4hi(vw);
            const f32x4 ca = k0a * m2a + k1a * m1a + k2a * va, cb = k0b * m2b + k1b * m1b + k2b * vb;
            *(u32x4*)(Z + off) = pack8(bf4lo(ww) * ca, bf4hi(ww) * cb);
            m2a = m1a; m2b = m1b; m1a = va; m1b = vb; }
    }
}
__device__ void carry_group(const Params& P, int g, unsigned char* smem) {
    const float2* abT = (const float2*)(P.ws + WS_ABT); const float* SLOC = (const float*)(P.ws + WS_SLOC); bf16_t* U = (bf16_t*)(P.ws + WS_U);
    float* sl = (float*)smem; unsigned* slw = (unsigned*)smem;
    float2* seg = (float2*)(smem + pg8::STAGE_BYTES + 64);
    const int tid = threadIdx.x, w = tid >> 6, p = tid & 63;
    const float2 a = abT[g * 64 + p];
    float2 a32 = a;
#pragma unroll
    for (int i = 0; i < 5; ++i) a32 = make_float2(a32.x * a32.x - a32.y * a32.y, 2.f * a32.x * a32.y);
    float sr = 0.f, si = 0.f;
    for (int half = 0; half < 2; ++half) {
        const f32x4* src = (const f32x4*)(SLOC + (size_t)(g * NCH_ + half * 256) * 128);
#pragma unroll
        for (int i = 0; i < 16; ++i) ((f32x4*)sl)[tid + 512 * i] = src[tid + 512 * i];
        __syncthreads();
        {
            float tr = 0.f, ti = 0.f;
#pragma unroll 8
            for (int c = 0; c < 32; ++c) { const float lr = sl[(32 * w + c) * 128 + p], li = sl[(32 * w + c) * 128 + 64 + p];
                const float nr = a.x * tr - a.y * ti + lr, ni = a.x * ti + a.y * tr + li; tr = nr; ti = ni; }
            seg[w * 64 + p] = make_float2(tr, ti);
        }
        __syncthreads();
        float wr_ = sr, wi_ = si;
#pragma unroll
        for (int j = 0; j < 8; ++j) { const float2 t = seg[j * 64 + p];
            const float nr = a32.x * sr - a32.y * si + t.x, ni = a32.x * si + a32.y * sr + t.y; sr = nr; si = ni;
            if (j + 1 == w) { wr_ = sr; wi_ = si; } }
#pragma unroll 8
        for (int c = 0; c < 32; ++c) { const float lr = sl[(32 * w + c) * 128 + p], li = sl[(32 * w + c) * 128 + 64 + p];
            slw[(32 * w + c) * 128 + p] = cvt_pk_bf16(wr_, wi_);
            const float nr = a.x * wr_ - a.y * wi_ + lr, ni = a.x * wi_ + a.y * wr_ + li; wr_ = nr; wi_ = ni; }
        __syncthreads();
#pragma unroll
        for (int i = 0; i < 4; ++i) { const int it = tid + 512 * i, c = it >> 3, p0 = (it & 7) * 8;
            const u32x4 w0 = *(const u32x4*)(slw + c * 128 + p0), w1 = *(const u32x4*)(slw + c * 128 + p0 + 4);
            u32x4 re, im;
            re.x = (w0.x & 0xffffu) | (w0.y << 16); re.y = (w0.z & 0xffffu) | (w0.w << 16); re.z = (w1.x & 0xffffu) | (w1.y << 16); re.w = (w1.z & 0xffffu) | (w1.w << 16);
            im.x = (w0.x >> 16) | (w0.y & 0xffff0000u); im.y = (w0.z >> 16) | (w0.w & 0xffff0000u); im.z = (w1.x >> 16) | (w1.y & 0xffff0000u); im.w = (w1.z >> 16) | (w1.w & 0xffff0000u);
            bf16_t* u = U + (size_t)(g * NCH_ + half * 256 + c) * LDU_ + KU_ + p0;
            *(u32x4*)u = re; *(u32x4*)(u + 64) = im; }
        __syncthreads();
    }
}

__global__ void __launch_bounds__(512, 2) hybrid_fwd(Params P) {
    extern __shared__ __attribute__((aligned(16))) unsigned char smem[];
    LAS unsigned char* lds = (LAS unsigned char*)smem;
    unsigned char* ws = P.ws;
    const int bid = blockIdx.x, nb = gridDim.x;
    const int lo = P.ph_lo, hi = P.ph_hi;
#define IN(k) (lo <= (k) && (k) < hi)
    volatile LAS unsigned* xb_st = (volatile LAS unsigned*)(lds + pg8::STAGE_BYTES);
    XcdBarrier xbar; xbar.bar = (unsigned*)(ws + WS_BAR); xbar.x = 0; xbar.st = xb_st;
    if (hi - lo > 1) {
        if (threadIdx.x < 4) xb_st[threadIdx.x] = 0u;
        __syncthreads();
        xbar = xcd_barrier_post((unsigned*)(ws + WS_BAR), xb_st);
    }
    if (lo == 0x7fffffff) cg::this_grid().sync();
#define SEAM(k) do { if (IN(k) && IN((k) + 1)) { xcd_barrier(xbar); } } while (0)
    bf16_t* H = (bf16_t*)P.out; bf16_t* V = (bf16_t*)P.out + (size_t)L_ * D_;
    bf16_t* YG = (bf16_t*)P.out; bf16_t* Y3 = (bf16_t*)P.out + (size_t)L_ * SW_; bf16_t* TMP = (bf16_t*)P.out + (size_t)L_ * D_;
    bf16_t* U = (bf16_t*)(ws + WS_U);

    if (IN(0)) { for (int idx = bid; idx < 1088; idx += nb) do_job(P, smem, idx < 576 ? idx : idx + 256); } SEAM(0);
    if (IN(1)) {
        pg8::Gemm g{H, (const bf16_t*)(ws + WS_WIN), D_, D_, D_}; pg8::StaticOrder S; S.init(L_, INW_, nb, bid);
        EpiG1 E{U, (bf16_t*)(ws + WS_SG), V, (bf16_t*)(ws + WS_W), (bf16_t*)(ws + WS_SR), (bf16_t*)(ws + WS_SC)};
        pg8::gemm_phase(lds, g, S, E);
    } SEAM(1);
    if (IN(2)) {
        const int nbs = nb >= 128 ? 64 : 0;
        if (bid < nbs || nbs == 0) {
            pg8::Gemm g{U, (const bf16_t*)(ws + WS_WST), LDU_, KU_, KU_}; pg8::BatchOrder S{64, nbs ? nbs : nb, bid, 1};
            EpiS1 E{(float*)(ws + WS_SLOC), (unsigned*)(ws + WS_CNT) + 2 * 64 * 64, &P, smem};
            pg8::gemm_phase(lds, g, S, E);
        }
        if (nbs == 0 || bid >= nbs) { phase_z(P, nbs, nb - nbs); for (int idx = bid - nbs; idx < 528; idx += nb - nbs) do_job(P, smem, idx < 512 ? 1344 + idx : 752 + (idx - 512)); }
    } SEAM(2);
    if (IN(3)) {
        const int nbs = nb >= 256 ? 128 : 0;
        if (bid < nbs || nbs == 0) {
            pg8::Gemm g{U, (const bf16_t*)(ws + WS_MC), LDU_, LDU_, LDU_}; pg8::BatchOrder S{128, nbs ? nbs : nb, bid, 2};
            EpiS2 E{YG};
            pg8::gemm_phase(lds, g, S, E);
        }
        if (bid >= nbs || nbs == 0) {
            pg8::Gemm g{(const bf16_t*)(ws + WS_PBF), (const bf16_t*)(ws + WS_WPLE), PLE_, PLE_, PLE_}; pg8::StaticOrder S; S.init(L_, D_, nbs ? nb - nbs : nb, nbs ? bid - nbs : bid);
            EpiStore E{(bf16_t*)(ws + WS_PE), D_};
            pg8::gemm_phase(lds, g, S, E);
            __syncthreads();
            for (int idx = nbs ? bid - nbs : bid; idx < 240; idx += (nbs ? nb - nbs : nb)) do_job(P, smem, 576 + idx + (idx >= 176 ? 16 : 0));
        }
    } SEAM(3);
    if (IN(4)) {
        pg8::Gemm g{YG, (const bf16_t*)(ws + WS_WGLU), SW_, SW_, SW_}; pg8::StaticOrder S; S.init(L_, SW_, nb, bid);
        EpiGlu E{YG, (const bf16_t*)(ws + WS_SG), P.b_glu, Y3};
        pg8::gemm_phase(lds, g, S, E);
    } SEAM(4);
    if (IN(5)) {
        { pg8::Gemm g{Y3, (const bf16_t*)(ws + WS_WSSO), SW_, SW_, SW_}; pg8::StaticOrder S; S.init(L_, D_, nb, bid);
          EpiMerge<0> E{(const bf16_t*)(ws + WS_SR), nullptr, TMP}; pg8::gemm_phase(lds, g, S, E); }
        { pg8::Gemm g{(const bf16_t*)(ws + WS_Z), (const bf16_t*)(ws + WS_WCO), D_, D_, D_}; pg8::StaticOrder S; S.init(L_, D_, nb, bid);
          EpiMerge<1> E{(const bf16_t*)(ws + WS_SC), TMP, (bf16_t*)(ws + WS_MERGED)}; pg8::gemm_phase(lds, g, S, E); }
    } SEAM(5);
    if (IN(6)) {
        pg8::Gemm g{(const bf16_t*)(ws + WS_MERGED), (const bf16_t*)(ws + WS_WO), D_, D_, D_}; pg8::StaticOrder S; S.init(L_, D_, nb, bid);
        EpiX1 E{P.x, P.post_norm, (bf16_t*)(ws + WS_X1BF), PanelX{(float*)(ws + WS_MISC), (unsigned*)(ws + WS_CNT)}}; pg8::gemm_phase(lds, g, S, E);
    } SEAM(6);
    if (IN(7)) {
        pg8::Gemm g{(const bf16_t*)(ws + WS_X1BF), (const bf16_t*)(ws + WS_WG), D_, D_, D_}; pg8::StaticOrder S; S.init(L_, D_, nb, bid);
        EpiOut E{(const bf16_t*)(ws + WS_PE), (const bf16_t*)(ws + WS_X1BF), P.ple_norm, P.out, PanelX{(float*)(ws + WS_MISC + 1 * MiB), (unsigned*)(ws + WS_CNT) + 64 * 64}}; pg8::gemm_phase(lds, g, S, E);
    }
#undef IN
#undef SEAM
}


extern "C" void kernel_launch(void* const* d_in, const int* in_sizes, int n_in, void* d_out, int out_size, void* d_ws, size_t ws_size, hipStream_t stream) {
    constexpr int LDS_BYTES = pg8::STAGE_BYTES + 64 + 4096;
    static int grid = 0;
    if (grid == 0) {
        if (n_in != 22 || out_size != L_ * D_ || ws_size < WS_END) { fprintf(stderr, "kernel_launch: unexpected shapes (n_in %d out %d ws %zu)\n", n_in, out_size, ws_size); grid = -1; return; }
        int dev = 0, cus = 0, per_cu = 0;
        hipGetDevice(&dev); hipDeviceGetAttribute(&cus, hipDeviceAttributeMultiprocessorCount, dev);
        if (hipFuncSetAttribute((const void*)hybrid_fwd, hipFuncAttributeMaxDynamicSharedMemorySize, LDS_BYTES) != hipSuccess) { fprintf(stderr, "kernel_launch: hipFuncSetAttribute failed\n"); grid = -1; return; }
        hipOccupancyMaxActiveBlocksPerMultiprocessor(&per_cu, (const void*)hybrid_fwd, 512, LDS_BYTES);
        (void)hipGetLastError();
        if (per_cu < 1) per_cu = 1;
        grid = cus;
        fprintf(stderr, "kernel_launch: cus %d per_cu %d grid %d\n", cus, per_cu, grid);
    }
    if (grid < 0) return;
    Params P{};
    const float** f = (const float**)&P;
    for (int i = 0; i < 22; ++i) f[i] = (const float*)d_in[i];
    P.out = (float*)d_out; P.ws = (unsigned char*)d_ws;
    (void)hipMemsetAsync((unsigned char*)d_ws + WS_BAR, 0, 16384 + 2 * 64 * 256 + 32 * 256, stream);
#if ONE_LAUNCH
    P.ph_lo = 0; P.ph_hi = NPH;
    void* args[] = {&P};
    hipError_t e = hipLaunchCooperativeKernel((const void*)hybrid_fwd, dim3(grid), dim3(512), args, LDS_BYTES, stream);
    if (e != hipSuccess) fprintf(stderr, "cooperative launch failed: %s (grid %d)\n", hipGetErrorString(e), grid);
#else
    for (int ph = 0; ph < NPH; ++ph) {
        P.ph_lo = ph; P.ph_hi = ph + 1;
        hipLaunchKernelGGL(hybrid_fwd, dim3(grid), dim3(512), LDS_BYTES, stream, P);
    }
#endif
}
```

```cpp
#include <hip/hip_runtime.h>
#include <hip/hip_cooperative_groups.h>
#include <cstdio>
namespace cg = cooperative_groups;

#ifndef ONE_LAUNCH
#define ONE_LAUNCH 1
#endif

#define LAS __attribute__((address_space(3)))
typedef unsigned short bf16_t;
typedef short bf16x8 __attribute__((ext_vector_type(8)));
typedef float f32x4 __attribute__((ext_vector_type(4)));
typedef unsigned u32x4 __attribute__((ext_vector_type(4)));
typedef unsigned u32x2 __attribute__((ext_vector_type(2)));

constexpr int L_ = 16384, D_ = 1024, PLE_ = 256, SW_ = 512, NG_ = 32, CWID_ = 1024, INW_ = 7168;
constexpr int T_ = 32, NCH_ = L_ / T_  , KU_ = T_ * 16  , LDU_ = KU_ + 128  ;
constexpr float EPS_ = 1e-6f;
constexpr size_t MiB = 1024 * 1024;
constexpr size_t WS_WGLU = 0, WS_WSSO = WS_WGLU + 512 * 512 * 2, WS_WCO = WS_WSSO + 1024 * 512 * 2, WS_WO = WS_WCO + 2 * MiB, WS_WPLE = WS_WO + 2 * MiB,
                 WS_WG = WS_WPLE + 1024 * 256 * 2, WS_WIN = 8 * MiB, WS_MC = WS_WIN + 14 * MiB, WS_WST = WS_MC + 20 * MiB, WS_PBF = WS_WST + 8 * MiB,
                 WS_U = WS_PBF + 8 * MiB, WS_SLOC = WS_U + 20 * MiB, WS_SG = WS_SLOC + 8 * MiB, WS_W = WS_SG + 16 * MiB, WS_SR = WS_W + 32 * MiB,
                 WS_SC = WS_SR + 32 * MiB, WS_Z = WS_SC + 32 * MiB, WS_MISC = WS_Z + 32 * MiB, WS_END = WS_MISC + 3 * MiB;
constexpr size_t WS_ABT = WS_MISC + 2 * MiB, WS_BAR = WS_MISC + 2 * MiB + 64 * 1024, WS_CNT = WS_BAR + 16384;
constexpr size_t WS_PE = WS_W, WS_MERGED = WS_MC, WS_O = WS_SR, WS_X1BF = WS_SC, WS_E = WS_Z;
constexpr int NPH = 6;

struct Params {
    const float *x, *p, *pre_norm, *w_in, *a_re, *a_im, *log_step, *b_re, *b_im, *c_re, *c_im, *d_skip, *w_glu, *b_glu, *w_ssm_out, *conv_w, *w_conv_out, *w_o,
        *post_norm, *w_ple, *w_ple_gate, *ple_norm;
    float* out; unsigned char* ws; int ph_lo, ph_hi;
};

typedef __bf16 bf16x2_t __attribute__((ext_vector_type(2)));
typedef float f32x2_t __attribute__((ext_vector_type(2)));
__device__ __forceinline__ unsigned cvt_pk_bf16(float lo, float hi) { f32x2_t v = {lo, hi}; bf16x2_t b = __builtin_convertvector(v, bf16x2_t); return __builtin_bit_cast(unsigned, b); }
__device__ __forceinline__ float bflo(unsigned w) { return __uint_as_float(w << 16); }
__device__ __forceinline__ float bfhi(unsigned w) { return __uint_as_float(w & 0xffff0000u); }
__device__ __forceinline__ f32x4 bf4lo(u32x4 w) { return (f32x4){bflo(w.x), bfhi(w.x), bflo(w.y), bfhi(w.y)}; }
__device__ __forceinline__ f32x4 bf4hi(u32x4 w) { return (f32x4){bflo(w.z), bfhi(w.z), bflo(w.w), bfhi(w.w)}; }
__device__ __forceinline__ u32x4 pack8(f32x4 a, f32x4 b) { u32x4 w; w.x = cvt_pk_bf16(a[0], a[1]); w.y = cvt_pk_bf16(a[2], a[3]); w.z = cvt_pk_bf16(b[0], b[1]); w.w = cvt_pk_bf16(b[2], b[3]); return w; }
typedef __amdgpu_buffer_rsrc_t rsrc_t;
__device__ __forceinline__ void wt16b(const bf16_t* base, size_t elem, u32x4 v) {
    const rsrc_t r = __builtin_amdgcn_make_buffer_rsrc((void*)base, (short)0, 0x7ffffff0, 0x00020000);
    __builtin_amdgcn_raw_buffer_store_b128(v, r, (unsigned)(elem * 2), 0, 16); }
__device__ __forceinline__ void panel_arrive(unsigned* cnt, int pm) { if (threadIdx.x == 0) __hip_atomic_fetch_add(cnt + 64 * pm, 1u, __ATOMIC_RELAXED, __HIP_MEMORY_SCOPE_AGENT); }
__device__ __forceinline__ void panel_wait(unsigned* cnt, int pm, unsigned need) {
    if (threadIdx.x == 0) { unsigned spins = 0;
        while (__hip_atomic_load(cnt + 64 * pm, __ATOMIC_RELAXED, __HIP_MEMORY_SCOPE_AGENT) < need) { __builtin_amdgcn_s_sleep(2); if (++spins > (1u << 21)) break; }
        __builtin_amdgcn_fence(__ATOMIC_ACQUIRE, "agent"); asm volatile("s_waitcnt vmcnt(0)" ::: "memory"); }
    __syncthreads();
}
__device__ __forceinline__ float sigm(float x) { return __builtin_amdgcn_rcpf(1.f + __expf(-x)); }
__device__ __forceinline__ f32x4 sigm4(f32x4 v) { return (f32x4){sigm(v[0]), sigm(v[1]), sigm(v[2]), sigm(v[3])}; }
__device__ __forceinline__ float gelu_t(float x) { return x * sigm(1.5957691216f * (x + 0.044715f * x * x * x)); }
__device__ __forceinline__ f32x4 gelu4(f32x4 v) { return (f32x4){gelu_t(v[0]), gelu_t(v[1]), gelu_t(v[2]), gelu_t(v[3])}; }

#define XB_TMO      128
#define XB_XCNT(j)  (256  + 64 * (j))
#define XB_XSUB(j)  (1280 + 64 * (j))
#define XB_XGEN(j)  (2304 + 64 * (j))
#define XB_TOP      3328
#define XB_TOPGEN   3392
#define XCD_BAR_WORDS 3456
#define XB_SPIN_CAP (1u << 18)
__device__ __forceinline__ unsigned xb_ld(unsigned* p)              { return __hip_atomic_load(p, __ATOMIC_RELAXED, __HIP_MEMORY_SCOPE_AGENT); }
__device__ __forceinline__ unsigned xb_add(unsigned* p, unsigned v) { return __hip_atomic_fetch_add(p, v, __ATOMIC_RELAXED, __HIP_MEMORY_SCOPE_AGENT); }
__device__ __forceinline__ unsigned xb_xcc_id() { return (unsigned)__builtin_amdgcn_s_getreg((3 << 11) | 20) & 0xFu; }
#define XB_SPIN(cond, bar) do { unsigned _sp = 0; while (cond) { __builtin_amdgcn_s_sleep(1); \
    if ((++_sp & 255u) == 0u) { if (xb_ld(&(bar)[XB_TMO])) break; if (_sp > XB_SPIN_CAP) { atomicAdd(&(bar)[XB_TMO], 1u); break; } } } } while (0)

struct XcdBarrier {
    unsigned* bar; unsigned x;
    volatile LAS unsigned* st;
};

__device__ __forceinline__ XcdBarrier xcd_barrier_post(unsigned* bar, volatile LAS unsigned* st) {
    XcdBarrier b; b.bar = bar; b.x = xb_xcc_id(); b.st = st;
    if (threadIdx.x == 0) (void)xb_add(&bar[XB_XCNT(b.x)], 1u);
    return b;
}
__device__ __forceinline__ void xcd_barrier_complete(unsigned* bar, unsigned x, unsigned& nloc, unsigned& nx) {
    const unsigned G = gridDim.x * gridDim.y * gridDim.z;
    unsigned sum, cnt, mine, sp = 0u;
    for (;;) {
        sum = 0u; cnt = 0u; mine = 0u;
#pragma unroll
        for (unsigned j = 0; j < 16; ++j) { const unsigned c = xb_ld(&bar[XB_XCNT(j)]); sum += c; cnt += (c > 0u) ? 1u : 0u; mine = (j == x) ? c : mine; }
        if (sum == G) break;
        __builtin_amdgcn_s_sleep(1);
        if ((++sp & 255u) == 0u) { if (xb_ld(&bar[XB_TMO])) break; if (sp > XB_SPIN_CAP) { atomicAdd(&bar[XB_TMO], 1u); break; } }
    }
    nloc = mine > 0u ? mine : 1u; nx = cnt > 0u ? cnt : 1u;
}

__device__ __forceinline__ void xcd_barrier(const XcdBarrier& b) {
    asm volatile("s_waitcnt vmcnt(0)" ::: "memory");
    __syncthreads();
    if (threadIdx.x == 0) {
        unsigned* bar = b.bar;
        __builtin_amdgcn_s_waitcnt(0);
        unsigned nloc = b.st[0], nx = b.st[1];
        if (nloc == 0u) { xcd_barrier_complete(bar, b.x, nloc, nx); b.st[0] = nloc; b.st[1] = nx; }
        const unsigned old = xb_add(&bar[XB_XSUB(b.x)], 1u);
        const unsigned gen = old / nloc;
        if (old + 1u == (gen + 1u) * nloc) {
            __builtin_amdgcn_fence(__ATOMIC_RELEASE, "agent");
            asm volatile("s_waitcnt vmcnt(0)" ::: "memory");
            const unsigned og = xb_add(&bar[XB_TOP], 1u);
            const unsigned tg = og / nx;
            if (og + 1u == (tg + 1u) * nx) xb_add(&bar[XB_TOPGEN], 1u);
            else XB_SPIN(xb_ld(&bar[XB_TOPGEN]) == tg, bar);
            __builtin_amdgcn_fence(__ATOMIC_ACQUIRE, "agent");
            xb_add(&bar[XB_XGEN(b.x)], 1u);
            asm volatile("s_waitcnt vmcnt(0)" ::: "memory");
        } else {
            XB_SPIN(xb_ld(&bar[XB_XGEN(b.x)]) == gen, bar);
            __builtin_amdgcn_fence(__ATOMIC_ACQUIRE, "agent");
            asm volatile("s_waitcnt vmcnt(0)" ::: "memory");
        }
    }
    __syncthreads();
}

namespace pg8 {
constexpr int BM = 256, BK = 64, HALF = 128, HTB = HALF * BK * 2, STAGE_BYTES = 8 * HTB, NXCD = 8, WGM = 8;
__device__ __forceinline__ int lds_byte(int r, int c) { const int st = (r >> 4) * 2 + (c >> 5), rr = r & 15, cc = c & 31, ob = rr * 64 + cc * 2; return st * 1024 + (ob ^ (((ob >> 9) & 1) << 5)); }
__device__ __forceinline__ void stage_rc(int b, int& R, int& C) { const int st = b / 1024, sb = b % 1024, swz = sb ^ (((sb >> 9) & 1) << 5); R = (st >> 1) * 16 + swz / 64; C = (st & 1) * 32 + (swz % 64) / 2; }
__device__ __forceinline__ int perm32(int rho) { const int n = rho >> 4, i = rho & 15; return 8 * (i >> 2) + 4 * n + (i & 3); }
struct Unit { int pm, pn; };
struct Gemm { const bf16_t* A; const bf16_t* Bt; int lda, ldb, K; };

struct StaticOrder {
    int nM, nN, nwg, G, c;
    __device__ void init(int M, int N, int G_, int c_) { nM = M / BM; nN = N / BM; nwg = nM * nN; G = G_; c = c_; }
    __device__ bool next(int i, Unit& u) const {
        const long Lx = (long)i * G + c; if (c < 0 || Lx >= nwg) return false;
        int wgid = (int)Lx; { const int q = nwg / NXCD, r = nwg % NXCD, xcd = wgid % NXCD, off = wgid / NXCD; wgid = (xcd < r ? xcd * (q + 1) : r * (q + 1) + (xcd - r) * q) + off; }
        const int nig = WGM * nN, gid = wgid / nig, fm = gid * WGM, gsz = (nM - fm) < WGM ? (nM - fm) : WGM;
        u.pm = fm + ((wgid % nig) % gsz); u.pn = (wgid % nig) / gsz; return true;
    }
};
struct BatchOrder {
    int nunits, G, c, mode;
    __device__ bool next(int i, Unit& u) const {
        const int Lx = i * G + c; if (c < 0 || Lx >= nunits) return false;
        const int xcd = Lx & 7, slot = Lx >> 3;
        if (mode == 1) { const int g = xcd * 4 + (slot >> 1); u.pm = 2 * g + (slot & 1); u.pn = g; }
        else { const int g = xcd * 4 + (slot >> 2); u.pm = 2 * g + ((slot >> 1) & 1); u.pn = 2 * g + (slot & 1); }
        return true;
    }
};

template <class Epi, class Sched>
__device__ __forceinline__ void gemm_phase(LAS unsigned char* lds, const Gemm g, const Sched& S, const Epi& E) {
    const int tid = threadIdx.x, wid = __builtin_amdgcn_readfirstlane(tid >> 6), lane = tid & 63, wr = wid >> 2, wc = wid & 3, fr = lane & 15, fq = lane >> 4;
    const int K = g.K, nt = K / BK;
    unsigned voffA[2], voffB[2];
#pragma unroll
    for (int i = 0; i < 2; ++i) { int R, C; stage_rc(tid * 16 + i * 8192, R, C); const int Rb = Epi::PERM ? ((R & ~31) + perm32(R & 31)) : R;
        voffA[i] = (unsigned)(R * g.lda + C) * 2u; voffB[i] = (unsigned)(Rb * g.ldb + C) * 2u; }
    const size_t kstep = (size_t)(BK * 2);
    const size_t hstepA = (size_t)HALF * g.lda * 2, hstepB = (size_t)HALF * g.ldb * 2;
    const size_t tstepA = 2 * hstepA, tstepB = 2 * hstepB;
    const unsigned ldsw = (unsigned)wid * 1024u;
    const int aoff = lds_byte(wr * 64 + fr, fq * 8), boff = lds_byte(wc * 32 + fr, fq * 8);
#define PG8_SA(b, h) (((b) * 2 + (h)) * HTB)
#define PG8_SB(b, h) ((4 + (b) * 2 + (h)) * HTB)
#define PG8_STAGE(bufoff, gbase, voff) do { _Pragma("unroll") for (int _i = 0; _i < 2; ++_i) \
        __builtin_amdgcn_global_load_lds((const unsigned*)((const char*)(gbase) + (voff)[_i]), (LAS unsigned*)(lds + (bufoff) + ldsw + _i * 8192), 16, 0, 0); } while (0)
#define PG8_LDA(dst, b, h) do { _Pragma("unroll") for (int m = 0; m < 4; ++m) _Pragma("unroll") for (int k = 0; k < 2; ++k) dst[m][k] = *(const LAS bf16x8*)(lds + PG8_SA(b, h) + aoff + m * 2048 + k * 1024); } while (0)
#define PG8_LDB(dst, b, h) do { _Pragma("unroll") for (int n = 0; n < 2; ++n) _Pragma("unroll") for (int k = 0; k < 2; ++k) dst[n][k] = *(const LAS bf16x8*)(lds + PG8_SB(b, h) + boff + n * 2048 + k * 1024); } while (0)
#define PG8_MMA(ai, bj, At, Bt) do { __builtin_amdgcn_s_setprio(1); _Pragma("unroll") for (int m = 0; m < 4; ++m) _Pragma("unroll") for (int n = 0; n < 2; ++n) _Pragma("unroll") for (int k = 0; k < 2; ++k) \
        acc[ai][bj][m][n] = __builtin_amdgcn_mfma_f32_16x16x32_bf16(Bt[n][k], At[m][k], acc[ai][bj][m][n], 0, 0, 0); __builtin_amdgcn_s_setprio(0); } while (0)
#define PG8_WAIT_V(n) asm volatile("s_waitcnt vmcnt(" #n ")" ::: "memory")
#define PG8_WAIT_L(n) asm volatile("s_waitcnt lgkmcnt(" #n ")" ::: "memory")
#define PG8_BAR __builtin_amdgcn_s_barrier()
#define PG8_SCHED __builtin_amdgcn_sched_barrier(0)
    Unit cur, nxt; int ui = 0;
    if (!S.next(0, cur)) return;
    f32x4 acc[2][2][4][2];
#pragma unroll
    for (int a = 0; a < 2; ++a)
#pragma unroll
        for (int b = 0; b < 2; ++b)
#pragma unroll
            for (int m = 0; m < 4; ++m)
#pragma unroll
                for (int n = 0; n < 2; ++n) acc[a][b][m][n] = (f32x4){0.f, 0.f, 0.f, 0.f};
    bf16x8 At[4][2], B0[2][2], B1[2][2];
    const char* cA = (const char*)g.A + (size_t)cur.pm * tstepA; const char* cB = (const char*)g.Bt + (size_t)cur.pn * tstepB;
    PG8_STAGE(PG8_SB(0, 0), cB, voffB); PG8_STAGE(PG8_SB(0, 1), cB + hstepB, voffB); PG8_STAGE(PG8_SA(0, 0), cA, voffA); PG8_STAGE(PG8_SA(0, 1), cA + hstepA, voffA);
    if (wr == 1) PG8_BAR;
    PG8_WAIT_V(2); PG8_BAR;
    PG8_STAGE(PG8_SB(1, 0), cB + kstep, voffB); PG8_STAGE(PG8_SA(1, 0), cA + kstep, voffA); PG8_STAGE(PG8_SB(1, 1), cB + hstepB + kstep, voffB);
    PG8_WAIT_V(6); PG8_BAR;
    for (;;) {
        const bool has_next = S.next(ui + 1, nxt);
        const char* nA = has_next ? (const char*)g.A + (size_t)nxt.pm * tstepA : cA; const char* nB = has_next ? (const char*)g.Bt + (size_t)nxt.pn * tstepB : cB;
#pragma unroll 1
        for (int t = 0; t < nt; t += 2) {
            const bool last = (t == nt - 2);
            const char* a1 = cA + (size_t)(t + 1) * kstep;
            const char* a2 = last ? nA : cA + (size_t)(t + 2) * kstep; const char* b2 = last ? nB : cB + (size_t)(t + 2) * kstep;
            const char* a3 = a2 + kstep; const char* b3 = b2 + kstep;
            PG8_LDB(B0, 0, 0); PG8_LDB(B1, 0, 1); PG8_SCHED; PG8_LDA(At, 0, 0); PG8_STAGE(PG8_SA(1, 1), a1 + hstepA, voffA);
            PG8_WAIT_V(8); PG8_WAIT_L(0); PG8_BAR; PG8_MMA(0, 0, At, B0); PG8_MMA(0, 1, At, B1); PG8_BAR; PG8_SCHED;
            PG8_LDA(At, 0, 1); PG8_STAGE(PG8_SB(0, 0), b2, voffB); PG8_STAGE(PG8_SB(0, 1), b2 + hstepB, voffB); PG8_STAGE(PG8_SA(0, 0), a2, voffA);
            PG8_WAIT_V(8); PG8_WAIT_L(0); PG8_BAR; PG8_MMA(1, 0, At, B0); PG8_MMA(1, 1, At, B1); PG8_BAR; PG8_SCHED;
            PG8_LDB(B0, 1, 0); PG8_LDB(B1, 1, 1); PG8_SCHED; PG8_LDA(At, 1, 0); PG8_STAGE(PG8_SA(0, 1), a2 + hstepA, voffA);
            PG8_WAIT_V(8); PG8_WAIT_L(0); PG8_BAR; PG8_MMA(0, 0, At, B0); PG8_MMA(0, 1, At, B1); PG8_BAR; PG8_SCHED;
            PG8_LDA(At, 1, 1); PG8_STAGE(PG8_SB(1, 0), b3, voffB); PG8_STAGE(PG8_SB(1, 1), b3 + hstepB, voffB); PG8_STAGE(PG8_SA(1, 0), a3, voffA);
            PG8_WAIT_V(8); PG8_WAIT_L(0); PG8_BAR; PG8_MMA(1, 0, At, B0); PG8_MMA(1, 1, At, B1); PG8_BAR; PG8_SCHED;
        }
        if (wr == 0) PG8_BAR;
        if constexpr (!Epi::AFTER_DRAIN) E(acc, cur, wr, wc, fr, fq);
        if (!has_next) break;
#pragma unroll
        for (int a = 0; a < 2; ++a)
#pragma unroll
            for (int b = 0; b < 2; ++b)
#pragma unroll
                for (int m = 0; m < 4; ++m)
#pragma unroll
                    for (int n = 0; n < 2; ++n) acc[a][b][m][n] = (f32x4){0.f, 0.f, 0.f, 0.f};
        cur = nxt; cA = nA; cB = nB; ++ui;
        if (wr == 1) PG8_BAR;
    }
    PG8_WAIT_V(0);
    PG8_BAR;
    if constexpr (Epi::AFTER_DRAIN) E(acc, cur, wr, wc, fr, fq);
#undef PG8_SA
#undef PG8_SB
#undef PG8_STAGE
#undef PG8_LDA
#undef PG8_LDB
#undef PG8_MMA
#undef PG8_WAIT_V
#undef PG8_WAIT_L
#undef PG8_BAR
#undef PG8_SCHED
}
}
using pg8::Unit;
typedef f32x4 Acc[2][2][4][2];

#define EPI_ROWS(...) _Pragma("unroll") for (int ai = 0; ai < 2; ++ai) _Pragma("unroll") for (int m = 0; m < 4; ++m) { const int row = row0 + ai * 128 + m * 16; __VA_ARGS__ }

struct EpiG1 {
    static constexpr bool PERM = true, AFTER_DRAIN = false;
    bf16_t *U, *SG, *V, *W, *SR, *SC;
    __device__ __forceinline__ void operator()(const Acc& acc, const Unit& u, int wr, int wc, int fr, int fq) const {
        const int row0 = u.pm * 256 + wr * 64 + fr, cw = wc * 32 + 8 * fq, pn = u.pn;
        if (pn < 2) {
            EPI_ROWS(
                const int c = row >> 5, tt = row & 31;
                _Pragma("unroll") for (int bj = 0; bj < 2; ++bj) { const int col = pn * 256 + bj * 128 + cw; const int g = col >> 4, h0 = col & 15;
                    *(u32x4*)(U + ((size_t)(g * NCH_ + c)) * LDU_ + tt * 16 + h0) = pack8(acc[ai][bj][m][0], acc[ai][bj][m][1]); } )
        } else if (pn < 4) {
            EPI_ROWS(
                _Pragma("unroll") for (int bj = 0; bj < 2; ++bj) { const int col = (pn - 2) * 256 + bj * 128 + cw; const f32x4 a = acc[ai][bj][m][0], b = acc[ai][bj][m][1];
                    *(u32x4*)(SG + (size_t)row * SW_ + col) = pack8(a * sigm4(a), b * sigm4(b)); } )
        } else if (pn < 12) {
            EPI_ROWS(
                const int col = (pn - 4) * 128 + cw;
                *(u32x4*)(V + (size_t)row * CWID_ + col) = pack8(acc[ai][0][m][0] * acc[ai][1][m][0], acc[ai][0][m][1] * acc[ai][1][m][1]); )
        } else if (pn < 20) {
            EPI_ROWS(
                const int col = (pn - 12) * 128 + cw; const f32x4 ga = acc[ai][1][m][0], gb = acc[ai][1][m][1];
                *(u32x4*)(W + (size_t)row * CWID_ + col) = pack8(acc[ai][0][m][0] * (ga * sigm4(ga)), acc[ai][0][m][1] * (gb * sigm4(gb))); )
        } else {
            bf16_t* dst = pn < 24 ? SR : SC; const int pb = pn < 24 ? pn - 20 : pn - 24;
            EPI_ROWS(
                _Pragma("unroll") for (int bj = 0; bj < 2; ++bj) { const int col = pb * 256 + bj * 128 + cw;
                    *(u32x4*)(dst + (size_t)row * D_ + col) = pack8(acc[ai][bj][m][0], acc[ai][bj][m][1]); } )
        }
    }
};
__device__ void carry_group(const Params& P, int g, unsigned char* smem);
struct EpiS1 {
    static constexpr bool PERM = false, AFTER_DRAIN = true;
    float* SLOC; unsigned* gcnt; const Params* P; unsigned char* smem;
    __device__ __forceinline__ void operator()(const Acc& acc, const Unit& u, int wr, int wc, int fr, int fq) const {
        const int row0 = u.pm * 256 + wr * 64 + fr;
        EPI_ROWS(
            float* rp = SLOC + (size_t)row * 128 + wc * 32 + 4 * fq; *(f32x4*)rp = acc[ai][0][m][0]; *(f32x4*)(rp + 16) = acc[ai][0][m][1]; )
        asm volatile("s_waitcnt vmcnt(0)" ::: "memory");
        __syncthreads();
        unsigned* flag = (unsigned*)smem;
        if (threadIdx.x == 0) {
            __builtin_amdgcn_fence(__ATOMIC_RELEASE, "agent");
            asm volatile("s_waitcnt vmcnt(0)" ::: "memory");
            const unsigned old = __hip_atomic_fetch_add(gcnt + 64 * u.pn, 1u, __ATOMIC_RELAXED, __HIP_MEMORY_SCOPE_AGENT);
            if (old == 1u) { __builtin_amdgcn_fence(__ATOMIC_ACQUIRE, "agent"); asm volatile("s_waitcnt vmcnt(0)" ::: "memory"); }
            flag[0] = old;
        }
        __syncthreads();
        const unsigned old = flag[0];
        __syncthreads();
        if (old == 1u) carry_group(*P, u.pn, smem);
    }
};
struct EpiS2 {
    static constexpr bool PERM = true, AFTER_DRAIN = false;
    bf16_t* YG;
    __device__ __forceinline__ void operator()(const Acc& acc, const Unit& u, int wr, int wc, int fr, int fq) const {
        const int g = u.pm >> 1, c0 = (u.pm & 1) * 256 + wr * 64 + fr, n0 = (u.pn & 1) * 256 + wc * 32 + 8 * fq;
#pragma unroll
        for (int ai = 0; ai < 2; ++ai)
#pragma unroll
            for (int m = 0; m < 4; ++m) { const int c = c0 + ai * 128 + m * 16;
#pragma unroll
                for (int bj = 0; bj < 2; ++bj) { const int n = n0 + bj * 128, t = n >> 4, h0 = n & 15;
                    *(u32x4*)(YG + (size_t)(c * T_ + t) * SW_ + g * 16 + h0) = pack8(gelu4(acc[ai][bj][m][0]), gelu4(acc[ai][bj][m][1])); } }
    }
};
struct EpiStore {
    static constexpr bool PERM = true, AFTER_DRAIN = false;
    bf16_t* O; int ldc;
    __device__ __forceinline__ void operator()(const Acc& acc, const Unit& u, int wr, int wc, int fr, int fq) const {
        const int row0 = u.pm * 256 + wr * 64 + fr, col0 = u.pn * 256 + wc * 32 + 8 * fq;
        EPI_ROWS(
            _Pragma("unroll") for (int bj = 0; bj < 2; ++bj) *(u32x4*)(O + (size_t)row * ldc + col0 + bj * 128) = pack8(acc[ai][bj][m][0], acc[ai][bj][m][1]); )
    }
};
struct EpiGlu {
    static constexpr bool PERM = true, AFTER_DRAIN = false;
    const bf16_t *YG, *SG; const float* bglu; bf16_t* Y3;
    __device__ __forceinline__ void operator()(const Acc& acc, const Unit& u, int wr, int wc, int fr, int fq) const {
        const int row0 = u.pm * 256 + wr * 64 + fr, col0 = u.pn * 256 + wc * 32 + 8 * fq;
        f32x4 b0[2], b1[2];
#pragma unroll
        for (int bj = 0; bj < 2; ++bj) { b0[bj] = *(const f32x4*)(bglu + col0 + bj * 128); b1[bj] = *(const f32x4*)(bglu + col0 + bj * 128 + 4); }
#pragma unroll
        for (int ai = 0; ai < 2; ++ai) {
            u32x4 yw[4][2], sw[4][2];
#pragma unroll
            for (int m = 0; m < 4; ++m)
#pragma unroll
                for (int bj = 0; bj < 2; ++bj) { const size_t off = (size_t)(row0 + ai * 128 + m * 16) * SW_ + col0 + bj * 128; yw[m][bj] = *(const u32x4*)(YG + off); sw[m][bj] = *(const u32x4*)(SG + off); }
#pragma unroll
            for (int m = 0; m < 4; ++m)
#pragma unroll
                for (int bj = 0; bj < 2; ++bj) { const size_t off = (size_t)(row0 + ai * 128 + m * 16) * SW_ + col0 + bj * 128;
                    wt16b(Y3, off, pack8(bf4lo(yw[m][bj]) * sigm4(acc[ai][bj][m][0] + b0[bj]) * bf4lo(sw[m][bj]), bf4hi(yw[m][bj]) * sigm4(acc[ai][bj][m][1] + b1[bj]) * bf4hi(sw[m][bj]))); }
        }
    }
};
template <int MODE> struct EpiMerge {
    static constexpr bool PERM = true, AFTER_DRAIN = false;
    const bf16_t *S, *TMPI; bf16_t* O;
    __device__ __forceinline__ void operator()(const Acc& acc, const Unit& u, int wr, int wc, int fr, int fq) const {
        const int row0 = u.pm * 256 + wr * 64 + fr, col0 = u.pn * 256 + wc * 32 + 8 * fq;
#pragma unroll
        for (int ai = 0; ai < 2; ++ai) {
            u32x4 sw[4][2], tw[4][2];
#pragma unroll
            for (int m = 0; m < 4; ++m)
#pragma unroll
                for (int bj = 0; bj < 2; ++bj) { const size_t off = (size_t)(row0 + ai * 128 + m * 16) * D_ + col0 + bj * 128; sw[m][bj] = *(const u32x4*)(S + off); if (MODE == 1) tw[m][bj] = *(const u32x4*)(TMPI + off); }
#pragma unroll
            for (int m = 0; m < 4; ++m)
#pragma unroll
                for (int bj = 0; bj < 2; ++bj) { const size_t off = (size_t)(row0 + ai * 128 + m * 16) * D_ + col0 + bj * 128;
                    f32x4 a = sigm4(bf4lo(sw[m][bj])) * acc[ai][bj][m][0], b = sigm4(bf4hi(sw[m][bj])) * acc[ai][bj][m][1];
                    if (MODE == 1) { a += bf4lo(tw[m][bj]); b += bf4hi(tw[m][bj]); }
                    if (MODE == 1) wt16b(O, off, pack8(a, b)); else *(u32x4*)(O + off) = pack8(a, b); }
        }
    }
};
struct PanelX { float* part; unsigned* cnt; };
__device__ __forceinline__ void panel_rstd(const PanelX& px, const Unit& u, int wr, int wc, int fr, int fq, float (&s)[2][4]) {
    const int row0 = u.pm * 256 + wr * 64 + fr;
#pragma unroll
    for (int ai = 0; ai < 2; ++ai)
#pragma unroll
        for (int m = 0; m < 4; ++m) { float t = s[ai][m]; t += __shfl_xor(t, 16); t += __shfl_xor(t, 32);
            if (fq == 0) __hip_atomic_store(px.part + (size_t)(row0 + ai * 128 + m * 16) * 16 + u.pn * 4 + wc, t, __ATOMIC_RELAXED, __HIP_MEMORY_SCOPE_AGENT); }
    asm volatile("s_waitcnt vmcnt(0)" ::: "memory");
    __builtin_amdgcn_s_barrier();
    if (threadIdx.x == 0) {
        unsigned* c = px.cnt + 64 * u.pm;
        __hip_atomic_fetch_add(c, 1u, __ATOMIC_RELAXED, __HIP_MEMORY_SCOPE_AGENT);
        unsigned spins = 0;
        while (__hip_atomic_load(c, __ATOMIC_RELAXED, __HIP_MEMORY_SCOPE_AGENT) < 4u) { __builtin_amdgcn_s_sleep(4); if (++spins > (1u << 20)) break; }
    }
    asm volatile("s_waitcnt vmcnt(0) lgkmcnt(0)" ::: "memory");
    __builtin_amdgcn_s_barrier();
    asm volatile("" ::: "memory");
    __builtin_amdgcn_fence(__ATOMIC_ACQUIRE, "agent");
    asm volatile("s_waitcnt vmcnt(0)" ::: "memory");
#pragma unroll
    for (int ai = 0; ai < 2; ++ai)
#pragma unroll
        for (int m = 0; m < 4; ++m) { float* q = px.part + (size_t)(row0 + ai * 128 + m * 16) * 16 + fq * 4;
            const float q0 = __hip_atomic_load(q, __ATOMIC_RELAXED, __HIP_MEMORY_SCOPE_AGENT), q1 = __hip_atomic_load(q + 1, __ATOMIC_RELAXED, __HIP_MEMORY_SCOPE_AGENT),
                        q2 = __hip_atomic_load(q + 2, __ATOMIC_RELAXED, __HIP_MEMORY_SCOPE_AGENT), q3 = __hip_atomic_load(q + 3, __ATOMIC_RELAXED, __HIP_MEMORY_SCOPE_AGENT);
            float t = (q0 + q1) + (q2 + q3); t += __shfl_xor(t, 16); t += __shfl_xor(t, 32);
            s[ai][m] = rsqrtf(t * (1.0f / D_) + EPS_); }
}
__device__ __forceinline__ float sq8(f32x4 a, f32x4 b) { return ((a[0] * a[0] + a[1] * a[1]) + (a[2] * a[2] + a[3] * a[3])) + ((b[0] * b[0] + b[1] * b[1]) + (b[2] * b[2] + b[3] * b[3])); }
struct EpiX1 {
    static constexpr bool PERM = true, AFTER_DRAIN = true;
    const float *x, *gain; bf16_t* X1B; PanelX px;
    __device__ __forceinline__ void operator()(Acc& acc, const Unit& u, int wr, int wc, int fr, int fq) const {
        const int row0 = u.pm * 256 + wr * 64 + fr, col0 = u.pn * 256 + wc * 32 + 8 * fq;
        float s[2][4];
#pragma unroll
        for (int ai = 0; ai < 2; ++ai)
#pragma unroll
            for (int m = 0; m < 4; ++m) s[ai][m] = sq8(acc[ai][0][m][0], acc[ai][0][m][1]) + sq8(acc[ai][1][m][0], acc[ai][1][m][1]);
        panel_rstd(px, u, wr, wc, fr, fq, s);
        f32x4 g0[2], g1[2];
#pragma unroll
        for (int bj = 0; bj < 2; ++bj) { g0[bj] = *(const f32x4*)(gain + col0 + bj * 128); g1[bj] = *(const f32x4*)(gain + col0 + bj * 128 + 4); }
#pragma unroll
        for (int ai = 0; ai < 2; ++ai) {
            f32x4 xa[4][2], xb[4][2];
#pragma unroll
            for (int m = 0; m < 4; ++m)
#pragma unroll
                for (int bj = 0; bj < 2; ++bj) { const size_t off = (size_t)(row0 + ai * 128 + m * 16) * D_ + col0 + bj * 128; xa[m][bj] = *(const f32x4*)(x + off); xb[m][bj] = *(const f32x4*)(x + off + 4); }
#pragma unroll
            for (int m = 0; m < 4; ++m) { const float rs = s[ai][m];
#pragma unroll
                for (int bj = 0; bj < 2; ++bj) { const size_t off = (size_t)(row0 + ai * 128 + m * 16) * D_ + col0 + bj * 128;
                    const f32x4 ya = xa[m][bj] + acc[ai][bj][m][0] * rs * g0[bj], yb = xb[m][bj] + acc[ai][bj][m][1] * rs * g1[bj];
                    *(u32x4*)(X1B + off) = pack8(ya, yb); } }
        }
    }
};
struct EpiOut {
    static constexpr bool PERM = true, AFTER_DRAIN = true;
    const bf16_t *PE, *X1B; const float* gain; float* OUT; PanelX px;
    __device__ __forceinline__ void operator()(Acc& acc, const Unit& u, int wr, int wc, int fr, int fq) const {
        const int row0 = u.pm * 256 + wr * 64 + fr, col0 = u.pn * 256 + wc * 32 + 8 * fq;
        float s[2][4];
#pragma unroll
        for (int ai = 0; ai < 2; ++ai) {
            u32x4 pw[4][2];
#pragma unroll
            for (int m = 0; m < 4; ++m)
#pragma unroll
                for (int bj = 0; bj < 2; ++bj) pw[m][bj] = *(const u32x4*)(PE + (size_t)(row0 + ai * 128 + m * 16) * D_ + col0 + bj * 128);
#pragma unroll
            for (int m = 0; m < 4; ++m) { float t = 0.f;
#pragma unroll
                for (int bj = 0; bj < 2; ++bj) { acc[ai][bj][m][0] = bf4lo(pw[m][bj]) * sigm4(acc[ai][bj][m][0]); acc[ai][bj][m][1] = bf4hi(pw[m][bj]) * sigm4(acc[ai][bj][m][1]);
                    t += sq8(acc[ai][bj][m][0], acc[ai][bj][m][1]); }
                s[ai][m] = t; }
        }
        panel_rstd(px, u, wr, wc, fr, fq, s);
        f32x4 g0[2], g1[2];
#pragma unroll
        for (int bj = 0; bj < 2; ++bj) { g0[bj] = *(const f32x4*)(gain + col0 + bj * 128); g1[bj] = *(const f32x4*)(gain + col0 + bj * 128 + 4); }
#pragma unroll
        for (int ai = 0; ai < 2; ++ai) {
            u32x4 xw[4][2];
#pragma unroll
            for (int m = 0; m < 4; ++m)
#pragma unroll
                for (int bj = 0; bj < 2; ++bj) xw[m][bj] = *(const u32x4*)(X1B + (size_t)(row0 + ai * 128 + m * 16) * D_ + col0 + bj * 128);
#pragma unroll
            for (int m = 0; m < 4; ++m) { const float rs = s[ai][m];
#pragma unroll
                for (int bj = 0; bj < 2; ++bj) { const size_t off = (size_t)(row0 + ai * 128 + m * 16) * D_ + col0 + bj * 128;
                    *(f32x4*)(OUT + off) = bf4lo(xw[m][bj]) + acc[ai][bj][m][0] * rs * g0[bj]; *(f32x4*)(OUT + off + 4) = bf4hi(xw[m][bj]) + acc[ai][bj][m][1] * rs * g1[bj]; } }
        }
    }
};

__device__ __forceinline__ void tconv_tile(const float* __restrict__ src, int lds_, int sc0, int k0, bf16_t* __restrict__ dst, int ldd, int n0, float* tile  ) {
    const int tid = threadIdx.x;
    { const int nn = tid & 63, kb = tid >> 6; const float* pp = src + (size_t)(k0 + kb) * lds_ + sc0 + nn; const size_t step = (size_t)8 * lds_;
#pragma unroll 1
      for (int hb = 0; hb < 2; ++hb) { float v[16];
#pragma unroll
        for (int i = 0; i < 16; ++i) { v[i] = *pp; pp += step; }
#pragma unroll
        for (int i = 0; i < 16; ++i) tile[(kb + 8 * (hb * 16 + i)) * 65 + nn] = v[i]; } }
    __syncthreads();
#pragma unroll
    for (int i = 0; i < 4; ++i) { const int pidx = tid + 512 * i, kk2 = (pidx & 31) * 8, nn2 = pidx >> 5;
      f32x4 a, b;
#pragma unroll
      for (int j = 0; j < 4; ++j) { a[j] = tile[(kk2 + j) * 65 + nn2]; b[j] = tile[(kk2 + 4 + j) * 65 + nn2]; }
      *(u32x4*)(dst + (size_t)(n0 + nn2) * ldd + k0 + kk2) = pack8(a, b); }
    __syncthreads();
}
__device__ __forceinline__ int win_srccol(int n0) {
    const int pn = n0 >> 8, j = n0 & 255;
    if (pn < 2) return 256 * pn + j;
    if (pn < 4) return 512 + 256 * (pn - 2) + j;
    if (pn < 12) { const int i = pn - 4; return j < 128 ? 1024 + 128 * i + j : 3072 + 128 * i + (j - 128); }
    if (pn < 20) { const int i = pn - 12; return j < 128 ? 2048 + 128 * i + j : 4096 + 128 * i + (j - 128); }
    if (pn < 24) return 5120 + 256 * (pn - 20) + j;
    return 6144 + 256 * (pn - 24) + j;
}
__device__ void ssm_prep(const Params& P, int g, int r, unsigned char* smem) {
    float2* s_ab = (float2*)smem;
    float2* s_Bb = s_ab + 64;
    float2* s_C = s_Bb + 1024;
    float2* s_pw = s_C + 1024;
    float* s_Kd = (float*)(s_pw + 64 * 33);
    const int tid = threadIdx.x;
    bf16_t* MC = (bf16_t*)(P.ws + WS_MC); bf16_t* WST = (bf16_t*)(P.ws + WS_WST); float2* abT = (float2*)(P.ws + WS_ABT);
    if (tid < 64) {
        const int p = tid; const float dt = expf(P.log_step[g]); const float ar = P.a_re[g * 64 + p], ai = P.a_im[g * 64 + p];
        const float mag = expf(ar * dt), th = ai * dt; const float abr = mag * cosf(th), abi = mag * sinf(th);
        const float den = ar * ar + ai * ai, nr = abr - 1.0f; const float fr = (nr * ar + abi * ai) / den, fi = (abi * ar - nr * ai) / den;
        s_ab[p] = make_float2(abr, abi);
#pragma unroll 1
        for (int h = 0; h < 16; ++h) { const float br = P.b_re[(g * 64 + p) * 16 + h], bi = P.b_im[(g * 64 + p) * 16 + h]; s_Bb[p * 16 + h] = make_float2(fr * br - fi * bi, fr * bi + fi * br); }
        float cr = 1.f, ci = 0.f;
#pragma unroll 1
        for (int d = 0; d <= T_; ++d) { s_pw[p * 33 + d] = make_float2(cr, ci); const float nr2 = cr * abr - ci * abi, ni2 = cr * abi + ci * abr; cr = nr2; ci = ni2; }
        if (r == 0) abT[g * 64 + p] = s_pw[p * 33 + T_];
    }
    for (int i = tid; i < 1024; i += 512) { const int h = i >> 6, p = i & 63; s_C[i] = make_float2(P.c_re[(g * 16 + h) * 64 + p], P.c_im[(g * 16 + h) * 64 + p]); }
    __syncthreads();
#pragma unroll 1
    for (int i = 0; i < 4; ++i) { const int idx = tid + 512 * i, d = idx >> 6, hh = (idx >> 4) & 3, hp = idx & 15, h = 4 * r + hh; float a = 0.f;
#pragma unroll 4
        for (int p = 0; p < 64; ++p) { const float2 c = s_C[h * 64 + p], w = s_pw[p * 33 + d], b = s_Bb[p * 16 + hp]; const float xr = c.x * w.x - c.y * w.y, xi = c.x * w.y + c.y * w.x; a += xr * b.x - xi * b.y; }
        if (d == 0 && h == hp) a += P.d_skip[g * 16 + h];
        s_Kd[idx] = a; }
    __syncthreads();
#pragma unroll 1
    for (int i = 0; i < 20; ++i) { const int pidx = tid + 512 * i, rowi = pidx / 80, col8 = (pidx % 80) * 8, t = rowi >> 2, hh = rowi & 3, h = 4 * r + hh;
        f32x4 a = {0.f, 0.f, 0.f, 0.f}, b = {0.f, 0.f, 0.f, 0.f};
        if (col8 < KU_) { const int k = col8 >> 4, h0 = col8 & 15;
            if (k <= t) { const float* kd = s_Kd + (t - k) * 64 + hh * 16 + h0; a = (f32x4){kd[0], kd[1], kd[2], kd[3]}; b = (f32x4){kd[4], kd[5], kd[6], kd[7]}; } }
        else { const int q0 = col8 - KU_, im = q0 >= 64, p0 = q0 & 63;
#pragma unroll
            for (int j = 0; j < 8; ++j) { const float2 c = s_C[h * 64 + p0 + j], w = s_pw[(p0 + j) * 33 + t + 1]; const float v = im ? -(c.x * w.y + c.y * w.x) : (c.x * w.x - c.y * w.y); if (j < 4) a[j] = v; else b[j - 4] = v; } }
        *(u32x4*)(MC + ((size_t)(g * KU_ + t * 16 + h)) * LDU_ + col8) = pack8(a, b); }
#pragma unroll 1
    for (int i = 0; i < 4; ++i) { const int pidx = tid + 512 * i, q = 32 * r + (pidx >> 6), col8 = (pidx & 63) * 8, k = col8 >> 4, h0 = col8 & 15, p = q & 63, im = q >= 64;
        const float2 w = s_pw[p * 33 + (T_ - 1 - k)]; f32x4 a, b;
#pragma unroll
        for (int j = 0; j < 8; ++j) { const float2 bb = s_Bb[p * 16 + h0 + j]; const float v = im ? (w.x * bb.y + w.y * bb.x) : (w.x * bb.x - w.y * bb.y); if (j < 4) a[j] = v; else b[j - 4] = v; }
        *(u32x4*)(WST + ((size_t)(g * 256 + q)) * KU_ + col8) = pack8(a, b); }
    __syncthreads();
}

__device__ __forceinline__ void do_job(const Params& P, unsigned char* smem, int job) {
    const int tid = threadIdx.x;
    unsigned char* ws = P.ws;
    constexpr int J_SSM = 128, J_TC = 704, J_RMS = 512;
    {
        int j = job;
        if (j < J_SSM) { ssm_prep(P, j >> 2, j & 3, smem); return; }
        j -= J_SSM;
        if (j < J_TC) {
            const float* src; bf16_t* dst; int K, N, off; bool perm = false;
            if (j < 448) { src = P.w_in; dst = (bf16_t*)(ws + WS_WIN); K = 1024; N = INW_; perm = true; }
            else if ((off = j - 448) < 16) { j = off; src = P.w_glu; dst = (bf16_t*)(ws + WS_WGLU); K = 512; N = 512; }
            else if ((off = j - 464) < 32) { j = off; src = P.w_ssm_out; dst = (bf16_t*)(ws + WS_WSSO); K = 512; N = 1024; }
            else if ((off = j - 496) < 64) { j = off; src = P.w_conv_out; dst = (bf16_t*)(ws + WS_WCO); K = 1024; N = 1024; }
            else if ((off = j - 560) < 64) { j = off; src = P.w_o; dst = (bf16_t*)(ws + WS_WO); K = 1024; N = 1024; }
            else if ((off = j - 624) < 16) { j = off; src = P.w_ple; dst = (bf16_t*)(ws + WS_WPLE); K = 256; N = 1024; }
            else { j = j - 640; src = P.w_ple_gate; dst = (bf16_t*)(ws + WS_WG); K = 1024; N = 1024; }
            const int nkt = K >> 8, ntile = j / nkt, ktile = j % nkt, n0 = ntile * 64, k0 = ktile * 256;
            const int sc0 = perm ? win_srccol(n0) : n0;
            tconv_tile(src, N, sc0, k0, dst, K, n0, (float*)smem);
            return;
        }
        j -= J_TC;
        if (j < J_RMS) {
            const int lane = tid & 63, rowb = j * 32 + (tid >> 6) * 4;
            f32x4 v[4][4]; float s[4];
#pragma unroll
            for (int rr = 0; rr < 4; ++rr)
#pragma unroll
                for (int i = 0; i < 4; ++i) v[rr][i] = *(const f32x4*)(P.x + (size_t)(rowb + rr) * D_ + i * 256 + lane * 4);
#pragma unroll
            for (int rr = 0; rr < 4; ++rr) { float t = 0.f;
#pragma unroll
                for (int i = 0; i < 4; ++i) t += (v[rr][i][0] * v[rr][i][0] + v[rr][i][1] * v[rr][i][1]) + (v[rr][i][2] * v[rr][i][2] + v[rr][i][3] * v[rr][i][3]);
#pragma unroll
                for (int o = 32; o >= 1; o >>= 1) t += __shfl_xor(t, o);
                s[rr] = rsqrtf(t * (1.0f / D_) + EPS_); }
#pragma unroll
            for (int i = 0; i < 4; ++i) { const f32x4 gn = *(const f32x4*)(P.pre_norm + i * 256 + lane * 4);
#pragma unroll
                for (int rr = 0; rr < 4; ++rr) { const f32x4 y = v[rr][i] * s[rr] * gn; u32x2 w; w.x = cvt_pk_bf16(y[0], y[1]); w.y = cvt_pk_bf16(y[2], y[3]);
                    *(u32x2*)((bf16_t*)P.out + (size_t)(rowb + rr) * D_ + i * 256 + lane * 4) = w; } }
            return;
        }
        j -= J_RMS;
        {
            const size_t e0 = (size_t)j * 8192 + tid * 8;
            const f32x4 a0 = *(const f32x4*)(P.p + e0), b0 = *(const f32x4*)(P.p + e0 + 4), a1 = *(const f32x4*)(P.p + e0 + 4096), b1 = *(const f32x4*)(P.p + e0 + 4100);
            *(u32x4*)((bf16_t*)(ws + WS_PBF) + e0) = pack8(a0, b0); *(u32x4*)((bf16_t*)(ws + WS_PBF) + e0 + 4096) = pack8(a1, b1);
        }
    }
}

__device__ void phase_z(const Params& P, int b0, int nbz) {
    const bf16_t* V = (const bf16_t*)P.out + (size_t)L_ * D_;
    const bf16_t* W = (const bf16_t*)(P.ws + WS_W); bf16_t* Z = (bf16_t*)(P.ws + WS_Z);
    const int nthreads = nbz * 512;
    for (int idx = (blockIdx.x - b0) * 512 + threadIdx.x; idx < (L_ / 16) * 128; idx += nthreads) {
        const int oct = idx & 127, tb = idx >> 7, t0 = tb * 16, c0 = oct * 8;
        const f32x4 k0a = *(const f32x4*)(P.conv_w + c0), k0b = *(const f32x4*)(P.conv_w + c0 + 4);
        const f32x4 k1a = *(const f32x4*)(P.conv_w + CWID_ + c0), k1b = *(const f32x4*)(P.conv_w + CWID_ + c0 + 4);
        const f32x4 k2a = *(const f32x4*)(P.conv_w + 2 * CWID_ + c0), k2b = *(const f32x4*)(P.conv_w + 2 * CWID_ + c0 + 4);
        f32x4 m2a = {0.f, 0.f, 0.f, 0.f}, m2b = m2a, m1a = m2a, m1b = m2a;
        if (t0 > 0) { const u32x4 w2 = *(const u32x4*)(V + (size_t)(t0 - 2) * CWID_ + c0), w1 = *(const u32x4*)(V + (size_t)(t0 - 1) * CWID_ + c0);
            m2a = bf4lo(w2); m2b = bf4hi(w2); m1a = bf4lo(w1); m1b = bf4hi(w1); }
#pragma unroll
        for (int t = 0; t < 16; ++t) { const size_t off = (size_t)(t0 + t) * CWID_ + c0;
            const u32x4 vw = *(const u32x4*)(V + off), ww = *(const u32x4*)(W + off);
            const f32x4 va = bf4lo(vw), vb = bf4hi(vw);
            const f32x4 ca = k0a * m2a + k1a * m1a + k2a * va, cb = k0b * m2b + k1b * m1b + k2b * vb;
            *(u32x4*)(Z + off) = pack8(bf4lo(ww) * ca, bf4hi(ww) * cb);
            m2a = m1a; m2b = m1b; m1a = va; m1b = vb; }
    }
}
__device__ void carry_group(const Params& P, int g, unsigned char* smem) {
    const float2* abT = (const float2*)(P.ws + WS_ABT); const float* SLOC = (const float*)(P.ws + WS_SLOC); bf16_t* U = (bf16_t*)(P.ws + WS_U);
    float* sl = (float*)smem; unsigned* slw = (unsigned*)smem;
    float2* seg = (float2*)(smem + pg8::STAGE_BYTES + 64);
    const int tid = threadIdx.x, w = tid >> 6, p = tid & 63;
    const float2 a = abT[g * 64 + p];
    float2 a32 = a;
#pragma unroll
    for (int i = 0; i < 5; ++i) a32 = make_float2(a32.x * a32.x - a32.y * a32.y, 2.f * a32.x * a32.y);
    float sr = 0.f, si = 0.f;
    for (int half = 0; half < 2; ++half) {
        const f32x4* src = (const f32x4*)(SLOC + (size_t)(g * NCH_ + half * 256) * 128);
#pragma unroll
        for (int i = 0; i < 16; ++i) ((f32x4*)sl)[tid + 512 * i] = src[tid + 512 * i];
        __syncthreads();
        {
            float tr = 0.f, ti = 0.f;
#pragma unroll 8
            for (int c = 0; c < 32; ++c) { const float lr = sl[(32 * w + c) * 128 + p], li = sl[(32 * w + c) * 128 + 64 + p];
                const float nr = a.x * tr - a.y * ti + lr, ni = a.x * ti + a.y * tr + li; tr = nr; ti = ni; }
            seg[w * 64 + p] = make_float2(tr, ti);
        }
        __syncthreads();
        float wr_ = sr, wi_ = si;
#pragma unroll
        for (int j = 0; j < 8; ++j) { const float2 t = seg[j * 64 + p];
            const float nr = a32.x * sr - a32.y * si + t.x, ni = a32.x * si + a32.y * sr + t.y; sr = nr; si = ni;
            if (j + 1 == w) { wr_ = sr; wi_ = si; } }
#pragma unroll 8
        for (int c = 0; c < 32; ++c) { const float lr = sl[(32 * w + c) * 128 + p], li = sl[(32 * w + c) * 128 + 64 + p];
            slw[(32 * w + c) * 128 + p] = cvt_pk_bf16(wr_, wi_);
            const float nr = a.x * wr_ - a.y * wi_ + lr, ni = a.x * wi_ + a.y * wr_ + li; wr_ = nr; wi_ = ni; }
        __syncthreads();
#pragma unroll
        for (int i = 0; i < 4; ++i) { const int it = tid + 512 * i, c = it >> 3, p0 = (it & 7) * 8;
            const u32x4 w0 = *(const u32x4*)(slw + c * 128 + p0), w1 = *(const u32x4*)(slw + c * 128 + p0 + 4);
            u32x4 re, im;
            re.x = (w0.x & 0xffffu) | (w0.y << 16); re.y = (w0.z & 0xffffu) | (w0.w << 16); re.z = (w1.x & 0xffffu) | (w1.y << 16); re.w = (w1.z & 0xffffu) | (w1.w << 16);
            im.x = (w0.x >> 16) | (w0.y & 0xffff0000u); im.y = (w0.z >> 16) | (w0.w & 0xffff0000u); im.z = (w1.x >> 16) | (w1.y & 0xffff0000u); im.w = (w1.z >> 16) | (w1.w & 0xffff0000u);
            bf16_t* u = U + (size_t)(g * NCH_ + half * 256 + c) * LDU_ + KU_ + p0;
            *(u32x4*)u = re; *(u32x4*)(u + 64) = im; }
        __syncthreads();
    }
}

__global__ void __launch_bounds__(512, 2) hybrid_fwd(Params P) {
    extern __shared__ __attribute__((aligned(16))) unsigned char smem[];
    LAS unsigned char* lds = (LAS unsigned char*)smem;
    unsigned char* ws = P.ws;
    const int bid = blockIdx.x, nb = gridDim.x;
    const int lo = P.ph_lo, hi = P.ph_hi;
#define IN(k) (lo <= (k) && (k) < hi)
    volatile LAS unsigned* xb_st = (volatile LAS unsigned*)(lds + pg8::STAGE_BYTES);
    XcdBarrier xbar; xbar.bar = (unsigned*)(ws + WS_BAR); xbar.x = 0; xbar.st = xb_st;
    if (hi - lo > 1) {
        if (threadIdx.x < 4) xb_st[threadIdx.x] = 0u;
        __syncthreads();
        xbar = xcd_barrier_post((unsigned*)(ws + WS_BAR), xb_st);
    }
    if (lo == 0x7fffffff) cg::this_grid().sync();
#define SEAM(k) do { if (IN(k) && IN((k) + 1)) { xcd_barrier(xbar); } } while (0)
    bf16_t* H = (bf16_t*)P.out; bf16_t* V = (bf16_t*)P.out + (size_t)L_ * D_;
    bf16_t* YG = (bf16_t*)P.out; bf16_t* Y3 = (bf16_t*)P.out + (size_t)L_ * SW_; bf16_t* TMP = (bf16_t*)P.out + (size_t)L_ * D_;
    bf16_t* U = (bf16_t*)(ws + WS_U);

    if (IN(0)) { for (int idx = bid; idx < 1088; idx += nb) do_job(P, smem, idx < 576 ? idx : idx + 256); } SEAM(0);
    if (IN(1)) {
        pg8::Gemm g{H, (const bf16_t*)(ws + WS_WIN), D_, D_, D_}; pg8::StaticOrder S; S.init(L_, INW_, nb, bid);
        EpiG1 E{U, (bf16_t*)(ws + WS_SG), V, (bf16_t*)(ws + WS_W), (bf16_t*)(ws + WS_SR), (bf16_t*)(ws + WS_SC)};
        pg8::gemm_phase(lds, g, S, E);
    } SEAM(1);
    if (IN(2)) {
        const int nbs = nb >= 128 ? 64 : 0;
        if (bid < nbs || nbs == 0) {
            pg8::Gemm g{U, (const bf16_t*)(ws + WS_WST), LDU_, KU_, KU_}; pg8::BatchOrder S{64, nbs ? nbs : nb, bid, 1};
            EpiS1 E{(float*)(ws + WS_SLOC), (unsigned*)(ws + WS_CNT) + 2 * 64 * 64, &P, smem};
            pg8::gemm_phase(lds, g, S, E);
        }
        if (nbs == 0 || bid >= nbs) { phase_z(P, nbs, nb - nbs); for (int idx = bid - nbs; idx < 528; idx += nb - nbs) do_job(P, smem, idx < 512 ? 1344 + idx : 752 + (idx - 512)); }
    } SEAM(2);
    if (IN(3)) {
        const int nbs = nb >= 256 ? 128 : 0;
        if (bid < nbs || nbs == 0) {
            pg8::Gemm g{U, (const bf16_t*)(ws + WS_MC), LDU_, LDU_, LDU_}; pg8::BatchOrder S{128, nbs ? nbs : nb, bid, 2};
            EpiS2 E{YG};
            pg8::gemm_phase(lds, g, S, E);
        }
        if (bid >= nbs || nbs == 0) {
            pg8::Gemm g{(const bf16_t*)(ws + WS_PBF), (const bf16_t*)(ws + WS_WPLE), PLE_, PLE_, PLE_}; pg8::StaticOrder S; S.init(L_, D_, nbs ? nb - nbs : nb, nbs ? bid - nbs : bid);
            EpiStore E{(bf16_t*)(ws + WS_PE), D_};
            pg8::gemm_phase(lds, g, S, E);
            __syncthreads();
            for (int idx = nbs ? bid - nbs : bid; idx < 240; idx += (nbs ? nb - nbs : nb)) do_job(P, smem, 576 + idx + (idx >= 176 ? 16 : 0));
        }
    } SEAM(3);
    if (IN(4)) {
        unsigned* cntY3 = (unsigned*)(ws + WS_CNT) + 2 * 64 * 64 + 32 * 64; unsigned* cntMG = cntY3 + 64 * 64;
        const bool has = (nb == 256);
#define MY_PM (8 * (bid & 7) + ((bid >> 3) & 7))
        { pg8::Gemm g{YG, (const bf16_t*)(ws + WS_WGLU), SW_, SW_, SW_}; pg8::StaticOrder S; S.init(L_, SW_, nb, bid);
          EpiGlu E{YG, (const bf16_t*)(ws + WS_SG), P.b_glu, Y3};
          pg8::gemm_phase(lds, g, S, E);
          if (has && bid < 128) panel_arrive(cntY3, MY_PM); }
        if (has) {
            panel_wait(cntY3, MY_PM, 2u);
            { pg8::Gemm g{Y3, (const bf16_t*)(ws + WS_WSSO), SW_, SW_, SW_}; pg8::StaticOrder S; S.init(L_, D_, nb, bid);
              EpiMerge<0> E{(const bf16_t*)(ws + WS_SR), nullptr, TMP}; pg8::gemm_phase(lds, g, S, E); }
            { pg8::Gemm g{(const bf16_t*)(ws + WS_Z), (const bf16_t*)(ws + WS_WCO), D_, D_, D_}; pg8::StaticOrder S; S.init(L_, D_, nb, bid);
              EpiMerge<1> E{(const bf16_t*)(ws + WS_SC), TMP, (bf16_t*)(ws + WS_MERGED)}; pg8::gemm_phase(lds, g, S, E); }
            panel_arrive(cntMG, MY_PM);
            panel_wait(cntMG, MY_PM, 4u);
            pg8::Gemm g{(const bf16_t*)(ws + WS_MERGED), (const bf16_t*)(ws + WS_WO), D_, D_, D_}; pg8::StaticOrder S; S.init(L_, D_, nb, bid);
            EpiX1 E{P.x, P.post_norm, (bf16_t*)(ws + WS_X1BF), PanelX{(float*)(ws + WS_MISC), (unsigned*)(ws + WS_CNT)}}; pg8::gemm_phase(lds, g, S, E);
        }
#undef MY_PM
    } SEAM(4);
    if (IN(5)) {
        pg8::Gemm g{(const bf16_t*)(ws + WS_X1BF), (const bf16_t*)(ws + WS_WG), D_, D_, D_}; pg8::StaticOrder S; S.init(L_, D_, nb, bid);
        EpiOut E{(const bf16_t*)(ws + WS_PE), (const bf16_t*)(ws + WS_X1BF), P.ple_norm, P.out, PanelX{(float*)(ws + WS_MISC + 1 * MiB), (unsigned*)(ws + WS_CNT) + 64 * 64}}; pg8::gemm_phase(lds, g, S, E);
    }
#undef IN
#undef SEAM
}


extern "C" void kernel_launch(void* const* d_in, const int* in_sizes, int n_in, void* d_out, int out_size, void* d_ws, size_t ws_size, hipStream_t stream) {
    constexpr int LDS_BYTES = pg8::STAGE_BYTES + 64 + 4096;
    static int grid = 0;
    if (grid == 0) {
        if (n_in != 22 || out_size != L_ * D_ || ws_size < WS_END) { fprintf(stderr, "kernel_launch: unexpected shapes (n_in %d out %d ws %zu)\n", n_in, out_size, ws_size); grid = -1; return; }
        int dev = 0, cus = 0, per_cu = 0;
        hipGetDevice(&dev); hipDeviceGetAttribute(&cus, hipDeviceAttributeMultiprocessorCount, dev);
        if (hipFuncSetAttribute((const void*)hybrid_fwd, hipFuncAttributeMaxDynamicSharedMemorySize, LDS_BYTES) != hipSuccess) { fprintf(stderr, "kernel_launch: hipFuncSetAttribute failed\n"); grid = -1; return; }
        hipOccupancyMaxActiveBlocksPerMultiprocessor(&per_cu, (const void*)hybrid_fwd, 512, LDS_BYTES);
        (void)hipGetLastError();
        if (per_cu < 1) per_cu = 1;
        grid = cus;
        fprintf(stderr, "kernel_launch: cus %d per_cu %d grid %d\n", cus, per_cu, grid);
    }
    if (grid < 0) return;
    Params P{};
    const float** f = (const float**)&P;
    for (int i = 0; i < 22; ++i) f[i] = (const float*)d_in[i];
    P.out = (float*)d_out; P.ws = (unsigned char*)d_ws;
    (void)hipMemsetAsync((unsigned char*)d_ws + WS_BAR, 0, 16384 + 2 * 64 * 256 + 32 * 256 + 2 * 64 * 256, stream);
#if ONE_LAUNCH
    P.ph_lo = 0; P.ph_hi = NPH;
    void* args[] = {&P};
    hipError_t e = hipLaunchCooperativeKernel((const void*)hybrid_fwd, dim3(grid), dim3(512), args, LDS_BYTES, stream);
    if (e != hipSuccess) fprintf(stderr, "cooperative launch failed: %s (grid %d)\n", hipGetErrorString(e), grid);
#else
    for (int ph = 0; ph < NPH; ++ph) {
        P.ph_lo = ph; P.ph_hi = ph + 1;
        hipLaunchKernelGGL(hybrid_fwd, dim3(grid), dim3(512), LDS_BYTES, stream, P);
    }
#endif
}
```

```cpp
#include <hip/hip_runtime.h>
#include <hip/hip_cooperative_groups.h>
#include <cstdio>
namespace cg = cooperative_groups;

#ifndef ONE_LAUNCH
#define ONE_LAUNCH 1
#endif

#define LAS __attribute__((address_space(3)))
typedef unsigned short bf16_t;
typedef short bf16x8 __attribute__((ext_vector_type(8)));
typedef float f32x4 __attribute__((ext_vector_type(4)));
typedef unsigned u32x4 __attribute__((ext_vector_type(4)));
typedef unsigned u32x2 __attribute__((ext_vector_type(2)));

constexpr int L_ = 16384, D_ = 1024, PLE_ = 256, SW_ = 512, NG_ = 32, CWID_ = 1024, INW_ = 7168;
constexpr int T_ = 32, NCH_ = L_ / T_  , KU_ = T_ * 16  , LDU_ = KU_ + 128  ;
constexpr float EPS_ = 1e-6f;
constexpr size_t MiB = 1024 * 1024;
constexpr size_t WS_WGLU = 0, WS_WSSO = WS_WGLU + 512 * 512 * 2, WS_WCO = WS_WSSO + 1024 * 512 * 2, WS_WO = WS_WCO + 2 * MiB, WS_WPLE = WS_WO + 2 * MiB,
                 WS_WG = WS_WPLE + 1024 * 256 * 2, WS_WIN = 8 * MiB, WS_MC = WS_WIN + 14 * MiB, WS_WST = WS_MC + 20 * MiB, WS_PBF = WS_WST + 8 * MiB,
                 WS_U = WS_PBF + 8 * MiB, WS_SLOC = WS_U + 20 * MiB, WS_SG = WS_SLOC + 8 * MiB, WS_W = WS_SG + 16 * MiB, WS_SR = WS_W + 32 * MiB,
                 WS_SC = WS_SR + 32 * MiB, WS_Z = WS_SC + 32 * MiB, WS_MISC = WS_Z + 32 * MiB, WS_END = WS_MISC + 3 * MiB;
constexpr size_t WS_ABT = WS_MISC + 2 * MiB, WS_BAR = WS_MISC + 2 * MiB + 64 * 1024, WS_CNT = WS_BAR + 16384;
constexpr size_t WS_PE = WS_W, WS_MERGED = WS_MC, WS_O = WS_SR, WS_X1BF = WS_SC, WS_E = WS_Z;
constexpr int NPH = 5;

struct Params {
    const float *x, *p, *pre_norm, *w_in, *a_re, *a_im, *log_step, *b_re, *b_im, *c_re, *c_im, *d_skip, *w_glu, *b_glu, *w_ssm_out, *conv_w, *w_conv_out, *w_o,
        *post_norm, *w_ple, *w_ple_gate, *ple_norm;
    float* out; unsigned char* ws; int ph_lo, ph_hi;
};

typedef __bf16 bf16x2_t __attribute__((ext_vector_type(2)));
typedef float f32x2_t __attribute__((ext_vector_type(2)));
__device__ __forceinline__ unsigned cvt_pk_bf16(float lo, float hi) { f32x2_t v = {lo, hi}; bf16x2_t b = __builtin_convertvector(v, bf16x2_t); return __builtin_bit_cast(unsigned, b); }
__device__ __forceinline__ float bflo(unsigned w) { return __uint_as_float(w << 16); }
__device__ __forceinline__ float bfhi(unsigned w) { return __uint_as_float(w & 0xffff0000u); }
__device__ __forceinline__ f32x4 bf4lo(u32x4 w) { return (f32x4){bflo(w.x), bfhi(w.x), bflo(w.y), bfhi(w.y)}; }
__device__ __forceinline__ f32x4 bf4hi(u32x4 w) { return (f32x4){bflo(w.z), bfhi(w.z), bflo(w.w), bfhi(w.w)}; }
__device__ __forceinline__ u32x4 pack8(f32x4 a, f32x4 b) { u32x4 w; w.x = cvt_pk_bf16(a[0], a[1]); w.y = cvt_pk_bf16(a[2], a[3]); w.z = cvt_pk_bf16(b[0], b[1]); w.w = cvt_pk_bf16(b[2], b[3]); return w; }
typedef __amdgpu_buffer_rsrc_t rsrc_t;
__device__ __forceinline__ void wt16b(const bf16_t* base, size_t elem, u32x4 v) {
    const rsrc_t r = __builtin_amdgcn_make_buffer_rsrc((void*)base, (short)0, 0x7ffffff0, 0x00020000);
    __builtin_amdgcn_raw_buffer_store_b128(v, r, (unsigned)(elem * 2), 0, 16); }
__device__ __forceinline__ void panel_arrive(unsigned* cnt, int pm) { if (threadIdx.x == 0) __hip_atomic_fetch_add(cnt + 64 * pm, 1u, __ATOMIC_RELAXED, __HIP_MEMORY_SCOPE_AGENT); }
__device__ __forceinline__ void panel_wait(unsigned* cnt, int pm, unsigned need) {
    if (threadIdx.x == 0) { unsigned spins = 0;
        while (__hip_atomic_load(cnt + 64 * pm, __ATOMIC_RELAXED, __HIP_MEMORY_SCOPE_AGENT) < need) { __builtin_amdgcn_s_sleep(2); if (++spins > (1u << 21)) break; }
        __builtin_amdgcn_fence(__ATOMIC_ACQUIRE, "agent"); asm volatile("s_waitcnt vmcnt(0)" ::: "memory"); }
    __syncthreads();
}
__device__ __forceinline__ float sigm(float x) { return __builtin_amdgcn_rcpf(1.f + __expf(-x)); }
__device__ __forceinline__ f32x4 sigm4(f32x4 v) { return (f32x4){sigm(v[0]), sigm(v[1]), sigm(v[2]), sigm(v[3])}; }
__device__ __forceinline__ float gelu_t(float x) { return x * sigm(1.5957691216f * (x + 0.044715f * x * x * x)); }
__device__ __forceinline__ f32x4 gelu4(f32x4 v) { return (f32x4){gelu_t(v[0]), gelu_t(v[1]), gelu_t(v[2]), gelu_t(v[3])}; }

#define XB_TMO      128
#define XB_XCNT(j)  (256  + 64 * (j))
#define XB_XSUB(j)  (1280 + 64 * (j))
#define XB_XGEN(j)  (2304 + 64 * (j))
#define XB_TOP      3328
#define XB_TOPGEN   3392
#define XCD_BAR_WORDS 3456
#define XB_SPIN_CAP (1u << 18)
__device__ __forceinline__ unsigned xb_ld(unsigned* p)              { return __hip_atomic_load(p, __ATOMIC_RELAXED, __HIP_MEMORY_SCOPE_AGENT); }
__device__ __forceinline__ unsigned xb_add(unsigned* p, unsigned v) { return __hip_atomic_fetch_add(p, v, __ATOMIC_RELAXED, __HIP_MEMORY_SCOPE_AGENT); }
__device__ __forceinline__ unsigned xb_xcc_id() { return (unsigned)__builtin_amdgcn_s_getreg((3 << 11) | 20) & 0xFu; }
#define XB_SPIN(cond, bar) do { unsigned _sp = 0; while (cond) { __builtin_amdgcn_s_sleep(1); \
    if ((++_sp & 255u) == 0u) { if (xb_ld(&(bar)[XB_TMO])) break; if (_sp > XB_SPIN_CAP) { atomicAdd(&(bar)[XB_TMO], 1u); break; } } } } while (0)

struct XcdBarrier {
    unsigned* bar; unsigned x;
    volatile LAS unsigned* st;
};

__device__ __forceinline__ XcdBarrier xcd_barrier_post(unsigned* bar, volatile LAS unsigned* st) {
    XcdBarrier b; b.bar = bar; b.x = xb_xcc_id(); b.st = st;
    if (threadIdx.x == 0) (void)xb_add(&bar[XB_XCNT(b.x)], 1u);
    return b;
}
__device__ __forceinline__ void xcd_barrier_complete(unsigned* bar, unsigned x, unsigned& nloc, unsigned& nx) {
    const unsigned G = gridDim.x * gridDim.y * gridDim.z;
    unsigned sum, cnt, mine, sp = 0u;
    for (;;) {
        sum = 0u; cnt = 0u; mine = 0u;
#pragma unroll
        for (unsigned j = 0; j < 16; ++j) { const unsigned c = xb_ld(&bar[XB_XCNT(j)]); sum += c; cnt += (c > 0u) ? 1u : 0u; mine = (j == x) ? c : mine; }
        if (sum == G) break;
        __builtin_amdgcn_s_sleep(1);
        if ((++sp & 255u) == 0u) { if (xb_ld(&bar[XB_TMO])) break; if (sp > XB_SPIN_CAP) { atomicAdd(&bar[XB_TMO], 1u); break; } }
    }
    nloc = mine > 0u ? mine : 1u; nx = cnt > 0u ? cnt : 1u;
}

__device__ __forceinline__ void xcd_barrier(const XcdBarrier& b) {
    asm volatile("s_waitcnt vmcnt(0)" ::: "memory");
    __syncthreads();
    if (threadIdx.x == 0) {
        unsigned* bar = b.bar;
        __builtin_amdgcn_s_waitcnt(0);
        unsigned nloc = b.st[0], nx = b.st[1];
        if (nloc == 0u) { xcd_barrier_complete(bar, b.x, nloc, nx); b.st[0] = nloc; b.st[1] = nx; }
        const unsigned old = xb_add(&bar[XB_XSUB(b.x)], 1u);
        const unsigned gen = old / nloc;
        if (old + 1u == (gen + 1u) * nloc) {
            __builtin_amdgcn_fence(__ATOMIC_RELEASE, "agent");
            asm volatile("s_waitcnt vmcnt(0)" ::: "memory");
            const unsigned og = xb_add(&bar[XB_TOP], 1u);
            const unsigned tg = og / nx;
            if (og + 1u == (tg + 1u) * nx) xb_add(&bar[XB_TOPGEN], 1u);
            else XB_SPIN(xb_ld(&bar[XB_TOPGEN]) == tg, bar);
            __builtin_amdgcn_fence(__ATOMIC_ACQUIRE, "agent");
            xb_add(&bar[XB_XGEN(b.x)], 1u);
            asm volatile("s_waitcnt vmcnt(0)" ::: "memory");
        } else {
            XB_SPIN(xb_ld(&bar[XB_XGEN(b.x)]) == gen, bar);
            __builtin_amdgcn_fence(__ATOMIC_ACQUIRE, "agent");
            asm volatile("s_waitcnt vmcnt(0)" ::: "memory");
        }
    }
    __syncthreads();
}

namespace pg8 {
constexpr int BM = 256, BK = 64, HALF = 128, HTB = HALF * BK * 2, STAGE_BYTES = 8 * HTB, NXCD = 8, WGM = 8;
__device__ __forceinline__ int lds_byte(int r, int c) { const int st = (r >> 4) * 2 + (c >> 5), rr = r & 15, cc = c & 31, ob = rr * 64 + cc * 2; return st * 1024 + (ob ^ (((ob >> 9) & 1) << 5)); }
__device__ __forceinline__ void stage_rc(int b, int& R, int& C) { const int st = b / 1024, sb = b % 1024, swz = sb ^ (((sb >> 9) & 1) << 5); R = (st >> 1) * 16 + swz / 64; C = (st & 1) * 32 + (swz % 64) / 2; }
__device__ __forceinline__ int perm32(int rho) { const int n = rho >> 4, i = rho & 15; return 8 * (i >> 2) + 4 * n + (i & 3); }
struct Unit { int pm, pn; };
struct Gemm { const bf16_t* A; const bf16_t* Bt; int lda, ldb, K; };

struct StaticOrder {
    int nM, nN, nwg, G, c;
    __device__ void init(int M, int N, int G_, int c_) { nM = M / BM; nN = N / BM; nwg = nM * nN; G = G_; c = c_; }
    __device__ bool next(int i, Unit& u) const {
        const long Lx = (long)i * G + c; if (c < 0 || Lx >= nwg) return false;
        int wgid = (int)Lx; { const int q = nwg / NXCD, r = nwg % NXCD, xcd = wgid % NXCD, off = wgid / NXCD; wgid = (xcd < r ? xcd * (q + 1) : r * (q + 1) + (xcd - r) * q) + off; }
        const int nig = WGM * nN, gid = wgid / nig, fm = gid * WGM, gsz = (nM - fm) < WGM ? (nM - fm) : WGM;
        u.pm = fm + ((wgid % nig) % gsz); u.pn = (wgid % nig) / gsz; return true;
    }
};
struct BatchOrder {
    int nunits, G, c, mode;
    __device__ bool next(int i, Unit& u) const {
        const int Lx = i * G + c; if (c < 0 || Lx >= nunits) return false;
        const int xcd = Lx & 7, slot = Lx >> 3;
        if (mode == 1) { const int g = xcd * 4 + (slot >> 1); u.pm = 2 * g + (slot & 1); u.pn = g; }
        else { const int g = xcd * 4 + (slot >> 2); u.pm = 2 * g + ((slot >> 1) & 1); u.pn = 2 * g + (slot & 1); }
        return true;
    }
};

template <class Epi, class Sched>
__device__ __forceinline__ void gemm_phase(LAS unsigned char* lds, const Gemm g, const Sched& S, const Epi& E) {
    const int tid = threadIdx.x, wid = __builtin_amdgcn_readfirstlane(tid >> 6), lane = tid & 63, wr = wid >> 2, wc = wid & 3, fr = lane & 15, fq = lane >> 4;
    const int K = g.K, nt = K / BK;
    unsigned voffA[2], voffB[2];
#pragma unroll
    for (int i = 0; i < 2; ++i) { int R, C; stage_rc(tid * 16 + i * 8192, R, C); const int Rb = Epi::PERM ? ((R & ~31) + perm32(R & 31)) : R;
        voffA[i] = (unsigned)(R * g.lda + C) * 2u; voffB[i] = (unsigned)(Rb * g.ldb + C) * 2u; }
    const size_t kstep = (size_t)(BK * 2);
    const size_t hstepA = (size_t)HALF * g.lda * 2, hstepB = (size_t)HALF * g.ldb * 2;
    const size_t tstepA = 2 * hstepA, tstepB = 2 * hstepB;
    const unsigned ldsw = (unsigned)wid * 1024u;
    const int aoff = lds_byte(wr * 64 + fr, fq * 8), boff = lds_byte(wc * 32 + fr, fq * 8);
#define PG8_SA(b, h) (((b) * 2 + (h)) * HTB)
#define PG8_SB(b, h) ((4 + (b) * 2 + (h)) * HTB)
#define PG8_STAGE(bufoff, gbase, voff) do { _Pragma("unroll") for (int _i = 0; _i < 2; ++_i) \
        __builtin_amdgcn_global_load_lds((const unsigned*)((const char*)(gbase) + (voff)[_i]), (LAS unsigned*)(lds + (bufoff) + ldsw + _i * 8192), 16, 0, 0); } while (0)
#define PG8_LDA(dst, b, h) do { _Pragma("unroll") for (int m = 0; m < 4; ++m) _Pragma("unroll") for (int k = 0; k < 2; ++k) dst[m][k] = *(const LAS bf16x8*)(lds + PG8_SA(b, h) + aoff + m * 2048 + k * 1024); } while (0)
#define PG8_LDB(dst, b, h) do { _Pragma("unroll") for (int n = 0; n < 2; ++n) _Pragma("unroll") for (int k = 0; k < 2; ++k) dst[n][k] = *(const LAS bf16x8*)(lds + PG8_SB(b, h) + boff + n * 2048 + k * 1024); } while (0)
#define PG8_MMA(ai, bj, At, Bt) do { __builtin_amdgcn_s_setprio(1); _Pragma("unroll") for (int m = 0; m < 4; ++m) _Pragma("unroll") for (int n = 0; n < 2; ++n) _Pragma("unroll") for (int k = 0; k < 2; ++k) \
        acc[ai][bj][m][n] = __builtin_amdgcn_mfma_f32_16x16x32_bf16(Bt[n][k], At[m][k], acc[ai][bj][m][n], 0, 0, 0); __builtin_amdgcn_s_setprio(0); } while (0)
#define PG8_WAIT_V(n) asm volatile("s_waitcnt vmcnt(" #n ")" ::: "memory")
#define PG8_WAIT_L(n) asm volatile("s_waitcnt lgkmcnt(" #n ")" ::: "memory")
#define PG8_BAR __builtin_amdgcn_s_barrier()
#define PG8_SCHED __builtin_amdgcn_sched_barrier(0)
    Unit cur, nxt; int ui = 0;
    if (!S.next(0, cur)) return;
    f32x4 acc[2][2][4][2];
#pragma unroll
    for (int a = 0; a < 2; ++a)
#pragma unroll
        for (int b = 0; b < 2; ++b)
#pragma unroll
            for (int m = 0; m < 4; ++m)
#pragma unroll
                for (int n = 0; n < 2; ++n) acc[a][b][m][n] = (f32x4){0.f, 0.f, 0.f, 0.f};
    bf16x8 At[4][2], B0[2][2], B1[2][2];
    const char* cA = (const char*)g.A + (size_t)cur.pm * tstepA; const char* cB = (const char*)g.Bt + (size_t)cur.pn * tstepB;
    PG8_STAGE(PG8_SB(0, 0), cB, voffB); PG8_STAGE(PG8_SB(0, 1), cB + hstepB, voffB); PG8_STAGE(PG8_SA(0, 0), cA, voffA); PG8_STAGE(PG8_SA(0, 1), cA + hstepA, voffA);
    if (wr == 1) PG8_BAR;
    PG8_WAIT_V(2); PG8_BAR;
    PG8_STAGE(PG8_SB(1, 0), cB + kstep, voffB); PG8_STAGE(PG8_SA(1, 0), cA + kstep, voffA); PG8_STAGE(PG8_SB(1, 1), cB + hstepB + kstep, voffB);
    PG8_WAIT_V(6); PG8_BAR;
    for (;;) {
        const bool has_next = S.next(ui + 1, nxt);
        const char* nA = has_next ? (const char*)g.A + (size_t)nxt.pm * tstepA : cA; const char* nB = has_next ? (const char*)g.Bt + (size_t)nxt.pn * tstepB : cB;
#pragma unroll 1
        for (int t = 0; t < nt; t += 2) {
            const bool last = (t == nt - 2);
            const char* a1 = cA + (size_t)(t + 1) * kstep;
            const char* a2 = last ? nA : cA + (size_t)(t + 2) * kstep; const char* b2 = last ? nB : cB + (size_t)(t + 2) * kstep;
            const char* a3 = a2 + kstep; const char* b3 = b2 + kstep;
            PG8_LDB(B0, 0, 0); PG8_LDB(B1, 0, 1); PG8_SCHED; PG8_LDA(At, 0, 0); PG8_STAGE(PG8_SA(1, 1), a1 + hstepA, voffA);
            PG8_WAIT_V(8); PG8_WAIT_L(0); PG8_BAR; PG8_MMA(0, 0, At, B0); PG8_MMA(0, 1, At, B1); PG8_BAR; PG8_SCHED;
            PG8_LDA(At, 0, 1); PG8_STAGE(PG8_SB(0, 0), b2, voffB); PG8_STAGE(PG8_SB(0, 1), b2 + hstepB, voffB); PG8_STAGE(PG8_SA(0, 0), a2, voffA);
            PG8_WAIT_V(8); PG8_WAIT_L(0); PG8_BAR; PG8_MMA(1, 0, At, B0); PG8_MMA(1, 1, At, B1); PG8_BAR; PG8_SCHED;
            PG8_LDB(B0, 1, 0); PG8_LDB(B1, 1, 1); PG8_SCHED; PG8_LDA(At, 1, 0); PG8_STAGE(PG8_SA(0, 1), a2 + hstepA, voffA);
            PG8_WAIT_V(8); PG8_WAIT_L(0); PG8_BAR; PG8_MMA(0, 0, At, B0); PG8_MMA(0, 1, At, B1); PG8_BAR; PG8_SCHED;
            PG8_LDA(At, 1, 1); PG8_STAGE(PG8_SB(1, 0), b3, voffB); PG8_STAGE(PG8_SB(1, 1), b3 + hstepB, voffB); PG8_STAGE(PG8_SA(1, 0), a3, voffA);
            PG8_WAIT_V(8); PG8_WAIT_L(0); PG8_BAR; PG8_MMA(1, 0, At, B0); PG8_MMA(1, 1, At, B1); PG8_BAR; PG8_SCHED;
        }
        if (wr == 0) PG8_BAR;
        if constexpr (!Epi::AFTER_DRAIN) E(acc, cur, wr, wc, fr, fq);
        if (!has_next) break;
#pragma unroll
        for (int a = 0; a < 2; ++a)
#pragma unroll
            for (int b = 0; b < 2; ++b)
#pragma unroll
                for (int m = 0; m < 4; ++m)
#pragma unroll
                    for (int n = 0; n < 2; ++n) acc[a][b][m][n] = (f32x4){0.f, 0.f, 0.f, 0.f};
        cur = nxt; cA = nA; cB = nB; ++ui;
        if (wr == 1) PG8_BAR;
    }
    PG8_WAIT_V(0);
    PG8_BAR;
    if constexpr (Epi::AFTER_DRAIN) E(acc, cur, wr, wc, fr, fq);
#undef PG8_SA
#undef PG8_SB
#undef PG8_STAGE
#undef PG8_LDA
#undef PG8_LDB
#undef PG8_MMA
#undef PG8_WAIT_V
#undef PG8_WAIT_L
#undef PG8_BAR
#undef PG8_SCHED
}
}
using pg8::Unit;
typedef f32x4 Acc[2][2][4][2];

#define EPI_ROWS(...) _Pragma("unroll") for (int ai = 0; ai < 2; ++ai) _Pragma("unroll") for (int m = 0; m < 4; ++m) { const int row = row0 + ai * 128 + m * 16; __VA_ARGS__ }

struct EpiG1 {
    static constexpr bool PERM = true, AFTER_DRAIN = false;
    bf16_t *U, *SG, *V, *W, *SR, *SC;
    __device__ __forceinline__ void operator()(const Acc& acc, const Unit& u, int wr, int wc, int fr, int fq) const {
        const int row0 = u.pm * 256 + wr * 64 + fr, cw = wc * 32 + 8 * fq, pn = u.pn;
        if (pn < 2) {
            EPI_ROWS(
                const int c = row >> 5, tt = row & 31;
                _Pragma("unroll") for (int bj = 0; bj < 2; ++bj) { const int col = pn * 256 + bj * 128 + cw; const int g = col >> 4, h0 = col & 15;
                    *(u32x4*)(U + ((size_t)(g * NCH_ + c)) * LDU_ + tt * 16 + h0) = pack8(acc[ai][bj][m][0], acc[ai][bj][m][1]); } )
        } else if (pn < 4) {
            EPI_ROWS(
                _Pragma("unroll") for (int bj = 0; bj < 2; ++bj) { const int col = (pn - 2) * 256 + bj * 128 + cw; const f32x4 a = acc[ai][bj][m][0], b = acc[ai][bj][m][1];
                    *(u32x4*)(SG + (size_t)row * SW_ + col) = pack8(a * sigm4(a), b * sigm4(b)); } )
        } else if (pn < 12) {
            EPI_ROWS(
                const int col = (pn - 4) * 128 + cw;
                *(u32x4*)(V + (size_t)row * CWID_ + col) = pack8(acc[ai][0][m][0] * acc[ai][1][m][0], acc[ai][0][m][1] * acc[ai][1][m][1]); )
        } else if (pn < 20) {
            EPI_ROWS(
                const int col = (pn - 12) * 128 + cw; const f32x4 ga = acc[ai][1][m][0], gb = acc[ai][1][m][1];
                *(u32x4*)(W + (size_t)row * CWID_ + col) = pack8(acc[ai][0][m][0] * (ga * sigm4(ga)), acc[ai][0][m][1] * (gb * sigm4(gb))); )
        } else {
            bf16_t* dst = pn < 24 ? SR : SC; const int pb = pn < 24 ? pn - 20 : pn - 24;
            EPI_ROWS(
                _Pragma("unroll") for (int bj = 0; bj < 2; ++bj) { const int col = pb * 256 + bj * 128 + cw;
                    *(u32x4*)(dst + (size_t)row * D_ + col) = pack8(acc[ai][bj][m][0], acc[ai][bj][m][1]); } )
        }
    }
};
__device__ void carry_group(const Params& P, int g, unsigned char* smem);
struct EpiS1 {
    static constexpr bool PERM = false, AFTER_DRAIN = true;
    float* SLOC; unsigned* gcnt; const Params* P; unsigned char* smem;
    __device__ __forceinline__ void operator()(const Acc& acc, const Unit& u, int wr, int wc, int fr, int fq) const {
        const int row0 = u.pm * 256 + wr * 64 + fr;
        EPI_ROWS(
            float* rp = SLOC + (size_t)row * 128 + wc * 32 + 4 * fq; *(f32x4*)rp = acc[ai][0][m][0]; *(f32x4*)(rp + 16) = acc[ai][0][m][1]; )
        asm volatile("s_waitcnt vmcnt(0)" ::: "memory");
        __syncthreads();
        unsigned* flag = (unsigned*)smem;
        if (threadIdx.x == 0) {
            __builtin_amdgcn_fence(__ATOMIC_RELEASE, "agent");
            asm volatile("s_waitcnt vmcnt(0)" ::: "memory");
            const unsigned old = __hip_atomic_fetch_add(gcnt + 64 * u.pn, 1u, __ATOMIC_RELAXED, __HIP_MEMORY_SCOPE_AGENT);
            if (old == 1u) { __builtin_amdgcn_fence(__ATOMIC_ACQUIRE, "agent"); asm volatile("s_waitcnt vmcnt(0)" ::: "memory"); }
            flag[0] = old;
        }
        __syncthreads();
        const unsigned old = flag[0];
        __syncthreads();
        if (old == 1u) carry_group(*P, u.pn, smem);
    }
};
struct EpiS2 {
    static constexpr bool PERM = true, AFTER_DRAIN = false;
    bf16_t* YG;
    __device__ __forceinline__ void operator()(const Acc& acc, const Unit& u, int wr, int wc, int fr, int fq) const {
        const int g = u.pm >> 1, c0 = (u.pm & 1) * 256 + wr * 64 + fr, n0 = (u.pn & 1) * 256 + wc * 32 + 8 * fq;
#pragma unroll
        for (int ai = 0; ai < 2; ++ai)
#pragma unroll
            for (int m = 0; m < 4; ++m) { const int c = c0 + ai * 128 + m * 16;
#pragma unroll
                for (int bj = 0; bj < 2; ++bj) { const int n = n0 + bj * 128, t = n >> 4, h0 = n & 15;
                    *(u32x4*)(YG + (size_t)(c * T_ + t) * SW_ + g * 16 + h0) = pack8(gelu4(acc[ai][bj][m][0]), gelu4(acc[ai][bj][m][1])); } }
    }
};
struct EpiStore {
    static constexpr bool PERM = true, AFTER_DRAIN = false;
    bf16_t* O; int ldc;
    __device__ __forceinline__ void operator()(const Acc& acc, const Unit& u, int wr, int wc, int fr, int fq) const {
        const int row0 = u.pm * 256 + wr * 64 + fr, col0 = u.pn * 256 + wc * 32 + 8 * fq;
        EPI_ROWS(
            _Pragma("unroll") for (int bj = 0; bj < 2; ++bj) *(u32x4*)(O + (size_t)row * ldc + col0 + bj * 128) = pack8(acc[ai][bj][m][0], acc[ai][bj][m][1]); )
    }
};
struct EpiGlu {
    static constexpr bool PERM = true, AFTER_DRAIN = false;
    const bf16_t *YG, *SG; const float* bglu; bf16_t* Y3;
    __device__ __forceinline__ void operator()(const Acc& acc, const Unit& u, int wr, int wc, int fr, int fq) const {
        const int row0 = u.pm * 256 + wr * 64 + fr, col0 = u.pn * 256 + wc * 32 + 8 * fq;
        f32x4 b0[2], b1[2];
#pragma unroll
        for (int bj = 0; bj < 2; ++bj) { b0[bj] = *(const f32x4*)(bglu + col0 + bj * 128); b1[bj] = *(const f32x4*)(bglu + col0 + bj * 128 + 4); }
#pragma unroll
        for (int ai = 0; ai < 2; ++ai) {
            u32x4 yw[4][2], sw[4][2];
#pragma unroll
            for (int m = 0; m < 4; ++m)
#pragma unroll
                for (int bj = 0; bj < 2; ++bj) { const size_t off = (size_t)(row0 + ai * 128 + m * 16) * SW_ + col0 + bj * 128; yw[m][bj] = *(const u32x4*)(YG + off); sw[m][bj] = *(const u32x4*)(SG + off); }
#pragma unroll
            for (int m = 0; m < 4; ++m)
#pragma unroll
                for (int bj = 0; bj < 2; ++bj) { const size_t off = (size_t)(row0 + ai * 128 + m * 16) * SW_ + col0 + bj * 128;
                    wt16b(Y3, off, pack8(bf4lo(yw[m][bj]) * sigm4(acc[ai][bj][m][0] + b0[bj]) * bf4lo(sw[m][bj]), bf4hi(yw[m][bj]) * sigm4(acc[ai][bj][m][1] + b1[bj]) * bf4hi(sw[m][bj]))); }
        }
    }
};
template <int MODE> struct EpiMerge {
    static constexpr bool PERM = true, AFTER_DRAIN = false;
    const bf16_t *S, *TMPI; bf16_t* O;
    __device__ __forceinline__ void operator()(const Acc& acc, const Unit& u, int wr, int wc, int fr, int fq) const {
        const int row0 = u.pm * 256 + wr * 64 + fr, col0 = u.pn * 256 + wc * 32 + 8 * fq;
#pragma unroll
        for (int ai = 0; ai < 2; ++ai) {
            u32x4 sw[4][2], tw[4][2];
#pragma unroll
            for (int m = 0; m < 4; ++m)
#pragma unroll
                for (int bj = 0; bj < 2; ++bj) { const size_t off = (size_t)(row0 + ai * 128 + m * 16) * D_ + col0 + bj * 128; sw[m][bj] = *(const u32x4*)(S + off); if (MODE == 1) tw[m][bj] = *(const u32x4*)(TMPI + off); }
#pragma unroll
            for (int m = 0; m < 4; ++m)
#pragma unroll
                for (int bj = 0; bj < 2; ++bj) { const size_t off = (size_t)(row0 + ai * 128 + m * 16) * D_ + col0 + bj * 128;
                    f32x4 a = sigm4(bf4lo(sw[m][bj])) * acc[ai][bj][m][0], b = sigm4(bf4hi(sw[m][bj])) * acc[ai][bj][m][1];
                    if (MODE == 1) { a += bf4lo(tw[m][bj]); b += bf4hi(tw[m][bj]); }
                    if (MODE == 1) wt16b(O, off, pack8(a, b)); else *(u32x4*)(O + off) = pack8(a, b); }
        }
    }
};
struct PanelX { float* part; unsigned* cnt; };
__device__ __forceinline__ void panel_rstd(const PanelX& px, const Unit& u, int wr, int wc, int fr, int fq, float (&s)[2][4]) {
    const int row0 = u.pm * 256 + wr * 64 + fr;
    const rsrc_t pr = __builtin_amdgcn_make_buffer_rsrc((void*)px.part, (short)0, L_ * 16 * 4, 0x00020000);
#pragma unroll
    for (int ai = 0; ai < 2; ++ai)
#pragma unroll
        for (int m = 0; m < 4; ++m) { float t = s[ai][m]; t += __shfl_xor(t, 16); t += __shfl_xor(t, 32);
            if (fq == 0) __builtin_amdgcn_raw_buffer_store_b32(__float_as_uint(t), pr, (unsigned)(((row0 + ai * 128 + m * 16) * 16 + u.pn * 4 + wc) * 4), 0, 16); }
    asm volatile("s_waitcnt vmcnt(0)" ::: "memory");
    __builtin_amdgcn_s_barrier();
    if (threadIdx.x == 0) {
        unsigned* c = px.cnt + 64 * u.pm;
        __hip_atomic_fetch_add(c, 1u, __ATOMIC_RELAXED, __HIP_MEMORY_SCOPE_AGENT);
        unsigned spins = 0;
        while (__hip_atomic_load(c, __ATOMIC_RELAXED, __HIP_MEMORY_SCOPE_AGENT) < 4u) { __builtin_amdgcn_s_sleep(4); if (++spins > (1u << 20)) break; }
    }
    asm volatile("s_waitcnt vmcnt(0) lgkmcnt(0)" ::: "memory");
    __builtin_amdgcn_s_barrier();
    asm volatile("" ::: "memory");
    __builtin_amdgcn_fence(__ATOMIC_ACQUIRE, "agent");
    asm volatile("s_waitcnt vmcnt(0)" ::: "memory");
#pragma unroll
    for (int ai = 0; ai < 2; ++ai)
#pragma unroll
        for (int m = 0; m < 4; ++m) { const u32x4 q = __builtin_amdgcn_raw_buffer_load_b128(pr, (unsigned)(((row0 + ai * 128 + m * 16) * 16 + fq * 4) * 4), 0, 16);
            float t = (__uint_as_float(q.x) + __uint_as_float(q.y)) + (__uint_as_float(q.z) + __uint_as_float(q.w)); t += __shfl_xor(t, 16); t += __shfl_xor(t, 32);
            s[ai][m] = rsqrtf(t * (1.0f / D_) + EPS_); }
}
__device__ __forceinline__ float sq8(f32x4 a, f32x4 b) { return ((a[0] * a[0] + a[1] * a[1]) + (a[2] * a[2] + a[3] * a[3])) + ((b[0] * b[0] + b[1] * b[1]) + (b[2] * b[2] + b[3] * b[3])); }
struct EpiX1 {
    static constexpr bool PERM = true, AFTER_DRAIN = true;
    const float *x, *gain; bf16_t* X1B; PanelX px;
    __device__ __forceinline__ void operator()(Acc& acc, const Unit& u, int wr, int wc, int fr, int fq) const {
        const int row0 = u.pm * 256 + wr * 64 + fr, col0 = u.pn * 256 + wc * 32 + 8 * fq;
        float s[2][4];
#pragma unroll
        for (int ai = 0; ai < 2; ++ai)
#pragma unroll
            for (int m = 0; m < 4; ++m) s[ai][m] = sq8(acc[ai][0][m][0], acc[ai][0][m][1]) + sq8(acc[ai][1][m][0], acc[ai][1][m][1]);
        panel_rstd(px, u, wr, wc, fr, fq, s);
        f32x4 g0[2], g1[2];
#pragma unroll
        for (int bj = 0; bj < 2; ++bj) { g0[bj] = *(const f32x4*)(gain + col0 + bj * 128); g1[bj] = *(const f32x4*)(gain + col0 + bj * 128 + 4); }
#pragma unroll
        for (int ai = 0; ai < 2; ++ai) {
            f32x4 xa[4][2], xb[4][2];
#pragma unroll
            for (int m = 0; m < 4; ++m)
#pragma unroll
                for (int bj = 0; bj < 2; ++bj) { const size_t off = (size_t)(row0 + ai * 128 + m * 16) * D_ + col0 + bj * 128; xa[m][bj] = *(const f32x4*)(x + off); xb[m][bj] = *(const f32x4*)(x + off + 4); }
#pragma unroll
            for (int m = 0; m < 4; ++m) { const float rs = s[ai][m];
#pragma unroll
                for (int bj = 0; bj < 2; ++bj) { const size_t off = (size_t)(row0 + ai * 128 + m * 16) * D_ + col0 + bj * 128;
                    const f32x4 ya = xa[m][bj] + acc[ai][bj][m][0] * rs * g0[bj], yb = xb[m][bj] + acc[ai][bj][m][1] * rs * g1[bj];
                    wt16b(X1B, off, pack8(ya, yb)); } }
        }
    }
};
struct EpiOut {
    static constexpr bool PERM = true, AFTER_DRAIN = true;
    const bf16_t *PE, *X1B; const float* gain; float* OUT; PanelX px;
    __device__ __forceinline__ void operator()(Acc& acc, const Unit& u, int wr, int wc, int fr, int fq) const {
        const int row0 = u.pm * 256 + wr * 64 + fr, col0 = u.pn * 256 + wc * 32 + 8 * fq;
        float s[2][4];
#pragma unroll
        for (int ai = 0; ai < 2; ++ai) {
            u32x4 pw[4][2];
#pragma unroll
            for (int m = 0; m < 4; ++m)
#pragma unroll
                for (int bj = 0; bj < 2; ++bj) pw[m][bj] = *(const u32x4*)(PE + (size_t)(row0 + ai * 128 + m * 16) * D_ + col0 + bj * 128);
#pragma unroll
            for (int m = 0; m < 4; ++m) { float t = 0.f;
#pragma unroll
                for (int bj = 0; bj < 2; ++bj) { acc[ai][bj][m][0] = bf4lo(pw[m][bj]) * sigm4(acc[ai][bj][m][0]); acc[ai][bj][m][1] = bf4hi(pw[m][bj]) * sigm4(acc[ai][bj][m][1]);
                    t += sq8(acc[ai][bj][m][0], acc[ai][bj][m][1]); }
                s[ai][m] = t; }
        }
        panel_rstd(px, u, wr, wc, fr, fq, s);
        f32x4 g0[2], g1[2];
#pragma unroll
        for (int bj = 0; bj < 2; ++bj) { g0[bj] = *(const f32x4*)(gain + col0 + bj * 128); g1[bj] = *(const f32x4*)(gain + col0 + bj * 128 + 4); }
#pragma unroll
        for (int ai = 0; ai < 2; ++ai) {
            u32x4 xw[4][2];
#pragma unroll
            for (int m = 0; m < 4; ++m)
#pragma unroll
                for (int bj = 0; bj < 2; ++bj) xw[m][bj] = *(const u32x4*)(X1B + (size_t)(row0 + ai * 128 + m * 16) * D_ + col0 + bj * 128);
#pragma unroll
            for (int m = 0; m < 4; ++m) { const float rs = s[ai][m];
#pragma unroll
                for (int bj = 0; bj < 2; ++bj) { const size_t off = (size_t)(row0 + ai * 128 + m * 16) * D_ + col0 + bj * 128;
                    *(f32x4*)(OUT + off) = bf4lo(xw[m][bj]) + acc[ai][bj][m][0] * rs * g0[bj]; *(f32x4*)(OUT + off + 4) = bf4hi(xw[m][bj]) + acc[ai][bj][m][1] * rs * g1[bj]; } }
        }
    }
};

__device__ __forceinline__ void tconv_tile(const float* __restrict__ src, int lds_, int sc0, int k0, bf16_t* __restrict__ dst, int ldd, int n0, float* tile  ) {
    const int tid = threadIdx.x;
    { const int nn = tid & 63, kb = tid >> 6; const float* pp = src + (size_t)(k0 + kb) * lds_ + sc0 + nn; const size_t step = (size_t)8 * lds_;
#pragma unroll 1
      for (int hb = 0; hb < 2; ++hb) { float v[16];
#pragma unroll
        for (int i = 0; i < 16; ++i) { v[i] = *pp; pp += step; }
#pragma unroll
        for (int i = 0; i < 16; ++i) tile[(kb + 8 * (hb * 16 + i)) * 65 + nn] = v[i]; } }
    __syncthreads();
#pragma unroll
    for (int i = 0; i < 4; ++i) { const int pidx = tid + 512 * i, kk2 = (pidx & 31) * 8, nn2 = pidx >> 5;
      f32x4 a, b;
#pragma unroll
      for (int j = 0; j < 4; ++j) { a[j] = tile[(kk2 + j) * 65 + nn2]; b[j] = tile[(kk2 + 4 + j) * 65 + nn2]; }
      *(u32x4*)(dst + (size_t)(n0 + nn2) * ldd + k0 + kk2) = pack8(a, b); }
    __syncthreads();
}
__device__ __forceinline__ int win_srccol(int n0) {
    const int pn = n0 >> 8, j = n0 & 255;
    if (pn < 2) return 256 * pn + j;
    if (pn < 4) return 512 + 256 * (pn - 2) + j;
    if (pn < 12) { const int i = pn - 4; return j < 128 ? 1024 + 128 * i + j : 3072 + 128 * i + (j - 128); }
    if (pn < 20) { const int i = pn - 12; return j < 128 ? 2048 + 128 * i + j : 4096 + 128 * i + (j - 128); }
    if (pn < 24) return 5120 + 256 * (pn - 20) + j;
    return 6144 + 256 * (pn - 24) + j;
}
__device__ void ssm_prep(const Params& P, int g, int r, unsigned char* smem) {
    float2* s_ab = (float2*)smem;
    float2* s_Bb = s_ab + 64;
    float2* s_C = s_Bb + 1024;
    float2* s_pw = s_C + 1024;
    float* s_Kd = (float*)(s_pw + 64 * 33);
    const int tid = threadIdx.x;
    bf16_t* MC = (bf16_t*)(P.ws + WS_MC); bf16_t* WST = (bf16_t*)(P.ws + WS_WST); float2* abT = (float2*)(P.ws + WS_ABT);
    if (tid < 64) {
        const int p = tid; const float dt = expf(P.log_step[g]); const float ar = P.a_re[g * 64 + p], ai = P.a_im[g * 64 + p];
        const float mag = expf(ar * dt), th = ai * dt; const float abr = mag * cosf(th), abi = mag * sinf(th);
        const float den = ar * ar + ai * ai, nr = abr - 1.0f; const float fr = (nr * ar + abi * ai) / den, fi = (abi * ar - nr * ai) / den;
        s_ab[p] = make_float2(abr, abi);
#pragma unroll 1
        for (int h = 0; h < 16; ++h) { const float br = P.b_re[(g * 64 + p) * 16 + h], bi = P.b_im[(g * 64 + p) * 16 + h]; s_Bb[p * 16 + h] = make_float2(fr * br - fi * bi, fr * bi + fi * br); }
        float cr = 1.f, ci = 0.f;
#pragma unroll 1
        for (int d = 0; d <= T_; ++d) { s_pw[p * 33 + d] = make_float2(cr, ci); const float nr2 = cr * abr - ci * abi, ni2 = cr * abi + ci * abr; cr = nr2; ci = ni2; }
        if (r == 0) abT[g * 64 + p] = s_pw[p * 33 + T_];
    }
    for (int i = tid; i < 1024; i += 512) { const int h = i >> 6, p = i & 63; s_C[i] = make_float2(P.c_re[(g * 16 + h) * 64 + p], P.c_im[(g * 16 + h) * 64 + p]); }
    __syncthreads();
#pragma unroll 1
    for (int i = 0; i < 4; ++i) { const int idx = tid + 512 * i, d = idx >> 6, hh = (idx >> 4) & 3, hp = idx & 15, h = 4 * r + hh; float a = 0.f;
#pragma unroll 4
        for (int p = 0; p < 64; ++p) { const float2 c = s_C[h * 64 + p], w = s_pw[p * 33 + d], b = s_Bb[p * 16 + hp]; const float xr = c.x * w.x - c.y * w.y, xi = c.x * w.y + c.y * w.x; a += xr * b.x - xi * b.y; }
        if (d == 0 && h == hp) a += P.d_skip[g * 16 + h];
        s_Kd[idx] = a; }
    __syncthreads();
#pragma unroll 1
    for (int i = 0; i < 20; ++i) { const int pidx = tid + 512 * i, rowi = pidx / 80, col8 = (pidx % 80) * 8, t = rowi >> 2, hh = rowi & 3, h = 4 * r + hh;
        f32x4 a = {0.f, 0.f, 0.f, 0.f}, b = {0.f, 0.f, 0.f, 0.f};
        if (col8 < KU_) { const int k = col8 >> 4, h0 = col8 & 15;
            if (k <= t) { const float* kd = s_Kd + (t - k) * 64 + hh * 16 + h0; a = (f32x4){kd[0], kd[1], kd[2], kd[3]}; b = (f32x4){kd[4], kd[5], kd[6], kd[7]}; } }
        else { const int q0 = col8 - KU_, im = q0 >= 64, p0 = q0 & 63;
#pragma unroll
            for (int j = 0; j < 8; ++j) { const float2 c = s_C[h * 64 + p0 + j], w = s_pw[(p0 + j) * 33 + t + 1]; const float v = im ? -(c.x * w.y + c.y * w.x) : (c.x * w.x - c.y * w.y); if (j < 4) a[j] = v; else b[j - 4] = v; } }
        *(u32x4*)(MC + ((size_t)(g * KU_ + t * 16 + h)) * LDU_ + col8) = pack8(a, b); }
#pragma unroll 1
    for (int i = 0; i < 4; ++i) { const int pidx = tid + 512 * i, q = 32 * r + (pidx >> 6), col8 = (pidx & 63) * 8, k = col8 >> 4, h0 = col8 & 15, p = q & 63, im = q >= 64;
        const float2 w = s_pw[p * 33 + (T_ - 1 - k)]; f32x4 a, b;
#pragma unroll
        for (int j = 0; j < 8; ++j) { const float2 bb = s_Bb[p * 16 + h0 + j]; const float v = im ? (w.x * bb.y + w.y * bb.x) : (w.x * bb.x - w.y * bb.y); if (j < 4) a[j] = v; else b[j - 4] = v; }
        *(u32x4*)(WST + ((size_t)(g * 256 + q)) * KU_ + col8) = pack8(a, b); }
    __syncthreads();
}

__device__ __forceinline__ void do_job(const Params& P, unsigned char* smem, int job) {
    const int tid = threadIdx.x;
    unsigned char* ws = P.ws;
    constexpr int J_SSM = 128, J_TC = 704, J_RMS = 512;
    {
        int j = job;
        if (j < J_SSM) { ssm_prep(P, j >> 2, j & 3, smem); return; }
        j -= J_SSM;
        if (j < J_TC) {
            const float* src; bf16_t* dst; int K, N, off; bool perm = false;
            if (j < 448) { src = P.w_in; dst = (bf16_t*)(ws + WS_WIN); K = 1024; N = INW_; perm = true; }
            else if ((off = j - 448) < 16) { j = off; src = P.w_glu; dst = (bf16_t*)(ws + WS_WGLU); K = 512; N = 512; }
            else if ((off = j - 464) < 32) { j = off; src = P.w_ssm_out; dst = (bf16_t*)(ws + WS_WSSO); K = 512; N = 1024; }
            else if ((off = j - 496) < 64) { j = off; src = P.w_conv_out; dst = (bf16_t*)(ws + WS_WCO); K = 1024; N = 1024; }
            else if ((off = j - 560) < 64) { j = off; src = P.w_o; dst = (bf16_t*)(ws + WS_WO); K = 1024; N = 1024; }
            else if ((off = j - 624) < 16) { j = off; src = P.w_ple; dst = (bf16_t*)(ws + WS_WPLE); K = 256; N = 1024; }
            else { j = j - 640; src = P.w_ple_gate; dst = (bf16_t*)(ws + WS_WG); K = 1024; N = 1024; }
            const int nkt = K >> 8, ntile = j / nkt, ktile = j % nkt, n0 = ntile * 64, k0 = ktile * 256;
            const int sc0 = perm ? win_srccol(n0) : n0;
            tconv_tile(src, N, sc0, k0, dst, K, n0, (float*)smem);
            return;
        }
        j -= J_TC;
        if (j < J_RMS) {
            const int lane = tid & 63, rowb = j * 32 + (tid >> 6) * 4;
            f32x4 v[4][4]; float s[4];
#pragma unroll
            for (int rr = 0; rr < 4; ++rr)
#pragma unroll
                for (int i = 0; i < 4; ++i) v[rr][i] = *(const f32x4*)(P.x + (size_t)(rowb + rr) * D_ + i * 256 + lane * 4);
#pragma unroll
            for (int rr = 0; rr < 4; ++rr) { float t = 0.f;
#pragma unroll
                for (int i = 0; i < 4; ++i) t += (v[rr][i][0] * v[rr][i][0] + v[rr][i][1] * v[rr][i][1]) + (v[rr][i][2] * v[rr][i][2] + v[rr][i][3] * v[rr][i][3]);
#pragma unroll
                for (int o = 32; o >= 1; o >>= 1) t += __shfl_xor(t, o);
                s[rr] = rsqrtf(t * (1.0f / D_) + EPS_); }
#pragma unroll
            for (int i = 0; i < 4; ++i) { const f32x4 gn = *(const f32x4*)(P.pre_norm + i * 256 + lane * 4);
#pragma unroll
                for (int rr = 0; rr < 4; ++rr) { const f32x4 y = v[rr][i] * s[rr] * gn; u32x2 w; w.x = cvt_pk_bf16(y[0], y[1]); w.y = cvt_pk_bf16(y[2], y[3]);
                    *(u32x2*)((bf16_t*)P.out + (size_t)(rowb + rr) * D_ + i * 256 + lane * 4) = w; } }
            return;
        }
        j -= J_RMS;
        {
            const size_t e0 = (size_t)j * 8192 + tid * 8;
            const f32x4 a0 = *(const f32x4*)(P.p + e0), b0 = *(const f32x4*)(P.p + e0 + 4), a1 = *(const f32x4*)(P.p + e0 + 4096), b1 = *(const f32x4*)(P.p + e0 + 4100);
            *(u32x4*)((bf16_t*)(ws + WS_PBF) + e0) = pack8(a0, b0); *(u32x4*)((bf16_t*)(ws + WS_PBF) + e0 + 4096) = pack8(a1, b1);
        }
    }
}

__device__ void phase_z(const Params& P, int b0, int nbz) {
    const bf16_t* V = (const bf16_t*)P.out + (size_t)L_ * D_;
    const bf16_t* W = (const bf16_t*)(P.ws + WS_W); bf16_t* Z = (bf16_t*)(P.ws + WS_Z);
    const int nthreads = nbz * 512;
    for (int idx = (blockIdx.x - b0) * 512 + threadIdx.x; idx < (L_ / 16) * 128; idx += nthreads) {
        const int oct = idx & 127, tb = idx >> 7, t0 = tb * 16, c0 = oct * 8;
        const f32x4 k0a = *(const f32x4*)(P.conv_w + c0), k0b = *(const f32x4*)(P.conv_w + c0 + 4);
        const f32x4 k1a = *(const f32x4*)(P.conv_w + CWID_ + c0), k1b = *(const f32x4*)(P.conv_w + CWID_ + c0 + 4);
        const f32x4 k2a = *(const f32x4*)(P.conv_w + 2 * CWID_ + c0), k2b = *(const f32x4*)(P.conv_w + 2 * CWID_ + c0 + 4);
        f32x4 m2a = {0.f, 0.f, 0.f, 0.f}, m2b = m2a, m1a = m2a, m1b = m2a;
        if (t0 > 0) { const u32x4 w2 = *(const u32x4*)(V + (size_t)(t0 - 2) * CWID_ + c0), w1 = *(const u32x4*)(V + (size_t)(t0 - 1) * CWID_ + c0);
            m2a = bf4lo(w2); m2b = bf4hi(w2); m1a = bf4lo(w1); m1b = bf4hi(w1); }
#pragma unroll
        for (int t = 0; t < 16; ++t) { const size_t off = (size_t)(t0 + t) * CWID_ + c0;
            const u32x4 vw = *(const u32x4*)(V + off), ww = *(const u32x4*)(W + off);
            const f32x4 va = bf4lo(vw), vb = bf4hi(vw);
            const f32x4 ca = k0a * m2a + k1a * m1a + k2a * va, cb = k0b * m2b + k1b * m1b + k2b * vb;
            *(u32x4*)(Z + off) = pack8(bf4lo(ww) * ca, bf4hi(ww) * cb);
            m2a = m1a; m2b = m1b; m1a = va; m1b = vb; }
    }
}
__device__ void carry_group(const Params& P, int g, unsigned char* smem) {
    const float2* abT = (const float2*)(P.ws + WS_ABT); const float* SLOC = (const float*)(P.ws + WS_SLOC); bf16_t* U = (bf16_t*)(P.ws + WS_U);
    float* sl = (float*)smem; unsigned* slw = (unsigned*)smem;
    float2* seg = (float2*)(smem + pg8::STAGE_BYTES + 64);
    const int tid = threadIdx.x, w = tid >> 6, p = tid & 63;
    const float2 a = abT[g * 64 + p];
    float2 a32 = a;
#pragma unroll
    for (int i = 0; i < 5; ++i) a32 = make_float2(a32.x * a32.x - a32.y * a32.y, 2.f * a32.x * a32.y);
    float sr = 0.f, si = 0.f;
    for (int half = 0; half < 2; ++half) {
        const f32x4* src = (const f32x4*)(SLOC + (size_t)(g * NCH_ + half * 256) * 128);
#pragma unroll
        for (int i = 0; i < 16; ++i) ((f32x4*)sl)[tid + 512 * i] = src[tid + 512 * i];
        __syncthreads();
        {
            float tr = 0.f, ti = 0.f;
#pragma unroll 8
            for (int c = 0; c < 32; ++c) { const float lr = sl[(32 * w + c) * 128 + p], li = sl[(32 * w + c) * 128 + 64 + p];
                const float nr = a.x * tr - a.y * ti + lr, ni = a.x * ti + a.y * tr + li; tr = nr; ti = ni; }
            seg[w * 64 + p] = make_float2(tr, ti);
        }
        __syncthreads();
        float wr_ = sr, wi_ = si;
#pragma unroll
        for (int j = 0; j < 8; ++j) { const float2 t = seg[j * 64 + p];
            const float nr = a32.x * sr - a32.y * si + t.x, ni = a32.x * si + a32.y * sr + t.y; sr = nr; si = ni;
            if (j + 1 == w) { wr_ = sr; wi_ = si; } }
#pragma unroll 8
        for (int c = 0; c < 32; ++c) { const float lr = sl[(32 * w + c) * 128 + p], li = sl[(32 * w + c) * 128 + 64 + p];
            slw[(32 * w + c) * 128 + p] = cvt_pk_bf16(wr_, wi_);
            const float nr = a.x * wr_ - a.y * wi_ + lr, ni = a.x * wi_ + a.y * wr_ + li; wr_ = nr; wi_ = ni; }
        __syncthreads();
#pragma unroll
        for (int i = 0; i < 4; ++i) { const int it = tid + 512 * i, c = it >> 3, p0 = (it & 7) * 8;
            const u32x4 w0 = *(const u32x4*)(slw + c * 128 + p0), w1 = *(const u32x4*)(slw + c * 128 + p0 + 4);
            u32x4 re, im;
            re.x = (w0.x & 0xffffu) | (w0.y << 16); re.y = (w0.z & 0xffffu) | (w0.w << 16); re.z = (w1.x & 0xffffu) | (w1.y << 16); re.w = (w1.z & 0xffffu) | (w1.w << 16);
            im.x = (w0.x >> 16) | (w0.y & 0xffff0000u); im.y = (w0.z >> 16) | (w0.w & 0xffff0000u); im.z = (w1.x >> 16) | (w1.y & 0xffff0000u); im.w = (w1.z >> 16) | (w1.w & 0xffff0000u);
            bf16_t* u = U + (size_t)(g * NCH_ + half * 256 + c) * LDU_ + KU_ + p0;
            *(u32x4*)u = re; *(u32x4*)(u + 64) = im; }
        __syncthreads();
    }
}

__global__ void __launch_bounds__(512, 2) hybrid_fwd(Params P) {
    extern __shared__ __attribute__((aligned(16))) unsigned char smem[];
    LAS unsigned char* lds = (LAS unsigned char*)smem;
    unsigned char* ws = P.ws;
    const int bid = blockIdx.x, nb = gridDim.x;
    const int lo = P.ph_lo, hi = P.ph_hi;
#define IN(k) (lo <= (k) && (k) < hi)
    volatile LAS unsigned* xb_st = (volatile LAS unsigned*)(lds + pg8::STAGE_BYTES);
    XcdBarrier xbar; xbar.bar = (unsigned*)(ws + WS_BAR); xbar.x = 0; xbar.st = xb_st;
    if (hi - lo > 1) {
        if (threadIdx.x < 4) xb_st[threadIdx.x] = 0u;
        __syncthreads();
        xbar = xcd_barrier_post((unsigned*)(ws + WS_BAR), xb_st);
    }
    if (lo == 0x7fffffff) cg::this_grid().sync();
#define SEAM(k) do { if (IN(k) && IN((k) + 1)) { xcd_barrier(xbar); } } while (0)
    bf16_t* H = (bf16_t*)P.out; bf16_t* V = (bf16_t*)P.out + (size_t)L_ * D_;
    bf16_t* YG = (bf16_t*)P.out; bf16_t* Y3 = (bf16_t*)P.out + (size_t)L_ * SW_; bf16_t* TMP = (bf16_t*)P.out + (size_t)L_ * D_;
    bf16_t* U = (bf16_t*)(ws + WS_U);

    if (IN(0)) { for (int idx = bid; idx < 1088; idx += nb) do_job(P, smem, idx < 576 ? idx : idx + 256); } SEAM(0);
    if (IN(1)) {
        pg8::Gemm g{H, (const bf16_t*)(ws + WS_WIN), D_, D_, D_}; pg8::StaticOrder S; S.init(L_, INW_, nb, bid);
        EpiG1 E{U, (bf16_t*)(ws + WS_SG), V, (bf16_t*)(ws + WS_W), (bf16_t*)(ws + WS_SR), (bf16_t*)(ws + WS_SC)};
        pg8::gemm_phase(lds, g, S, E);
    } SEAM(1);
    if (IN(2)) {
        const int nbs = nb >= 128 ? 64 : 0;
        if (bid < nbs || nbs == 0) {
            pg8::Gemm g{U, (const bf16_t*)(ws + WS_WST), LDU_, KU_, KU_}; pg8::BatchOrder S{64, nbs ? nbs : nb, bid, 1};
            EpiS1 E{(float*)(ws + WS_SLOC), (unsigned*)(ws + WS_CNT) + 2 * 64 * 64, &P, smem};
            pg8::gemm_phase(lds, g, S, E);
        }
        if (nbs == 0 || bid >= nbs) { phase_z(P, nbs, nb - nbs); for (int idx = bid - nbs; idx < 528; idx += nb - nbs) do_job(P, smem, idx < 512 ? 1344 + idx : 752 + (idx - 512)); }
    } SEAM(2);
    if (IN(3)) {
        const int nbs = nb >= 256 ? 128 : 0;
        if (bid < nbs || nbs == 0) {
            pg8::Gemm g{U, (const bf16_t*)(ws + WS_MC), LDU_, LDU_, LDU_}; pg8::BatchOrder S{128, nbs ? nbs : nb, bid, 2};
            EpiS2 E{YG};
            pg8::gemm_phase(lds, g, S, E);
        }
        if (bid >= nbs || nbs == 0) {
            pg8::Gemm g{(const bf16_t*)(ws + WS_PBF), (const bf16_t*)(ws + WS_WPLE), PLE_, PLE_, PLE_}; pg8::StaticOrder S; S.init(L_, D_, nbs ? nb - nbs : nb, nbs ? bid - nbs : bid);
            EpiStore E{(bf16_t*)(ws + WS_PE), D_};
            pg8::gemm_phase(lds, g, S, E);
            __syncthreads();
            for (int idx = nbs ? bid - nbs : bid; idx < 240; idx += (nbs ? nb - nbs : nb)) do_job(P, smem, 576 + idx + (idx >= 176 ? 16 : 0));
        }
    } SEAM(3);
    if (IN(4)) {
#define cntY3 ((unsigned*)(P.ws + WS_CNT) + 2 * 64 * 64 + 32 * 64)
#define cntMG (cntY3 + 64 * 64)
#define cntX1 (cntMG + 64 * 64)
        const bool has = (nb == 256);
#define MY_PM (8 * (bid & 7) + ((bid >> 3) & 7))
        { pg8::Gemm g{YG, (const bf16_t*)(ws + WS_WGLU), SW_, SW_, SW_}; pg8::StaticOrder S; S.init(L_, SW_, nb, bid);
          EpiGlu E{YG, (const bf16_t*)(ws + WS_SG), P.b_glu, Y3};
          pg8::gemm_phase(lds, g, S, E);
          if (has && bid < 128) panel_arrive(cntY3, MY_PM); }
        if (has) {
            panel_wait(cntY3, MY_PM, 2u);
            { pg8::Gemm g{Y3, (const bf16_t*)(ws + WS_WSSO), SW_, SW_, SW_}; pg8::StaticOrder S; S.init(L_, D_, nb, bid);
              EpiMerge<0> E{(const bf16_t*)(ws + WS_SR), nullptr, TMP}; pg8::gemm_phase(lds, g, S, E); }
            { pg8::Gemm g{(const bf16_t*)(ws + WS_Z), (const bf16_t*)(ws + WS_WCO), D_, D_, D_}; pg8::StaticOrder S; S.init(L_, D_, nb, bid);
              EpiMerge<1> E{(const bf16_t*)(ws + WS_SC), TMP, (bf16_t*)(ws + WS_MERGED)}; pg8::gemm_phase(lds, g, S, E); }
            panel_arrive(cntMG, MY_PM);
            panel_wait(cntMG, MY_PM, 4u);
            pg8::Gemm g{(const bf16_t*)(ws + WS_MERGED), (const bf16_t*)(ws + WS_WO), D_, D_, D_}; pg8::StaticOrder S; S.init(L_, D_, nb, bid);
            { EpiX1 E{P.x, P.post_norm, (bf16_t*)(ws + WS_X1BF), PanelX{(float*)(ws + WS_MISC), (unsigned*)(ws + WS_CNT)}}; pg8::gemm_phase(lds, g, S, E); }
            asm volatile("s_waitcnt vmcnt(0)" ::: "memory"); __syncthreads();
            panel_arrive(cntX1, MY_PM);
            if (threadIdx.x < 4) { const int q = MY_PM, p0 = q < 16 ? 4 * q : (q < 32 ? 4 * (q - 16) : 2 * (q - 32)), np = q < 32 ? 4 : 2;
                if ((int)threadIdx.x < np) { unsigned spins = 0;
                    while (__hip_atomic_load(cntMG + 64 * (p0 + (int)threadIdx.x), __ATOMIC_RELAXED, __HIP_MEMORY_SCOPE_AGENT) < 4u) { __builtin_amdgcn_s_sleep(2); if (++spins > (1u << 21)) break; } } }
            panel_wait(cntX1, MY_PM, 4u);
            pg8::Gemm g7{(const bf16_t*)(ws + WS_X1BF), (const bf16_t*)(ws + WS_WG), D_, D_, D_}; pg8::StaticOrder S7; S7.init(L_, D_, nb, bid);
            EpiOut E7{(const bf16_t*)(ws + WS_PE), (const bf16_t*)(ws + WS_X1BF), P.ple_norm, P.out, PanelX{(float*)(ws + WS_MISC + 1 * MiB), (unsigned*)(ws + WS_CNT) + 64 * 64}}; pg8::gemm_phase(lds, g7, S7, E7);
        }
#undef MY_PM
#undef cntY3
#undef cntMG
#undef cntX1
    }
#undef IN
#undef SEAM
}


extern "C" void kernel_launch(void* const* d_in, const int* in_sizes, int n_in, void* d_out, int out_size, void* d_ws, size_t ws_size, hipStream_t stream) {
    constexpr int LDS_BYTES = pg8::STAGE_BYTES + 64 + 4096;
    static int grid = 0;
    if (grid == 0) {
        if (n_in != 22 || out_size != L_ * D_ || ws_size < WS_END) { fprintf(stderr, "kernel_launch: unexpected shapes (n_in %d out %d ws %zu)\n", n_in, out_size, ws_size); grid = -1; return; }
        int dev = 0, cus = 0, per_cu = 0;
        hipGetDevice(&dev); hipDeviceGetAttribute(&cus, hipDeviceAttributeMultiprocessorCount, dev);
        if (hipFuncSetAttribute((const void*)hybrid_fwd, hipFuncAttributeMaxDynamicSharedMemorySize, LDS_BYTES) != hipSuccess) { fprintf(stderr, "kernel_launch: hipFuncSetAttribute failed\n"); grid = -1; return; }
        hipOccupancyMaxActiveBlocksPerMultiprocessor(&per_cu, (const void*)hybrid_fwd, 512, LDS_BYTES);
        (void)hipGetLastError();
        if (per_cu < 1) per_cu = 1;
        grid = cus;
        fprintf(stderr, "kernel_launch: cus %d per_cu %d grid %d\n", cus, per_cu, grid);
    }
    if (grid < 0) return;
    Params P{};
    const float** f = (const float**)&P;
    for (int i = 0; i < 22; ++i) f[i] = (const float*)d_in[i];
    P.out = (float*)d_out; P.ws = (unsigned char*)d_ws;
    (void)hipMemsetAsync((unsigned char*)d_ws + WS_BAR, 0, 16384 + 2 * 64 * 256 + 32 * 256 + 3 * 64 * 256, stream);
#if ONE_LAUNCH
    P.ph_lo = 0; P.ph_hi = NPH;
    void* args[] = {&P};
    hipError_t e = hipLaunchCooperativeKernel((const void*)hybrid_fwd, dim3(grid), dim3(512), args, LDS_BYTES, stream);
    if (e != hipSuccess) fprintf(stderr, "cooperative launch failed: %s (grid %d)\n", hipGetErrorString(e), grid);
#else
    for (int ph = 0; ph < NPH; ++ph) {
        P.ph_lo = ph; P.ph_hi = ph + 1;
        hipLaunchKernelGGL(hybrid_fwd, dim3(grid), dim3(512), LDS_BYTES, stream, P);
    }
#endif
}
```

```cpp
#include <hip/hip_runtime.h>
#include <hip/hip_cooperative_groups.h>
#include <cstdio>
namespace cg = cooperative_groups;

#ifndef ONE_LAUNCH
#define ONE_LAUNCH 1
#endif

#define LAS __attribute__((address_space(3)))
typedef unsigned short bf16_t;
typedef short bf16x8 __attribute__((ext_vector_type(8)));
typedef float f32x4 __attribute__((ext_vector_type(4)));
typedef unsigned u32x4 __attribute__((ext_vector_type(4)));
typedef unsigned u32x2 __attribute__((ext_vector_type(2)));

constexpr int L_ = 16384, D_ = 1024, PLE_ = 256, SW_ = 512, NG_ = 32, CWID_ = 1024, INW_ = 7168;
constexpr int T_ = 32, NCH_ = L_ / T_  , KU_ = T_ * 16  , LDU_ = KU_ + 128  ;
constexpr float EPS_ = 1e-6f;
constexpr size_t MiB = 1024 * 1024;
constexpr size_t WS_WGLU = 0, WS_WSSO = WS_WGLU + 512 * 512 * 2, WS_WCO = WS_WSSO + 1024 * 512 * 2, WS_WO = WS_WCO + 2 * MiB, WS_WPLE = WS_WO + 2 * MiB,
                 WS_WG = WS_WPLE + 1024 * 256 * 2, WS_WIN = 8 * MiB, WS_MC = WS_WIN + 14 * MiB, WS_WST = WS_MC + 20 * MiB, WS_PBF = WS_WST + 8 * MiB,
                 WS_U = WS_PBF + 8 * MiB, WS_SLOC = WS_U + 20 * MiB, WS_SG = WS_SLOC + 8 * MiB, WS_W = WS_SG + 16 * MiB, WS_SR = WS_W + 32 * MiB,
                 WS_SC = WS_SR + 32 * MiB, WS_Z = WS_SC + 32 * MiB, WS_MISC = WS_Z + 32 * MiB, WS_END = WS_MISC + 3 * MiB;
constexpr size_t WS_ABT = WS_MISC + 2 * MiB, WS_BAR = WS_MISC + 2 * MiB + 64 * 1024, WS_CNT = WS_BAR + 16384;
constexpr size_t WS_PE = WS_W, WS_MERGED = WS_MC, WS_O = WS_SR, WS_X1BF = WS_SC, WS_E = WS_Z;
constexpr int NPH = 5;

struct Params {
    const float *x, *p, *pre_norm, *w_in, *a_re, *a_im, *log_step, *b_re, *b_im, *c_re, *c_im, *d_skip, *w_glu, *b_glu, *w_ssm_out, *conv_w, *w_conv_out, *w_o,
        *post_norm, *w_ple, *w_ple_gate, *ple_norm;
    float* out; unsigned char* ws; int ph_lo, ph_hi;
};

typedef __bf16 bf16x2_t __attribute__((ext_vector_type(2)));
typedef float f32x2_t __attribute__((ext_vector_type(2)));
__device__ __forceinline__ unsigned cvt_pk_bf16(float lo, float hi) { f32x2_t v = {lo, hi}; bf16x2_t b = __builtin_convertvector(v, bf16x2_t); return __builtin_bit_cast(unsigned, b); }
__device__ __forceinline__ float bflo(unsigned w) { return __uint_as_float(w << 16); }
__device__ __forceinline__ float bfhi(unsigned w) { return __uint_as_float(w & 0xffff0000u); }
__device__ __forceinline__ f32x4 bf4lo(u32x4 w) { return (f32x4){bflo(w.x), bfhi(w.x), bflo(w.y), bfhi(w.y)}; }
__device__ __forceinline__ f32x4 bf4hi(u32x4 w) { return (f32x4){bflo(w.z), bfhi(w.z), bflo(w.w), bfhi(w.w)}; }
__device__ __forceinline__ u32x4 pack8(f32x4 a, f32x4 b) { u32x4 w; w.x = cvt_pk_bf16(a[0], a[1]); w.y = cvt_pk_bf16(a[2], a[3]); w.z = cvt_pk_bf16(b[0], b[1]); w.w = cvt_pk_bf16(b[2], b[3]); return w; }
typedef __amdgpu_buffer_rsrc_t rsrc_t;
__device__ __forceinline__ void wt16b(const bf16_t* base, size_t elem, u32x4 v) {
    const rsrc_t r = __builtin_amdgcn_make_buffer_rsrc((void*)base, (short)0, 0x7ffffff0, 0x00020000);
    __builtin_amdgcn_raw_buffer_store_b128(v, r, (unsigned)(elem * 2), 0, 16); }
__device__ __forceinline__ void panel_arrive(unsigned* cnt, int pm) { if (threadIdx.x == 0) __hip_atomic_fetch_add(cnt + 64 * pm, 1u, __ATOMIC_RELAXED, __HIP_MEMORY_SCOPE_AGENT); }
__device__ __forceinline__ void panel_wait(unsigned* cnt, int pm, unsigned need) {
    if (threadIdx.x == 0) { unsigned spins = 0;
        while (__hip_atomic_load(cnt + 64 * pm, __ATOMIC_RELAXED, __HIP_MEMORY_SCOPE_AGENT) < need) { __builtin_amdgcn_s_sleep(2); if (++spins > (1u << 21)) break; }
        __builtin_amdgcn_fence(__ATOMIC_ACQUIRE, "agent"); asm volatile("s_waitcnt vmcnt(0)" ::: "memory"); }
    __syncthreads();
}
__device__ __forceinline__ float sigm(float x) { return __builtin_amdgcn_rcpf(1.f + __expf(-x)); }
__device__ __forceinline__ f32x4 sigm4(f32x4 v) { return (f32x4){sigm(v[0]), sigm(v[1]), sigm(v[2]), sigm(v[3])}; }
__device__ __forceinline__ float gelu_t(float x) { return x * sigm(1.5957691216f * (x + 0.044715f * x * x * x)); }
__device__ __forceinline__ f32x4 gelu4(f32x4 v) { return (f32x4){gelu_t(v[0]), gelu_t(v[1]), gelu_t(v[2]), gelu_t(v[3])}; }

#define XB_TMO      128
#define XB_XCNT(j)  (256  + 64 * (j))
#define XB_XSUB(j)  (1280 + 64 * (j))
#define XB_XGEN(j)  (2304 + 64 * (j))
#define XB_TOP      3328
#define XB_TOPGEN   3392
#define XCD_BAR_WORDS 3456
#define XB_SPIN_CAP (1u << 18)
__device__ __forceinline__ unsigned xb_ld(unsigned* p)              { return __hip_atomic_load(p, __ATOMIC_RELAXED, __HIP_MEMORY_SCOPE_AGENT); }
__device__ __forceinline__ unsigned xb_add(unsigned* p, unsigned v) { return __hip_atomic_fetch_add(p, v, __ATOMIC_RELAXED, __HIP_MEMORY_SCOPE_AGENT); }
__device__ __forceinline__ unsigned xb_xcc_id() { return (unsigned)__builtin_amdgcn_s_getreg((3 << 11) | 20) & 0xFu; }
#define XB_SPIN(cond, bar) do { unsigned _sp = 0; while (cond) { __builtin_amdgcn_s_sleep(1); \
    if ((++_sp & 255u) == 0u) { if (xb_ld(&(bar)[XB_TMO])) break; if (_sp > XB_SPIN_CAP) { atomicAdd(&(bar)[XB_TMO], 1u); break; } } } } while (0)

struct XcdBarrier {
    unsigned* bar; unsigned x;
    volatile LAS unsigned* st;
};

__device__ __forceinline__ XcdBarrier xcd_barrier_post(unsigned* bar, volatile LAS unsigned* st) {
    XcdBarrier b; b.bar = bar; b.x = xb_xcc_id(); b.st = st;
    if (threadIdx.x == 0) (void)xb_add(&bar[XB_XCNT(b.x)], 1u);
    return b;
}
__device__ __forceinline__ void xcd_barrier_complete(unsigned* bar, unsigned x, unsigned& nloc, unsigned& nx) {
    const unsigned G = gridDim.x * gridDim.y * gridDim.z;
    unsigned sum, cnt, mine, sp = 0u;
    for (;;) {
        sum = 0u; cnt = 0u; mine = 0u;
#pragma unroll
        for (unsigned j = 0; j < 16; ++j) { const unsigned c = xb_ld(&bar[XB_XCNT(j)]); sum += c; cnt += (c > 0u) ? 1u : 0u; mine = (j == x) ? c : mine; }
        if (sum == G) break;
        __builtin_amdgcn_s_sleep(1);
        if ((++sp & 255u) == 0u) { if (xb_ld(&bar[XB_TMO])) break; if (sp > XB_SPIN_CAP) { atomicAdd(&bar[XB_TMO], 1u); break; } }
    }
    nloc = mine > 0u ? mine : 1u; nx = cnt > 0u ? cnt : 1u;
}

__device__ __forceinline__ void xcd_barrier(const XcdBarrier& b) {
    asm volatile("s_waitcnt vmcnt(0)" ::: "memory");
    __syncthreads();
    if (threadIdx.x == 0) {
        unsigned* bar = b.bar;
        __builtin_amdgcn_s_waitcnt(0);
        unsigned nloc = b.st[0], nx = b.st[1];
        if (nloc == 0u) { xcd_barrier_complete(bar, b.x, nloc, nx); b.st[0] = nloc; b.st[1] = nx; }
        const unsigned old = xb_add(&bar[XB_XSUB(b.x)], 1u);
        const unsigned gen = old / nloc;
        if (old + 1u == (gen + 1u) * nloc) {
            __builtin_amdgcn_fence(__ATOMIC_RELEASE, "agent");
            asm volatile("s_waitcnt vmcnt(0)" ::: "memory");
            const unsigned og = xb_add(&bar[XB_TOP], 1u);
            const unsigned tg = og / nx;
            if (og + 1u == (tg + 1u) * nx) xb_add(&bar[XB_TOPGEN], 1u);
            else XB_SPIN(xb_ld(&bar[XB_TOPGEN]) == tg, bar);
            __builtin_amdgcn_fence(__ATOMIC_ACQUIRE, "agent");
            xb_add(&bar[XB_XGEN(b.x)], 1u);
            asm volatile("s_waitcnt vmcnt(0)" ::: "memory");
        } else {
            XB_SPIN(xb_ld(&bar[XB_XGEN(b.x)]) == gen, bar);
            __builtin_amdgcn_fence(__ATOMIC_ACQUIRE, "agent");
            asm volatile("s_waitcnt vmcnt(0)" ::: "memory");
        }
    }
    __syncthreads();
}

namespace pg8 {
constexpr int BM = 256, BK = 64, HALF = 128, HTB = HALF * BK * 2, STAGE_BYTES = 8 * HTB, NXCD = 8, WGM = 8;
__device__ __forceinline__ int lds_byte(int r, int c) { const int st = (r >> 4) * 2 + (c >> 5), rr = r & 15, cc = c & 31, ob = rr * 64 + cc * 2; return st * 1024 + (ob ^ (((ob >> 9) & 1) << 5)); }
__device__ __forceinline__ void stage_rc(int b, int& R, int& C) { const int st = b / 1024, sb = b % 1024, swz = sb ^ (((sb >> 9) & 1) << 5); R = (st >> 1) * 16 + swz / 64; C = (st & 1) * 32 + (swz % 64) / 2; }
__device__ __forceinline__ int perm32(int rho) { const int n = rho >> 4, i = rho & 15; return 8 * (i >> 2) + 4 * n + (i & 3); }
struct Unit { int pm, pn; };
struct Gemm { const bf16_t* A; const bf16_t* Bt; int lda, ldb, K; };

struct StaticOrder {
    int nM, nN, nwg, G, c;
    __device__ void init(int M, int N, int G_, int c_) { nM = M / BM; nN = N / BM; nwg = nM * nN; G = G_; c = c_; }
    __device__ bool next(int i, Unit& u) const {
        const long Lx = (long)i * G + c; if (c < 0 || Lx >= nwg) return false;
        int wgid = (int)Lx; { const int q = nwg / NXCD, r = nwg % NXCD, xcd = wgid % NXCD, off = wgid / NXCD; wgid = (xcd < r ? xcd * (q + 1) : r * (q + 1) + (xcd - r) * q) + off; }
        const int nig = WGM * nN, gid = wgid / nig, fm = gid * WGM, gsz = (nM - fm) < WGM ? (nM - fm) : WGM;
        u.pm = fm + ((wgid % nig) % gsz); u.pn = (wgid % nig) / gsz; return true;
    }
};
struct BatchOrder {
    int nunits, G, c, mode;
    __device__ bool next(int i, Unit& u) const {
        const int Lx = i * G + c; if (c < 0 || Lx >= nunits) return false;
        const int xcd = Lx & 7, slot = Lx >> 3;
        if (mode == 1) { const int g = xcd * 4 + (slot >> 1); u.pm = 2 * g + (slot & 1); u.pn = g; }
        else { const int g = xcd * 4 + (slot >> 2); u.pm = 2 * g + ((slot >> 1) & 1); u.pn = 2 * g + (slot & 1); }
        return true;
    }
};

template <class Epi, class Sched>
__device__ __forceinline__ void gemm_phase(LAS unsigned char* lds, const Gemm g, const Sched& S, const Epi& E) {
    const int tid = threadIdx.x, wid = __builtin_amdgcn_readfirstlane(tid >> 6), lane = tid & 63, wr = wid >> 2, wc = wid & 3, fr = lane & 15, fq = lane >> 4;
    const int K = g.K, nt = K / BK;
    unsigned voffA[2], voffB[2];
#pragma unroll
    for (int i = 0; i < 2; ++i) { int R, C; stage_rc(tid * 16 + i * 8192, R, C); const int Rb = Epi::PERM ? ((R & ~31) + perm32(R & 31)) : R;
        voffA[i] = (unsigned)(R * g.lda + C) * 2u; voffB[i] = (unsigned)(Rb * g.ldb + C) * 2u; }
    const size_t kstep = (size_t)(BK * 2);
    const size_t hstepA = (size_t)HALF * g.lda * 2, hstepB = (size_t)HALF * g.ldb * 2;
    const size_t tstepA = 2 * hstepA, tstepB = 2 * hstepB;
    const unsigned ldsw = (unsigned)wid * 1024u;
    const int aoff = lds_byte(wr * 64 + fr, fq * 8), boff = lds_byte(wc * 32 + fr, fq * 8);
#define PG8_SA(b, h) (((b) * 2 + (h)) * HTB)
#define PG8_SB(b, h) ((4 + (b) * 2 + (h)) * HTB)
#define PG8_STAGE(bufoff, gbase, voff) do { _Pragma("unroll") for (int _i = 0; _i < 2; ++_i) \
        __builtin_amdgcn_global_load_lds((const unsigned*)((const char*)(gbase) + (voff)[_i]), (LAS unsigned*)(lds + (bufoff) + ldsw + _i * 8192), 16, 0, 0); } while (0)
#define PG8_LDA(dst, b, h) do { _Pragma("unroll") for (int m = 0; m < 4; ++m) _Pragma("unroll") for (int k = 0; k < 2; ++k) dst[m][k] = *(const LAS bf16x8*)(lds + PG8_SA(b, h) + aoff + m * 2048 + k * 1024); } while (0)
#define PG8_LDB(dst, b, h) do { _Pragma("unroll") for (int n = 0; n < 2; ++n) _Pragma("unroll") for (int k = 0; k < 2; ++k) dst[n][k] = *(const LAS bf16x8*)(lds + PG8_SB(b, h) + boff + n * 2048 + k * 1024); } while (0)
#define PG8_MMA(ai, bj, At, Bt) do { __builtin_amdgcn_s_setprio(1); _Pragma("unroll") for (int m = 0; m < 4; ++m) _Pragma("unroll") for (int n = 0; n < 2; ++n) _Pragma("unroll") for (int k = 0; k < 2; ++k) \
        acc[ai][bj][m][n] = __builtin_amdgcn_mfma_f32_16x16x32_bf16(Bt[n][k], At[m][k], acc[ai][bj][m][n], 0, 0, 0); __builtin_amdgcn_s_setprio(0); } while (0)
#define PG8_WAIT_V(n) asm volatile("s_waitcnt vmcnt(" #n ")" ::: "memory")
#define PG8_WAIT_L(n) asm volatile("s_waitcnt lgkmcnt(" #n ")" ::: "memory")
#define PG8_BAR __builtin_amdgcn_s_barrier()
#define PG8_SCHED __builtin_amdgcn_sched_barrier(0)
    Unit cur, nxt; int ui = 0;
    if (!S.next(0, cur)) return;
    f32x4 acc[2][2][4][2];
#pragma unroll
    for (int a = 0; a < 2; ++a)
#pragma unroll
        for (int b = 0; b < 2; ++b)
#pragma unroll
            for (int m = 0; m < 4; ++m)
#pragma unroll
                for (int n = 0; n < 2; ++n) acc[a][b][m][n] = (f32x4){0.f, 0.f, 0.f, 0.f};
    bf16x8 At[4][2], B0[2][2], B1[2][2];
    const char* cA = (const char*)g.A + (size_t)cur.pm * tstepA; const char* cB = (const char*)g.Bt + (size_t)cur.pn * tstepB;
    PG8_STAGE(PG8_SB(0, 0), cB, voffB); PG8_STAGE(PG8_SB(0, 1), cB + hstepB, voffB); PG8_STAGE(PG8_SA(0, 0), cA, voffA); PG8_STAGE(PG8_SA(0, 1), cA + hstepA, voffA);
    if (wr == 1) PG8_BAR;
    PG8_WAIT_V(2); PG8_BAR;
    PG8_STAGE(PG8_SB(1, 0), cB + kstep, voffB); PG8_STAGE(PG8_SA(1, 0), cA + kstep, voffA); PG8_STAGE(PG8_SB(1, 1), cB + hstepB + kstep, voffB);
    PG8_WAIT_V(6); PG8_BAR;
    for (;;) {
        const bool has_next = S.next(ui + 1, nxt);
        const char* nA = has_next ? (const char*)g.A + (size_t)nxt.pm * tstepA : cA; const char* nB = has_next ? (const char*)g.Bt + (size_t)nxt.pn * tstepB : cB;
#pragma unroll 1
        for (int t = 0; t < nt; t += 2) {
            const bool last = (t == nt - 2);
            const char* a1 = cA + (size_t)(t + 1) * kstep;
            const char* a2 = last ? nA : cA + (size_t)(t + 2) * kstep; const char* b2 = last ? nB : cB + (size_t)(t + 2) * kstep;
            const char* a3 = a2 + kstep; const char* b3 = b2 + kstep;
            PG8_LDB(B0, 0, 0); PG8_LDB(B1, 0, 1); PG8_SCHED; PG8_LDA(At, 0, 0); PG8_STAGE(PG8_SA(1, 1), a1 + hstepA, voffA);
            PG8_WAIT_V(8); PG8_WAIT_L(0); PG8_BAR; PG8_MMA(0, 0, At, B0); PG8_MMA(0, 1, At, B1); PG8_BAR; PG8_SCHED;
            PG8_LDA(At, 0, 1); PG8_STAGE(PG8_SB(0, 0), b2, voffB); PG8_STAGE(PG8_SB(0, 1), b2 + hstepB, voffB); PG8_STAGE(PG8_SA(0, 0), a2, voffA);
            PG8_WAIT_V(8); PG8_WAIT_L(0); PG8_BAR; PG8_MMA(1, 0, At, B0); PG8_MMA(1, 1, At, B1); PG8_BAR; PG8_SCHED;
            PG8_LDB(B0, 1, 0); PG8_LDB(B1, 1, 1); PG8_SCHED; PG8_LDA(At, 1, 0); PG8_STAGE(PG8_SA(0, 1), a2 + hstepA, voffA);
            PG8_WAIT_V(8); PG8_WAIT_L(0); PG8_BAR; PG8_MMA(0, 0, At, B0); PG8_MMA(0, 1, At, B1); PG8_BAR; PG8_SCHED;
            PG8_LDA(At, 1, 1); PG8_STAGE(PG8_SB(1, 0), b3, voffB); PG8_STAGE(PG8_SB(1, 1), b3 + hstepB, voffB); PG8_STAGE(PG8_SA(1, 0), a3, voffA);
            PG8_WAIT_V(8); PG8_WAIT_L(0); PG8_BAR; PG8_MMA(1, 0, At, B0); PG8_MMA(1, 1, At, B1); PG8_BAR; PG8_SCHED;
        }
        if (wr == 0) PG8_BAR;
        if constexpr (!Epi::AFTER_DRAIN) E(acc, cur, wr, wc, fr, fq);
        if (!has_next) break;
#pragma unroll
        for (int a = 0; a < 2; ++a)
#pragma unroll
            for (int b = 0; b < 2; ++b)
#pragma unroll
                for (int m = 0; m < 4; ++m)
#pragma unroll
                    for (int n = 0; n < 2; ++n) acc[a][b][m][n] = (f32x4){0.f, 0.f, 0.f, 0.f};
        cur = nxt; cA = nA; cB = nB; ++ui;
        if (wr == 1) PG8_BAR;
    }
    PG8_WAIT_V(0);
    PG8_BAR;
    if constexpr (Epi::AFTER_DRAIN) E(acc, cur, wr, wc, fr, fq);
#undef PG8_SA
#undef PG8_SB
#undef PG8_STAGE
#undef PG8_LDA
#undef PG8_LDB
#undef PG8_MMA
#undef PG8_WAIT_V
#undef PG8_WAIT_L
#undef PG8_BAR
#undef PG8_SCHED
}
}
using pg8::Unit;
typedef f32x4 Acc[2][2][4][2];

#define EPI_ROWS(...) _Pragma("unroll") for (int ai = 0; ai < 2; ++ai) _Pragma("unroll") for (int m = 0; m < 4; ++m) { const int row = row0 + ai * 128 + m * 16; __VA_ARGS__ }

struct EpiG1 {
    static constexpr bool PERM = true, AFTER_DRAIN = false;
    bf16_t *U, *SG, *V, *W, *SR, *SC;
    __device__ __forceinline__ void operator()(const Acc& acc, const Unit& u, int wr, int wc, int fr, int fq) const {
        const int row0 = u.pm * 256 + wr * 64 + fr, cw = wc * 32 + 8 * fq, pn = u.pn;
        if (pn < 2) {
            EPI_ROWS(
                const int c = row >> 5, tt = row & 31;
                _Pragma("unroll") for (int bj = 0; bj < 2; ++bj) { const int col = pn * 256 + bj * 128 + cw; const int g = col >> 4, h0 = col & 15;
                    *(u32x4*)(U + ((size_t)(g * NCH_ + c)) * LDU_ + tt * 16 + h0) = pack8(acc[ai][bj][m][0], acc[ai][bj][m][1]); } )
        } else if (pn < 4) {
            EPI_ROWS(
                _Pragma("unroll") for (int bj = 0; bj < 2; ++bj) { const int col = (pn - 2) * 256 + bj * 128 + cw; const f32x4 a = acc[ai][bj][m][0], b = acc[ai][bj][m][1];
                    *(u32x4*)(SG + (size_t)row * SW_ + col) = pack8(a * sigm4(a), b * sigm4(b)); } )
        } else if (pn < 12) {
            EPI_ROWS(
                const int col = (pn - 4) * 128 + cw;
                *(u32x4*)(V + (size_t)row * CWID_ + col) = pack8(acc[ai][0][m][0] * acc[ai][1][m][0], acc[ai][0][m][1] * acc[ai][1][m][1]); )
        } else if (pn < 20) {
            EPI_ROWS(
                const int col = (pn - 12) * 128 + cw; const f32x4 ga = acc[ai][1][m][0], gb = acc[ai][1][m][1];
                *(u32x4*)(W + (size_t)row * CWID_ + col) = pack8(acc[ai][0][m][0] * (ga * sigm4(ga)), acc[ai][0][m][1] * (gb * sigm4(gb))); )
        } else {
            bf16_t* dst = pn < 24 ? SR : SC; const int pb = pn < 24 ? pn - 20 : pn - 24;
            EPI_ROWS(
                _Pragma("unroll") for (int bj = 0; bj < 2; ++bj) { const int col = pb * 256 + bj * 128 + cw;
                    *(u32x4*)(dst + (size_t)row * D_ + col) = pack8(acc[ai][bj][m][0], acc[ai][bj][m][1]); } )
        }
    }
};
__device__ void carry_group(const Params& P, int g, unsigned char* smem);
struct EpiS1 {
    static constexpr bool PERM = false, AFTER_DRAIN = true;
    float* SLOC; unsigned* gcnt; const Params* P; unsigned char* smem;
    __device__ __forceinline__ void operator()(const Acc& acc, const Unit& u, int wr, int wc, int fr, int fq) const {
        const int row0 = u.pm * 256 + wr * 64 + fr;
        EPI_ROWS(
            float* rp = SLOC + (size_t)row * 128 + wc * 32 + 4 * fq; *(f32x4*)rp = acc[ai][0][m][0]; *(f32x4*)(rp + 16) = acc[ai][0][m][1]; )
        asm volatile("s_waitcnt vmcnt(0)" ::: "memory");
        __syncthreads();
        unsigned* flag = (unsigned*)smem;
        if (threadIdx.x == 0) {
            __builtin_amdgcn_fence(__ATOMIC_RELEASE, "agent");
            asm volatile("s_waitcnt vmcnt(0)" ::: "memory");
            const unsigned old = __hip_atomic_fetch_add(gcnt + 64 * u.pn, 1u, __ATOMIC_RELAXED, __HIP_MEMORY_SCOPE_AGENT);
            if (old == 1u) { __builtin_amdgcn_fence(__ATOMIC_ACQUIRE, "agent"); asm volatile("s_waitcnt vmcnt(0)" ::: "memory"); }
            flag[0] = old;
        }
        __syncthreads();
        const unsigned old = flag[0];
        __syncthreads();
        if (old == 1u) carry_group(*P, u.pn, smem);
    }
};
struct EpiS2 {
    static constexpr bool PERM = true, AFTER_DRAIN = false;
    bf16_t* YG;
    __device__ __forceinline__ void operator()(const Acc& acc, const Unit& u, int wr, int wc, int fr, int fq) const {
        const int g = u.pm >> 1, c0 = (u.pm & 1) * 256 + wr * 64 + fr, n0 = (u.pn & 1) * 256 + wc * 32 + 8 * fq;
#pragma unroll
        for (int ai = 0; ai < 2; ++ai)
#pragma unroll
            for (int m = 0; m < 4; ++m) { const int c = c0 + ai * 128 + m * 16;
#pragma unroll
                for (int bj = 0; bj < 2; ++bj) { const int n = n0 + bj * 128, t = n >> 4, h0 = n & 15;
                    *(u32x4*)(YG + (size_t)(c * T_ + t) * SW_ + g * 16 + h0) = pack8(gelu4(acc[ai][bj][m][0]), gelu4(acc[ai][bj][m][1])); } }
    }
};
struct EpiStore {
    static constexpr bool PERM = true, AFTER_DRAIN = false;
    bf16_t* O; int ldc;
    __device__ __forceinline__ void operator()(const Acc& acc, const Unit& u, int wr, int wc, int fr, int fq) const {
        const int row0 = u.pm * 256 + wr * 64 + fr, col0 = u.pn * 256 + wc * 32 + 8 * fq;
        EPI_ROWS(
            _Pragma("unroll") for (int bj = 0; bj < 2; ++bj) *(u32x4*)(O + (size_t)row * ldc + col0 + bj * 128) = pack8(acc[ai][bj][m][0], acc[ai][bj][m][1]); )
    }
};
struct EpiGlu {
    static constexpr bool PERM = true, AFTER_DRAIN = false;
    const bf16_t *YG, *SG; const float* bglu; bf16_t* Y3;
    __device__ __forceinline__ void operator()(const Acc& acc, const Unit& u, int wr, int wc, int fr, int fq) const {
        const int row0 = u.pm * 256 + wr * 64 + fr, col0 = u.pn * 256 + wc * 32 + 8 * fq;
        f32x4 b0[2], b1[2];
#pragma unroll
        for (int bj = 0; bj < 2; ++bj) { b0[bj] = *(const f32x4*)(bglu + col0 + bj * 128); b1[bj] = *(const f32x4*)(bglu + col0 + bj * 128 + 4); }
#pragma unroll
        for (int ai = 0; ai < 2; ++ai) {
            u32x4 yw[4][2], sw[4][2];
#pragma unroll
            for (int m = 0; m < 4; ++m)
#pragma unroll
                for (int bj = 0; bj < 2; ++bj) { const size_t off = (size_t)(row0 + ai * 128 + m * 16) * SW_ + col0 + bj * 128; yw[m][bj] = *(const u32x4*)(YG + off); sw[m][bj] = *(const u32x4*)(SG + off); }
#pragma unroll
            for (int m = 0; m < 4; ++m)
#pragma unroll
                for (int bj = 0; bj < 2; ++bj) { const size_t off = (size_t)(row0 + ai * 128 + m * 16) * SW_ + col0 + bj * 128;
                    wt16b(Y3, off, pack8(bf4lo(yw[m][bj]) * sigm4(acc[ai][bj][m][0] + b0[bj]) * bf4lo(sw[m][bj]), bf4hi(yw[m][bj]) * sigm4(acc[ai][bj][m][1] + b1[bj]) * bf4hi(sw[m][bj]))); }
        }
    }
};
template <int MODE> struct EpiMerge {
    static constexpr bool PERM = true, AFTER_DRAIN = false;
    const bf16_t *S, *TMPI; bf16_t* O;
    __device__ __forceinline__ void operator()(const Acc& acc, const Unit& u, int wr, int wc, int fr, int fq) const {
        const int row0 = u.pm * 256 + wr * 64 + fr, col0 = u.pn * 256 + wc * 32 + 8 * fq;
#pragma unroll
        for (int ai = 0; ai < 2; ++ai) {
            u32x4 sw[4][2], tw[4][2];
#pragma unroll
            for (int m = 0; m < 4; ++m)
#pragma unroll
                for (int bj = 0; bj < 2; ++bj) { const size_t off = (size_t)(row0 + ai * 128 + m * 16) * D_ + col0 + bj * 128; sw[m][bj] = *(const u32x4*)(S + off); if (MODE == 1) tw[m][bj] = *(const u32x4*)(TMPI + off); }
#pragma unroll
            for (int m = 0; m < 4; ++m)
#pragma unroll
                for (int bj = 0; bj < 2; ++bj) { const size_t off = (size_t)(row0 + ai * 128 + m * 16) * D_ + col0 + bj * 128;
                    f32x4 a = sigm4(bf4lo(sw[m][bj])) * acc[ai][bj][m][0], b = sigm4(bf4hi(sw[m][bj])) * acc[ai][bj][m][1];
                    if (MODE == 1) { a += bf4lo(tw[m][bj]); b += bf4hi(tw[m][bj]); }
                    if (MODE == 1) wt16b(O, off, pack8(a, b)); else *(u32x4*)(O + off) = pack8(a, b); }
        }
    }
};
struct PanelX { float* part; unsigned* cnt; };
__device__ __forceinline__ void panel_rstd(const PanelX& px, const Unit& u, int wr, int wc, int fr, int fq, float (&s)[2][4]) {
    const int row0 = u.pm * 256 + wr * 64 + fr;
    const rsrc_t pr = __builtin_amdgcn_make_buffer_rsrc((void*)px.part, (short)0, L_ * 16 * 4, 0x00020000);
#pragma unroll
    for (int ai = 0; ai < 2; ++ai)
#pragma unroll
        for (int m = 0; m < 4; ++m) { float t = s[ai][m]; t += __shfl_xor(t, 16); t += __shfl_xor(t, 32);
            if (fq == 0) __builtin_amdgcn_raw_buffer_store_b32(__float_as_uint(t), pr, (unsigned)(((row0 + ai * 128 + m * 16) * 16 + u.pn * 4 + wc) * 4), 0, 16); }
    asm volatile("s_waitcnt vmcnt(0)" ::: "memory");
    __builtin_amdgcn_s_barrier();
    if (threadIdx.x == 0) {
        unsigned* c = px.cnt + 64 * u.pm;
        __hip_atomic_fetch_add(c, 1u, __ATOMIC_RELAXED, __HIP_MEMORY_SCOPE_AGENT);
        unsigned spins = 0;
        while (__hip_atomic_load(c, __ATOMIC_RELAXED, __HIP_MEMORY_SCOPE_AGENT) < 4u) { __builtin_amdgcn_s_sleep(4); if (++spins > (1u << 20)) break; }
    }
    asm volatile("s_waitcnt vmcnt(0) lgkmcnt(0)" ::: "memory");
    __builtin_amdgcn_s_barrier();
    asm volatile("" ::: "memory");
    __builtin_amdgcn_fence(__ATOMIC_ACQUIRE, "agent");
    asm volatile("s_waitcnt vmcnt(0)" ::: "memory");
#pragma unroll
    for (int ai = 0; ai < 2; ++ai)
#pragma unroll
        for (int m = 0; m < 4; ++m) { const u32x4 q = __builtin_amdgcn_raw_buffer_load_b128(pr, (unsigned)(((row0 + ai * 128 + m * 16) * 16 + fq * 4) * 4), 0, 16);
            float t = (__uint_as_float(q.x) + __uint_as_float(q.y)) + (__uint_as_float(q.z) + __uint_as_float(q.w)); t += __shfl_xor(t, 16); t += __shfl_xor(t, 32);
            s[ai][m] = rsqrtf(t * (1.0f / D_) + EPS_); }
}
__device__ __forceinline__ float sq8(f32x4 a, f32x4 b) { return ((a[0] * a[0] + a[1] * a[1]) + (a[2] * a[2] + a[3] * a[3])) + ((b[0] * b[0] + b[1] * b[1]) + (b[2] * b[2] + b[3] * b[3])); }
struct EpiX1 {
    static constexpr bool PERM = true, AFTER_DRAIN = true;
    const float *x, *gain; bf16_t* X1B; PanelX px;
    __device__ __forceinline__ void operator()(Acc& acc, const Unit& u, int wr, int wc, int fr, int fq) const {
        const int row0 = u.pm * 256 + wr * 64 + fr, col0 = u.pn * 256 + wc * 32 + 8 * fq;
        float s[2][4];
#pragma unroll
        for (int ai = 0; ai < 2; ++ai)
#pragma unroll
            for (int m = 0; m < 4; ++m) s[ai][m] = sq8(acc[ai][0][m][0], acc[ai][0][m][1]) + sq8(acc[ai][1][m][0], acc[ai][1][m][1]);
        panel_rstd(px, u, wr, wc, fr, fq, s);
        f32x4 g0[2], g1[2];
#pragma unroll
        for (int bj = 0; bj < 2; ++bj) { g0[bj] = *(const f32x4*)(gain + col0 + bj * 128); g1[bj] = *(const f32x4*)(gain + col0 + bj * 128 + 4); }
#pragma unroll
        for (int ai = 0; ai < 2; ++ai) {
            f32x4 xa[4][2], xb[4][2];
#pragma unroll
            for (int m = 0; m < 4; ++m)
#pragma unroll
                for (int bj = 0; bj < 2; ++bj) { const size_t off = (size_t)(row0 + ai * 128 + m * 16) * D_ + col0 + bj * 128; xa[m][bj] = *(const f32x4*)(x + off); xb[m][bj] = *(const f32x4*)(x + off + 4); }
#pragma unroll
            for (int m = 0; m < 4; ++m) { const float rs = s[ai][m];
#pragma unroll
                for (int bj = 0; bj < 2; ++bj) { const size_t off = (size_t)(row0 + ai * 128 + m * 16) * D_ + col0 + bj * 128;
                    const f32x4 ya = xa[m][bj] + acc[ai][bj][m][0] * rs * g0[bj], yb = xb[m][bj] + acc[ai][bj][m][1] * rs * g1[bj];
                    wt16b(X1B, off, pack8(ya, yb)); } }
        }
    }
};
struct EpiOut {
    static constexpr bool PERM = true, AFTER_DRAIN = true;
    const bf16_t *PE, *X1B; const float* gain; float* OUT; PanelX px;
    __device__ __forceinline__ void operator()(Acc& acc, const Unit& u, int wr, int wc, int fr, int fq) const {
        const int row0 = u.pm * 256 + wr * 64 + fr, col0 = u.pn * 256 + wc * 32 + 8 * fq;
        float s[2][4];
#pragma unroll
        for (int ai = 0; ai < 2; ++ai) {
            u32x4 pw[4][2];
#pragma unroll
            for (int m = 0; m < 4; ++m)
#pragma unroll
                for (int bj = 0; bj < 2; ++bj) pw[m][bj] = *(const u32x4*)(PE + (size_t)(row0 + ai * 128 + m * 16) * D_ + col0 + bj * 128);
#pragma unroll
            for (int m = 0; m < 4; ++m) { float t = 0.f;
#pragma unroll
                for (int bj = 0; bj < 2; ++bj) { acc[ai][bj][m][0] = bf4lo(pw[m][bj]) * sigm4(acc[ai][bj][m][0]); acc[ai][bj][m][1] = bf4hi(pw[m][bj]) * sigm4(acc[ai][bj][m][1]);
                    t += sq8(acc[ai][bj][m][0], acc[ai][bj][m][1]); }
                s[ai][m] = t; }
        }
        panel_rstd(px, u, wr, wc, fr, fq, s);
        f32x4 g0[2], g1[2];
#pragma unroll
        for (int bj = 0; bj < 2; ++bj) { g0[bj] = *(const f32x4*)(gain + col0 + bj * 128); g1[bj] = *(const f32x4*)(gain + col0 + bj * 128 + 4); }
#pragma unroll
        for (int ai = 0; ai < 2; ++ai) {
            u32x4 xw[4][2];
#pragma unroll
            for (int m = 0; m < 4; ++m)
#pragma unroll
                for (int bj = 0; bj < 2; ++bj) xw[m][bj] = *(const u32x4*)(X1B + (size_t)(row0 + ai * 128 + m * 16) * D_ + col0 + bj * 128);
#pragma unroll
            for (int m = 0; m < 4; ++m) { const float rs = s[ai][m];
#pragma unroll
                for (int bj = 0; bj < 2; ++bj) { const size_t off = (size_t)(row0 + ai * 128 + m * 16) * D_ + col0 + bj * 128;
                    *(f32x4*)(OUT + off) = bf4lo(xw[m][bj]) + acc[ai][bj][m][0] * rs * g0[bj]; *(f32x4*)(OUT + off + 4) = bf4hi(xw[m][bj]) + acc[ai][bj][m][1] * rs * g1[bj]; } }
        }
    }
};

__device__ __forceinline__ void tconv_tile(const float* __restrict__ src, int lds_, int sc0, int k0, bf16_t* __restrict__ dst, int ldd, int n0, float* tile  ) {
    const int tid = threadIdx.x;
    { const int nn = tid & 63, kb = tid >> 6; const float* pp = src + (size_t)(k0 + kb) * lds_ + sc0 + nn; const size_t step = (size_t)8 * lds_;
#pragma unroll 1
      for (int hb = 0; hb < 2; ++hb) { float v[16];
#pragma unroll
        for (int i = 0; i < 16; ++i) { v[i] = *pp; pp += step; }
#pragma unroll
        for (int i = 0; i < 16; ++i) tile[(kb + 8 * (hb * 16 + i)) * 65 + nn] = v[i]; } }
    __syncthreads();
#pragma unroll
    for (int i = 0; i < 4; ++i) { const int pidx = tid + 512 * i, kk2 = (pidx & 31) * 8, nn2 = pidx >> 5;
      f32x4 a, b;
#pragma unroll
      for (int j = 0; j < 4; ++j) { a[j] = tile[(kk2 + j) * 65 + nn2]; b[j] = tile[(kk2 + 4 + j) * 65 + nn2]; }
      *(u32x4*)(dst + (size_t)(n0 + nn2) * ldd + k0 + kk2) = pack8(a, b); }
    __syncthreads();
}
__device__ __forceinline__ int win_srccol(int n0) {
    const int pn = n0 >> 8, j = n0 & 255;
    if (pn < 2) return 256 * pn + j;
    if (pn < 4) return 512 + 256 * (pn - 2) + j;
    if (pn < 12) { const int i = pn - 4; return j < 128 ? 1024 + 128 * i + j : 3072 + 128 * i + (j - 128); }
    if (pn < 20) { const int i = pn - 12; return j < 128 ? 2048 + 128 * i + j : 4096 + 128 * i + (j - 128); }
    if (pn < 24) return 5120 + 256 * (pn - 20) + j;
    return 6144 + 256 * (pn - 24) + j;
}
__device__ void ssm_prep(const Params& P, int g, int r, unsigned char* smem) {
    float2* s_ab = (float2*)smem;
    float2* s_Bb = s_ab + 64;
    float2* s_C = s_Bb + 1024;
    float2* s_pw = s_C + 1024;
    float* s_Kd = (float*)(s_pw + 64 * 33);
    const int tid = threadIdx.x;
    bf16_t* MC = (bf16_t*)(P.ws + WS_MC); bf16_t* WST = (bf16_t*)(P.ws + WS_WST); float2* abT = (float2*)(P.ws + WS_ABT);
    if (tid < 64) {
        const int p = tid; const float dt = expf(P.log_step[g]); const float ar = P.a_re[g * 64 + p], ai = P.a_im[g * 64 + p];
        const float mag = expf(ar * dt), th = ai * dt; const float abr = mag * cosf(th), abi = mag * sinf(th);
        const float den = ar * ar + ai * ai, nr = abr - 1.0f; const float fr = (nr * ar + abi * ai) / den, fi = (abi * ar - nr * ai) / den;
        s_ab[p] = make_float2(abr, abi);
#pragma unroll 1
        for (int h = 0; h < 16; ++h) { const float br = P.b_re[(g * 64 + p) * 16 + h], bi = P.b_im[(g * 64 + p) * 16 + h]; s_Bb[p * 16 + h] = make_float2(fr * br - fi * bi, fr * bi + fi * br); }
        float cr = 1.f, ci = 0.f;
#pragma unroll 1
        for (int d = 0; d <= T_; ++d) { s_pw[p * 33 + d] = make_float2(cr, ci); const float nr2 = cr * abr - ci * abi, ni2 = cr * abi + ci * abr; cr = nr2; ci = ni2; }
        if (r == 0) abT[g * 64 + p] = s_pw[p * 33 + T_];
    }
    for (int i = tid; i < 1024; i += 512) { const int h = i >> 6, p = i & 63; s_C[i] = make_float2(P.c_re[(g * 16 + h) * 64 + p], P.c_im[(g * 16 + h) * 64 + p]); }
    __syncthreads();
#pragma unroll 1
    for (int i = 0; i < 4; ++i) { const int idx = tid + 512 * i, d = idx >> 6, hh = (idx >> 4) & 3, hp = idx & 15, h = 4 * r + hh; float a = 0.f;
#pragma unroll 4
        for (int p = 0; p < 64; ++p) { const float2 c = s_C[h * 64 + p], w = s_pw[p * 33 + d], b = s_Bb[p * 16 + hp]; const float xr = c.x * w.x - c.y * w.y, xi = c.x * w.y + c.y * w.x; a += xr * b.x - xi * b.y; }
        if (d == 0 && h == hp) a += P.d_skip[g * 16 + h];
        s_Kd[idx] = a; }
    __syncthreads();
#pragma unroll 1
    for (int i = 0; i < 20; ++i) { const int pidx = tid + 512 * i, rowi = pidx / 80, col8 = (pidx % 80) * 8, t = rowi >> 2, hh = rowi & 3, h = 4 * r + hh;
        f32x4 a = {0.f, 0.f, 0.f, 0.f}, b = {0.f, 0.f, 0.f, 0.f};
        if (col8 < KU_) { const int k = col8 >> 4, h0 = col8 & 15;
            if (k <= t) { const float* kd = s_Kd + (t - k) * 64 + hh * 16 + h0; a = (f32x4){kd[0], kd[1], kd[2], kd[3]}; b = (f32x4){kd[4], kd[5], kd[6], kd[7]}; } }
        else { const int q0 = col8 - KU_, im = q0 >= 64, p0 = q0 & 63;
#pragma unroll
            for (int j = 0; j < 8; ++j) { const float2 c = s_C[h * 64 + p0 + j], w = s_pw[(p0 + j) * 33 + t + 1]; const float v = im ? -(c.x * w.y + c.y * w.x) : (c.x * w.x - c.y * w.y); if (j < 4) a[j] = v; else b[j - 4] = v; } }
        *(u32x4*)(MC + ((size_t)(g * KU_ + t * 16 + h)) * LDU_ + col8) = pack8(a, b); }
#pragma unroll 1
    for (int i = 0; i < 4; ++i) { const int pidx = tid + 512 * i, q = 32 * r + (pidx >> 6), col8 = (pidx & 63) * 8, k = col8 >> 4, h0 = col8 & 15, p = q & 63, im = q >= 64;
        const float2 w = s_pw[p * 33 + (T_ - 1 - k)]; f32x4 a, b;
#pragma unroll
        for (int j = 0; j < 8; ++j) { const float2 bb = s_Bb[p * 16 + h0 + j]; const float v = im ? (w.x * bb.y + w.y * bb.x) : (w.x * bb.x - w.y * bb.y); if (j < 4) a[j] = v; else b[j - 4] = v; }
        *(u32x4*)(WST + ((size_t)(g * 256 + q)) * KU_ + col8) = pack8(a, b); }
    __syncthreads();
}

__device__ __forceinline__ void do_job(const Params& P, unsigned char* smem, int job) {
    const int tid = threadIdx.x;
    unsigned char* ws = P.ws;
    constexpr int J_SSM = 128, J_TC = 704, J_RMS = 512;
    {
        int j = job;
        if (j < J_SSM) { ssm_prep(P, j >> 2, j & 3, smem); return; }
        j -= J_SSM;
        if (j < J_TC) {
            const float* src; bf16_t* dst; int K, N, off; bool perm = false;
            if (j < 448) { src = P.w_in; dst = (bf16_t*)(ws + WS_WIN); K = 1024; N = INW_; perm = true; }
            else if ((off = j - 448) < 16) { j = off; src = P.w_glu; dst = (bf16_t*)(ws + WS_WGLU); K = 512; N = 512; }
            else if ((off = j - 464) < 32) { j = off; src = P.w_ssm_out; dst = (bf16_t*)(ws + WS_WSSO); K = 512; N = 1024; }
            else if ((off = j - 496) < 64) { j = off; src = P.w_conv_out; dst = (bf16_t*)(ws + WS_WCO); K = 1024; N = 1024; }
            else if ((off = j - 560) < 64) { j = off; src = P.w_o; dst = (bf16_t*)(ws + WS_WO); K = 1024; N = 1024; }
            else if ((off = j - 624) < 16) { j = off; src = P.w_ple; dst = (bf16_t*)(ws + WS_WPLE); K = 256; N = 1024; }
            else { j = j - 640; src = P.w_ple_gate; dst = (bf16_t*)(ws + WS_WG); K = 1024; N = 1024; }
            const int nkt = K >> 8, ntile = j / nkt, ktile = j % nkt, n0 = ntile * 64, k0 = ktile * 256;
            const int sc0 = perm ? win_srccol(n0) : n0;
            tconv_tile(src, N, sc0, k0, dst, K, n0, (float*)smem);
            return;
        }
        j -= J_TC;
        if (j < J_RMS) {
            const int lane = tid & 63, rowb = j * 32 + (tid >> 6) * 4;
            f32x4 v[4][4]; float s[4];
#pragma unroll
            for (int rr = 0; rr < 4; ++rr)
#pragma unroll
                for (int i = 0; i < 4; ++i) v[rr][i] = *(const f32x4*)(P.x + (size_t)(rowb + rr) * D_ + i * 256 + lane * 4);
#pragma unroll
            for (int rr = 0; rr < 4; ++rr) { float t = 0.f;
#pragma unroll
                for (int i = 0; i < 4; ++i) t += (v[rr][i][0] * v[rr][i][0] + v[rr][i][1] * v[rr][i][1]) + (v[rr][i][2] * v[rr][i][2] + v[rr][i][3] * v[rr][i][3]);
#pragma unroll
                for (int o = 32; o >= 1; o >>= 1) t += __shfl_xor(t, o);
                s[rr] = rsqrtf(t * (1.0f / D_) + EPS_); }
#pragma unroll
            for (int i = 0; i < 4; ++i) { const f32x4 gn = *(const f32x4*)(P.pre_norm + i * 256 + lane * 4);
#pragma unroll
                for (int rr = 0; rr < 4; ++rr) { const f32x4 y = v[rr][i] * s[rr] * gn; u32x2 w; w.x = cvt_pk_bf16(y[0], y[1]); w.y = cvt_pk_bf16(y[2], y[3]);
                    *(u32x2*)((bf16_t*)P.out + (size_t)(rowb + rr) * D_ + i * 256 + lane * 4) = w; } }
            return;
        }
        j -= J_RMS;
        {
            const size_t e0 = (size_t)j * 8192 + tid * 8;
            const f32x4 a0 = *(const f32x4*)(P.p + e0), b0 = *(const f32x4*)(P.p + e0 + 4), a1 = *(const f32x4*)(P.p + e0 + 4096), b1 = *(const f32x4*)(P.p + e0 + 4100);
            *(u32x4*)((bf16_t*)(ws + WS_PBF) + e0) = pack8(a0, b0); *(u32x4*)((bf16_t*)(ws + WS_PBF) + e0 + 4096) = pack8(a1, b1);
        }
    }
}

__device__ void phase_z(const Params& P, int b0, int nbz) {
    const bf16_t* V = (const bf16_t*)P.out + (size_t)L_ * D_;
    const bf16_t* W = (const bf16_t*)(P.ws + WS_W); bf16_t* Z = (bf16_t*)(P.ws + WS_Z);
    const int nthreads = nbz * 512;
    for (int idx = (blockIdx.x - b0) * 512 + threadIdx.x; idx < (L_ / 16) * 128; idx += nthreads) {
        const int oct = idx & 127, tb = idx >> 7, t0 = tb * 16, c0 = oct * 8;
        const f32x4 k0a = *(const f32x4*)(P.conv_w + c0), k0b = *(const f32x4*)(P.conv_w + c0 + 4);
        const f32x4 k1a = *(const f32x4*)(P.conv_w + CWID_ + c0), k1b = *(const f32x4*)(P.conv_w + CWID_ + c0 + 4);
        const f32x4 k2a = *(const f32x4*)(P.conv_w + 2 * CWID_ + c0), k2b = *(const f32x4*)(P.conv_w + 2 * CWID_ + c0 + 4);
        f32x4 m2a = {0.f, 0.f, 0.f, 0.f}, m2b = m2a, m1a = m2a, m1b = m2a;
        if (t0 > 0) { const u32x4 w2 = *(const u32x4*)(V + (size_t)(t0 - 2) * CWID_ + c0), w1 = *(const u32x4*)(V + (size_t)(t0 - 1) * CWID_ + c0);
            m2a = bf4lo(w2); m2b = bf4hi(w2); m1a = bf4lo(w1); m1b = bf4hi(w1); }
#pragma unroll
        for (int t = 0; t < 16; ++t) { const size_t off = (size_t)(t0 + t) * CWID_ + c0;
            const u32x4 vw = *(const u32x4*)(V + off), ww = *(const u32x4*)(W + off);
            const f32x4 va = bf4lo(vw), vb = bf4hi(vw);
            const f32x4 ca = k0a * m2a + k1a * m1a + k2a * va, cb = k0b * m2b + k1b * m1b + k2b * vb;
            *(u32x4*)(Z + off) = pack8(bf4lo(ww) * ca, bf4hi(ww) * cb);
            m2a = m1a; m2b = m1b; m1a = va; m1b = vb; }
    }
}
__device__ void carry_group(const Params& P, int g, unsigned char* smem) {
    const float2* abT = (const float2*)(P.ws + WS_ABT); const float* SLOC = (const float*)(P.ws + WS_SLOC); bf16_t* U = (bf16_t*)(P.ws + WS_U);
    float* sl = (float*)smem; unsigned* slw = (unsigned*)smem;
    float2* seg = (float2*)(smem + pg8::STAGE_BYTES + 64);
    const int tid = threadIdx.x, w = tid >> 6, p = tid & 63;
    const float2 a = abT[g * 64 + p];
    float2 a32 = a;
#pragma unroll
    for (int i = 0; i < 5; ++i) a32 = make_float2(a32.x * a32.x - a32.y * a32.y, 2.f * a32.x * a32.y);
    float sr = 0.f, si = 0.f;
    for (int half = 0; half < 2; ++half) {
        const f32x4* src = (const f32x4*)(SLOC + (size_t)(g * NCH_ + half * 256) * 128);
#pragma unroll
        for (int i = 0; i < 16; ++i) ((f32x4*)sl)[tid + 512 * i] = src[tid + 512 * i];
        __syncthreads();
        {
            float tr = 0.f, ti = 0.f;
#pragma unroll 8
            for (int c = 0; c < 32; ++c) { const float lr = sl[(32 * w + c) * 128 + p], li = sl[(32 * w + c) * 128 + 64 + p];
                const float nr = a.x * tr - a.y * ti + lr, ni = a.x * ti + a.y * tr + li; tr = nr; ti = ni; }
            seg[w * 64 + p] = make_float2(tr, ti);
        }
        __syncthreads();
        float wr_ = sr, wi_ = si;
#pragma unroll
        for (int j = 0; j < 8; ++j) { const float2 t = seg[j * 64 + p];
            const float nr = a32.x * sr - a32.y * si + t.x, ni = a32.x * si + a32.y * sr + t.y; sr = nr; si = ni;
            if (j + 1 == w) { wr_ = sr; wi_ = si; } }
#pragma unroll 8
        for (int c = 0; c < 32; ++c) { const float lr = sl[(32 * w + c) * 128 + p], li = sl[(32 * w + c) * 128 + 64 + p];
            slw[(32 * w + c) * 128 + p] = cvt_pk_bf16(wr_, wi_);
            const float nr = a.x * wr_ - a.y * wi_ + lr, ni = a.x * wi_ + a.y * wr_ + li; wr_ = nr; wi_ = ni; }
        __syncthreads();
#pragma unroll
        for (int i = 0; i < 4; ++i) { const int it = tid + 512 * i, c = it >> 3, p0 = (it & 7) * 8;
            const u32x4 w0 = *(const u32x4*)(slw + c * 128 + p0), w1 = *(const u32x4*)(slw + c * 128 + p0 + 4);
            u32x4 re, im;
            re.x = (w0.x & 0xffffu) | (w0.y << 16); re.y = (w0.z & 0xffffu) | (w0.w << 16); re.z = (w1.x & 0xffffu) | (w1.y << 16); re.w = (w1.z & 0xffffu) | (w1.w << 16);
            im.x = (w0.x >> 16) | (w0.y & 0xffff0000u); im.y = (w0.z >> 16) | (w0.w & 0xffff0000u); im.z = (w1.x >> 16) | (w1.y & 0xffff0000u); im.w = (w1.z >> 16) | (w1.w & 0xffff0000u);
            bf16_t* u = U + (size_t)(g * NCH_ + half * 256 + c) * LDU_ + KU_ + p0;
            *(u32x4*)u = re; *(u32x4*)(u + 64) = im; }
        __syncthreads();
    }
}

__global__ void __launch_bounds__(512, 2) hybrid_fwd(Params P) {
    extern __shared__ __attribute__((aligned(16))) unsigned char smem[];
    LAS unsigned char* lds = (LAS unsigned char*)smem;
    unsigned char* ws = P.ws;
    const int bid = blockIdx.x, nb = gridDim.x;
    const int lo = P.ph_lo, hi = P.ph_hi;
#define IN(k) (lo <= (k) && (k) < hi)
    volatile LAS unsigned* xb_st = (volatile LAS unsigned*)(lds + pg8::STAGE_BYTES);
    XcdBarrier xbar; xbar.bar = (unsigned*)(ws + WS_BAR); xbar.x = 0; xbar.st = xb_st;
    if (hi - lo > 1) {
        if (threadIdx.x < 4) xb_st[threadIdx.x] = 0u;
        __syncthreads();
        xbar = xcd_barrier_post((unsigned*)(ws + WS_BAR), xb_st);
    }
    if (lo == 0x7fffffff) cg::this_grid().sync();
#define SEAM(k) do { if (IN(k) && IN((k) + 1)) { xcd_barrier(xbar); } } while (0)
    bf16_t* H = (bf16_t*)P.out; bf16_t* V = (bf16_t*)P.out + (size_t)L_ * D_;
    bf16_t* YG = (bf16_t*)P.out; bf16_t* Y3 = (bf16_t*)P.out + (size_t)L_ * SW_; bf16_t* TMP = (bf16_t*)P.out + (size_t)L_ * D_;
    bf16_t* U = (bf16_t*)(ws + WS_U);

    if (IN(0)) { for (int idx = bid; idx < 1088; idx += nb) do_job(P, smem, idx < 576 ? idx : idx + 256); } SEAM(0);
    if (IN(1)) {
        pg8::Gemm g{H, (const bf16_t*)(ws + WS_WIN), D_, D_, D_}; pg8::StaticOrder S; S.init(L_, INW_, nb, bid);
        EpiG1 E{U, (bf16_t*)(ws + WS_SG), V, (bf16_t*)(ws + WS_W), (bf16_t*)(ws + WS_SR), (bf16_t*)(ws + WS_SC)};
        pg8::gemm_phase(lds, g, S, E);
    } SEAM(1);
    if (IN(2)) {
        const int nbs = nb >= 128 ? 64 : 0;
        if (bid < nbs || nbs == 0) {
            pg8::Gemm g{U, (const bf16_t*)(ws + WS_WST), LDU_, KU_, KU_}; pg8::BatchOrder S{64, nbs ? nbs : nb, bid, 1};
            EpiS1 E{(float*)(ws + WS_SLOC), (unsigned*)(ws + WS_CNT) + 2 * 64 * 64, &P, smem};
            pg8::gemm_phase(lds, g, S, E);
        }
        if (nbs == 0 || bid >= nbs) { phase_z(P, nbs, nb - nbs); for (int idx = bid - nbs; idx < 528; idx += nb - nbs) do_job(P, smem, idx < 512 ? 1344 + idx : 752 + (idx - 512)); }
    } SEAM(2);
    if (IN(3)) {
        const int nbs = nb >= 256 ? 128 : 0;
        if (bid < nbs || nbs == 0) {
            pg8::Gemm g{U, (const bf16_t*)(ws + WS_MC), LDU_, LDU_, LDU_}; pg8::BatchOrder S{128, nbs ? nbs : nb, bid, 2};
            EpiS2 E{YG};
            pg8::gemm_phase(lds, g, S, E);
        }
        if (bid >= nbs || nbs == 0) {
            pg8::Gemm g{(const bf16_t*)(ws + WS_PBF), (const bf16_t*)(ws + WS_WPLE), PLE_, PLE_, PLE_}; pg8::StaticOrder S; S.init(L_, D_, nbs ? nb - nbs : nb, nbs ? bid - nbs : bid);
            EpiStore E{(bf16_t*)(ws + WS_PE), D_};
            pg8::gemm_phase(lds, g, S, E);
            __syncthreads();
            for (int idx = nbs ? bid - nbs : bid; idx < 240; idx += (nbs ? nb - nbs : nb)) do_job(P, smem, 576 + idx + (idx >= 176 ? 16 : 0));
        }
    } SEAM(3);
    if (IN(4)) {
#define cntY3 ((unsigned*)(P.ws + WS_CNT) + 2 * 64 * 64 + 32 * 64)
#define cntMG (cntY3 + 64 * 64)
#define cntX1 (cntMG + 64 * 64)
        const bool has = (nb == 256);
#define MY_PM (8 * (bid & 7) + ((bid >> 3) & 7))
        { pg8::Gemm g{YG, (const bf16_t*)(ws + WS_WGLU), SW_, SW_, SW_}; pg8::StaticOrder S; S.init(L_, SW_, nb, bid);
          EpiGlu E{YG, (const bf16_t*)(ws + WS_SG), P.b_glu, Y3};
          pg8::gemm_phase(lds, g, S, E);
          if (has && bid < 128) panel_arrive(cntY3, MY_PM); }
        if (has) {
            if (bid < 128) {
                panel_wait(cntY3, MY_PM, 2u);
                { pg8::Gemm g{Y3, (const bf16_t*)(ws + WS_WSSO), SW_, SW_, SW_}; pg8::StaticOrder S; S.init(L_, D_, nb, bid);
                  EpiMerge<0> E{(const bf16_t*)(ws + WS_SR), nullptr, TMP}; pg8::gemm_phase(lds, g, S, E); }
                { pg8::Gemm g{(const bf16_t*)(ws + WS_Z), (const bf16_t*)(ws + WS_WCO), D_, D_, D_}; pg8::StaticOrder S; S.init(L_, D_, nb, bid);
                  EpiMerge<1> E{(const bf16_t*)(ws + WS_SC), TMP, (bf16_t*)(ws + WS_MERGED)}; pg8::gemm_phase(lds, g, S, E); }
            } else {
                { pg8::Gemm g{(const bf16_t*)(ws + WS_Z), (const bf16_t*)(ws + WS_WCO), D_, D_, D_}; pg8::StaticOrder S; S.init(L_, D_, nb, bid);
                  EpiMerge<0> E{(const bf16_t*)(ws + WS_SC), nullptr, TMP}; pg8::gemm_phase(lds, g, S, E); }
                panel_wait(cntY3, MY_PM, 2u);
                { pg8::Gemm g{Y3, (const bf16_t*)(ws + WS_WSSO), SW_, SW_, SW_}; pg8::StaticOrder S; S.init(L_, D_, nb, bid);
                  EpiMerge<1> E{(const bf16_t*)(ws + WS_SR), TMP, (bf16_t*)(ws + WS_MERGED)}; pg8::gemm_phase(lds, g, S, E); }
            }
            panel_arrive(cntMG, MY_PM);
            panel_wait(cntMG, MY_PM, 4u);
            pg8::Gemm g{(const bf16_t*)(ws + WS_MERGED), (const bf16_t*)(ws + WS_WO), D_, D_, D_}; pg8::StaticOrder S; S.init(L_, D_, nb, bid);
            { EpiX1 E{P.x, P.post_norm, (bf16_t*)(ws + WS_X1BF), PanelX{(float*)(ws + WS_MISC), (unsigned*)(ws + WS_CNT)}}; pg8::gemm_phase(lds, g, S, E); }
            asm volatile("s_waitcnt vmcnt(0)" ::: "memory"); __syncthreads();
            panel_arrive(cntX1, MY_PM);
            if (threadIdx.x < 4) { const int q = MY_PM, p0 = q < 16 ? 4 * q : (q < 32 ? 4 * (q - 16) : 2 * (q - 32)), np = q < 32 ? 4 : 2;
                if ((int)threadIdx.x < np) { unsigned spins = 0;
                    while (__hip_atomic_load(cntMG + 64 * (p0 + (int)threadIdx.x), __ATOMIC_RELAXED, __HIP_MEMORY_SCOPE_AGENT) < 4u) { __builtin_amdgcn_s_sleep(2); if (++spins > (1u << 21)) break; } } }
            panel_wait(cntX1, MY_PM, 4u);
            pg8::Gemm g7{(const bf16_t*)(ws + WS_X1BF), (const bf16_t*)(ws + WS_WG), D_, D_, D_}; pg8::StaticOrder S7; S7.init(L_, D_, nb, bid);
            EpiOut E7{(const bf16_t*)(ws + WS_PE), (const bf16_t*)(ws + WS_X1BF), P.ple_norm, P.out, PanelX{(float*)(ws + WS_MISC + 1 * MiB), (unsigned*)(ws + WS_CNT) + 64 * 64}}; pg8::gemm_phase(lds, g7, S7, E7);
        }
#undef MY_PM
#undef cntY3
#undef cntMG
#undef cntX1
    }
#undef IN
#undef SEAM
}


extern "C" void kernel_launch(void* const* d_in, const int* in_sizes, int n_in, void* d_out, int out_size, void* d_ws, size_t ws_size, hipStream_t stream) {
    constexpr int LDS_BYTES = pg8::STAGE_BYTES + 64 + 4096;
    static int grid = 0;
    if (grid == 0) {
        if (n_in != 22 || out_size != L_ * D_ || ws_size < WS_END) { fprintf(stderr, "kernel_launch: unexpected shapes (n_in %d out %d ws %zu)\n", n_in, out_size, ws_size); grid = -1; return; }
        int dev = 0, cus = 0, per_cu = 0;
        hipGetDevice(&dev); hipDeviceGetAttribute(&cus, hipDeviceAttributeMultiprocessorCount, dev);
        if (hipFuncSetAttribute((const void*)hybrid_fwd, hipFuncAttributeMaxDynamicSharedMemorySize, LDS_BYTES) != hipSuccess) { fprintf(stderr, "kernel_launch: hipFuncSetAttribute failed\n"); grid = -1; return; }
        hipOccupancyMaxActiveBlocksPerMultiprocessor(&per_cu, (const void*)hybrid_fwd, 512, LDS_BYTES);
        (void)hipGetLastError();
        if (per_cu < 1) per_cu = 1;
        grid = cus;
        fprintf(stderr, "kernel_launch: cus %d per_cu %d grid %d\n", cus, per_cu, grid);
    }
    if (grid < 0) return;
    Params P{};
    const float** f = (const float**)&P;
    for (int i = 0; i < 22; ++i) f[i] = (const float*)d_in[i];
    P.out = (float*)d_out; P.ws = (unsigned char*)d_ws;
    (void)hipMemsetAsync((unsigned char*)d_ws + WS_BAR, 0, 16384 + 2 * 64 * 256 + 32 * 256 + 3 * 64 * 256, stream);
#if ONE_LAUNCH
    P.ph_lo = 0; P.ph_hi = NPH;
    void* args[] = {&P};
    hipError_t e = hipLaunchCooperativeKernel((const void*)hybrid_fwd, dim3(grid), dim3(512), args, LDS_BYTES, stream);
    if (e != hipSuccess) fprintf(stderr, "cooperative launch failed: %s (grid %d)\n", hipGetErrorString(e), grid);
#else
    for (int ph = 0; ph < NPH; ++ph) {
        P.ph_lo = ph; P.ph_hi = ph + 1;
        hipLaunchKernelGGL(hybrid_fwd, dim3(grid), dim3(512), LDS_BYTES, stream, P);
    }
#endif
}
```

```cpp
#include <hip/hip_runtime.h>
#include <hip/hip_cooperative_groups.h>
#include <cstdio>
namespace cg = cooperative_groups;

#ifndef ONE_LAUNCH
#define ONE_LAUNCH 1
#endif

#define LAS __attribute__((address_space(3)))
typedef unsigned short bf16_t;
typedef short bf16x8 __attribute__((ext_vector_type(8)));
typedef float f32x4 __attribute__((ext_vector_type(4)));
typedef unsigned u32x4 __attribute__((ext_vector_type(4)));
typedef unsigned u32x2 __attribute__((ext_vector_type(2)));

constexpr int L_ = 16384, D_ = 1024, PLE_ = 256, SW_ = 512, NG_ = 32, CWID_ = 1024, INW_ = 7168;
constexpr int T_ = 32, NCH_ = L_ / T_  , KU_ = T_ * 16  , LDU_ = KU_ + 128  ;
constexpr float EPS_ = 1e-6f;
constexpr size_t MiB = 1024 * 1024;
constexpr size_t WS_WGLU = 0, WS_WSSO = WS_WGLU + 512 * 512 * 2, WS_WCO = WS_WSSO + 1024 * 512 * 2, WS_WO = WS_WCO + 2 * MiB, WS_WPLE = WS_WO + 2 * MiB,
                 WS_WG = WS_WPLE + 1024 * 256 * 2, WS_WIN = 8 * MiB, WS_MC = WS_WIN + 14 * MiB, WS_WST = WS_MC + 20 * MiB, WS_PBF = WS_WST + 8 * MiB,
                 WS_U = WS_PBF + 8 * MiB, WS_SLOC = WS_U + 20 * MiB, WS_SG = WS_SLOC + 8 * MiB, WS_W = WS_SG + 16 * MiB, WS_SR = WS_W + 32 * MiB,
                 WS_SC = WS_SR + 32 * MiB, WS_Z = WS_SC + 32 * MiB, WS_MISC = WS_Z + 32 * MiB, WS_END = WS_MISC + 3 * MiB;
constexpr size_t WS_ABT = WS_MISC + 2 * MiB, WS_BAR = WS_MISC + 2 * MiB + 64 * 1024, WS_CNT = WS_BAR + 16384;
constexpr size_t WS_PE = WS_W, WS_MERGED = WS_MC, WS_O = WS_SR, WS_X1BF = WS_SC, WS_E = WS_Z;
constexpr int NPH = 5;

struct Params {
    const float *x, *p, *pre_norm, *w_in, *a_re, *a_im, *log_step, *b_re, *b_im, *c_re, *c_im, *d_skip, *w_glu, *b_glu, *w_ssm_out, *conv_w, *w_conv_out, *w_o,
        *post_norm, *w_ple, *w_ple_gate, *ple_norm;
    float* out; unsigned char* ws; int ph_lo, ph_hi;
};

typedef __bf16 bf16x2_t __attribute__((ext_vector_type(2)));
typedef float f32x2_t __attribute__((ext_vector_type(2)));
__device__ __forceinline__ unsigned cvt_pk_bf16(float lo, float hi) { f32x2_t v = {lo, hi}; bf16x2_t b = __builtin_convertvector(v, bf16x2_t); return __builtin_bit_cast(unsigned, b); }
__device__ __forceinline__ float bflo(unsigned w) { return __uint_as_float(w << 16); }
__device__ __forceinline__ float bfhi(unsigned w) { return __uint_as_float(w & 0xffff0000u); }
__device__ __forceinline__ f32x4 bf4lo(u32x4 w) { return (f32x4){bflo(w.x), bfhi(w.x), bflo(w.y), bfhi(w.y)}; }
__device__ __forceinline__ f32x4 bf4hi(u32x4 w) { return (f32x4){bflo(w.z), bfhi(w.z), bflo(w.w), bfhi(w.w)}; }
__device__ __forceinline__ u32x4 pack8(f32x4 a, f32x4 b) { u32x4 w; w.x = cvt_pk_bf16(a[0], a[1]); w.y = cvt_pk_bf16(a[2], a[3]); w.z = cvt_pk_bf16(b[0], b[1]); w.w = cvt_pk_bf16(b[2], b[3]); return w; }
typedef __amdgpu_buffer_rsrc_t rsrc_t;
__device__ __forceinline__ void wt16b(const bf16_t* base, size_t elem, u32x4 v) {
    const rsrc_t r = __builtin_amdgcn_make_buffer_rsrc((void*)base, (short)0, 0x7ffffff0, 0x00020000);
    __builtin_amdgcn_raw_buffer_store_b128(v, r, (unsigned)(elem * 2), 0, 16); }
__device__ __forceinline__ void panel_arrive(unsigned* cnt, int pm) { if (threadIdx.x == 0) __hip_atomic_fetch_add(cnt + 64 * pm, 1u, __ATOMIC_RELAXED, __HIP_MEMORY_SCOPE_AGENT); }
__device__ __forceinline__ void panel_wait(unsigned* cnt, int pm, unsigned need) {
    if (threadIdx.x == 0) { unsigned spins = 0;
        while (__hip_atomic_load(cnt + 64 * pm, __ATOMIC_RELAXED, __HIP_MEMORY_SCOPE_AGENT) < need) { __builtin_amdgcn_s_sleep(2); if (++spins > (1u << 21)) break; }
        __builtin_amdgcn_fence(__ATOMIC_ACQUIRE, "agent"); asm volatile("s_waitcnt vmcnt(0)" ::: "memory"); }
    __syncthreads();
}
__device__ __forceinline__ float sigm(float x) { return __builtin_amdgcn_rcpf(1.f + __expf(-x)); }
__device__ __forceinline__ f32x4 sigm4(f32x4 v) { return (f32x4){sigm(v[0]), sigm(v[1]), sigm(v[2]), sigm(v[3])}; }
__device__ __forceinline__ float gelu_t(float x) { return x * sigm(1.5957691216f * (x + 0.044715f * x * x * x)); }
__device__ __forceinline__ f32x4 gelu4(f32x4 v) { return (f32x4){gelu_t(v[0]), gelu_t(v[1]), gelu_t(v[2]), gelu_t(v[3])}; }

#define XB_TMO      128
#define XB_XCNT(j)  (256  + 64 * (j))
#define XB_XSUB(j)  (1280 + 64 * (j))
#define XB_XGEN(j)  (2304 + 64 * (j))
#define XB_TOP      3328
#define XB_TOPGEN   3392
#define XCD_BAR_WORDS 3456
#define XB_SPIN_CAP (1u << 18)
__device__ __forceinline__ unsigned xb_ld(unsigned* p)              { return __hip_atomic_load(p, __ATOMIC_RELAXED, __HIP_MEMORY_SCOPE_AGENT); }
__device__ __forceinline__ unsigned xb_add(unsigned* p, unsigned v) { return __hip_atomic_fetch_add(p, v, __ATOMIC_RELAXED, __HIP_MEMORY_SCOPE_AGENT); }
__device__ __forceinline__ unsigned xb_xcc_id() { return (unsigned)__builtin_amdgcn_s_getreg((3 << 11) | 20) & 0xFu; }
#define XB_SPIN(cond, bar) do { unsigned _sp = 0; while (cond) { __builtin_amdgcn_s_sleep(1); \
    if ((++_sp & 255u) == 0u) { if (xb_ld(&(bar)[XB_TMO])) break; if (_sp > XB_SPIN_CAP) { atomicAdd(&(bar)[XB_TMO], 1u); break; } } } } while (0)

struct XcdBarrier {
    unsigned* bar; unsigned x;
    volatile LAS unsigned* st;
};

__device__ __forceinline__ XcdBarrier xcd_barrier_post(unsigned* bar, volatile LAS unsigned* st) {
    XcdBarrier b; b.bar = bar; b.x = xb_xcc_id(); b.st = st;
    if (threadIdx.x == 0) (void)xb_add(&bar[XB_XCNT(b.x)], 1u);
    return b;
}
__device__ __forceinline__ void xcd_barrier_complete(unsigned* bar, unsigned x, unsigned& nloc, unsigned& nx) {
    const unsigned G = gridDim.x * gridDim.y * gridDim.z;
    unsigned sum, cnt, mine, sp = 0u;
    for (;;) {
        sum = 0u; cnt = 0u; mine = 0u;
#pragma unroll
        for (unsigned j = 0; j < 16; ++j) { const unsigned c = xb_ld(&bar[XB_XCNT(j)]); sum += c; cnt += (c > 0u) ? 1u : 0u; mine = (j == x) ? c : mine; }
        if (sum == G) break;
        __builtin_amdgcn_s_sleep(1);
        if ((++sp & 255u) == 0u) { if (xb_ld(&bar[XB_TMO])) break; if (sp > XB_SPIN_CAP) { atomicAdd(&bar[XB_TMO], 1u); break; } }
    }
    nloc = mine > 0u ? mine : 1u; nx = cnt > 0u ? cnt : 1u;
}

__device__ __forceinline__ void xcd_barrier(const XcdBarrier& b) {
    asm volatile("s_waitcnt vmcnt(0)" ::: "memory");
    __syncthreads();
    if (threadIdx.x == 0) {
        unsigned* bar = b.bar;
        __builtin_amdgcn_s_waitcnt(0);
        unsigned nloc = b.st[0], nx = b.st[1];
        if (nloc == 0u) { xcd_barrier_complete(bar, b.x, nloc, nx); b.st[0] = nloc; b.st[1] = nx; }
        const unsigned old = xb_add(&bar[XB_XSUB(b.x)], 1u);
        const unsigned gen = old / nloc;
        if (old + 1u == (gen + 1u) * nloc) {
            __builtin_amdgcn_fence(__ATOMIC_RELEASE, "agent");
            asm volatile("s_waitcnt vmcnt(0)" ::: "memory");
            const unsigned og = xb_add(&bar[XB_TOP], 1u);
            const unsigned tg = og / nx;
            if (og + 1u == (tg + 1u) * nx) xb_add(&bar[XB_TOPGEN], 1u);
            else XB_SPIN(xb_ld(&bar[XB_TOPGEN]) == tg, bar);
            __builtin_amdgcn_fence(__ATOMIC_ACQUIRE, "agent");
            xb_add(&bar[XB_XGEN(b.x)], 1u);
            asm volatile("s_waitcnt vmcnt(0)" ::: "memory");
        } else {
            XB_SPIN(xb_ld(&bar[XB_XGEN(b.x)]) == gen, bar);
            __builtin_amdgcn_fence(__ATOMIC_ACQUIRE, "agent");
            asm volatile("s_waitcnt vmcnt(0)" ::: "memory");
        }
    }
    __syncthreads();
}

namespace pg8 {
constexpr int BM = 256, BK = 64, HALF = 128, HTB = HALF * BK * 2, STAGE_BYTES = 8 * HTB, NXCD = 8, WGM = 8;
__device__ __forceinline__ int lds_byte(int r, int c) { const int st = (r >> 4) * 2 + (c >> 5), rr = r & 15, cc = c & 31, ob = rr * 64 + cc * 2; return st * 1024 + (ob ^ (((ob >> 9) & 1) << 5)); }
__device__ __forceinline__ void stage_rc(int b, int& R, int& C) { const int st = b / 1024, sb = b % 1024, swz = sb ^ (((sb >> 9) & 1) << 5); R = (st >> 1) * 16 + swz / 64; C = (st & 1) * 32 + (swz % 64) / 2; }
__device__ __forceinline__ int perm32(int rho) { const int n = rho >> 4, i = rho & 15; return 8 * (i >> 2) + 4 * n + (i & 3); }
struct Unit { int pm, pn; };
struct Gemm { const bf16_t* A; const bf16_t* Bt; int lda, ldb, K; };

struct StaticOrder {
    int nM, nN, nwg, G, c;
    __device__ void init(int M, int N, int G_, int c_) { nM = M / BM; nN = N / BM; nwg = nM * nN; G = G_; c = c_; }
    __device__ bool next(int i, Unit& u) const {
        const long Lx = (long)i * G + c; if (c < 0 || Lx >= nwg) return false;
        int wgid = (int)Lx; { const int q = nwg / NXCD, r = nwg % NXCD, xcd = wgid % NXCD, off = wgid / NXCD; wgid = (xcd < r ? xcd * (q + 1) : r * (q + 1) + (xcd - r) * q) + off; }
        const int nig = WGM * nN, gid = wgid / nig, fm = gid * WGM, gsz = (nM - fm) < WGM ? (nM - fm) : WGM;
        u.pm = fm + ((wgid % nig) % gsz); u.pn = (wgid % nig) / gsz; return true;
    }
};
struct BatchOrder {
    int nunits, G, c, mode;
    __device__ bool next(int i, Unit& u) const {
        const int Lx = i * G + c; if (c < 0 || Lx >= nunits) return false;
        const int xcd = Lx & 7, slot = Lx >> 3;
        if (mode == 1) { const int g = xcd * 4 + (slot >> 1); u.pm = 2 * g + (slot & 1); u.pn = g; }
        else { const int g = xcd * 4 + (slot >> 2); u.pm = 2 * g + ((slot >> 1) & 1); u.pn = 2 * g + (slot & 1); }
        return true;
    }
};

typedef f32x4 AccT[2][2][4][2];
template <bool INIT, class Epi, class Sched>
__device__ __forceinline__ void gemm_phase_acc(LAS unsigned char* lds, const Gemm g, const Sched& S, const Epi& E, AccT& acc) {
    const int tid = threadIdx.x, wid = __builtin_amdgcn_readfirstlane(tid >> 6), lane = tid & 63, wr = wid >> 2, wc = wid & 3, fr = lane & 15, fq = lane >> 4;
    const int K = g.K, nt = K / BK;
    unsigned voffA[2], voffB[2];
#pragma unroll
    for (int i = 0; i < 2; ++i) { int R, C; stage_rc(tid * 16 + i * 8192, R, C); const int Rb = Epi::PERM ? ((R & ~31) + perm32(R & 31)) : R;
        voffA[i] = (unsigned)(R * g.lda + C) * 2u; voffB[i] = (unsigned)(Rb * g.ldb + C) * 2u; }
    const size_t kstep = (size_t)(BK * 2);
    const size_t hstepA = (size_t)HALF * g.lda * 2, hstepB = (size_t)HALF * g.ldb * 2;
    const size_t tstepA = 2 * hstepA, tstepB = 2 * hstepB;
    const unsigned ldsw = (unsigned)wid * 1024u;
    const int aoff = lds_byte(wr * 64 + fr, fq * 8), boff = lds_byte(wc * 32 + fr, fq * 8);
#define PG8_SA(b, h) (((b) * 2 + (h)) * HTB)
#define PG8_SB(b, h) ((4 + (b) * 2 + (h)) * HTB)
#define PG8_STAGE(bufoff, gbase, voff) do { _Pragma("unroll") for (int _i = 0; _i < 2; ++_i) \
        __builtin_amdgcn_global_load_lds((const unsigned*)((const char*)(gbase) + (voff)[_i]), (LAS unsigned*)(lds + (bufoff) + ldsw + _i * 8192), 16, 0, 0); } while (0)
#define PG8_LDA(dst, b, h) do { _Pragma("unroll") for (int m = 0; m < 4; ++m) _Pragma("unroll") for (int k = 0; k < 2; ++k) dst[m][k] = *(const LAS bf16x8*)(lds + PG8_SA(b, h) + aoff + m * 2048 + k * 1024); } while (0)
#define PG8_LDB(dst, b, h) do { _Pragma("unroll") for (int n = 0; n < 2; ++n) _Pragma("unroll") for (int k = 0; k < 2; ++k) dst[n][k] = *(const LAS bf16x8*)(lds + PG8_SB(b, h) + boff + n * 2048 + k * 1024); } while (0)
#define PG8_MMA(ai, bj, At, Bt) do { __builtin_amdgcn_s_setprio(1); _Pragma("unroll") for (int m = 0; m < 4; ++m) _Pragma("unroll") for (int n = 0; n < 2; ++n) _Pragma("unroll") for (int k = 0; k < 2; ++k) \
        acc[ai][bj][m][n] = __builtin_amdgcn_mfma_f32_16x16x32_bf16(Bt[n][k], At[m][k], acc[ai][bj][m][n], 0, 0, 0); __builtin_amdgcn_s_setprio(0); } while (0)
#define PG8_WAIT_V(n) asm volatile("s_waitcnt vmcnt(" #n ")" ::: "memory")
#define PG8_WAIT_L(n) asm volatile("s_waitcnt lgkmcnt(" #n ")" ::: "memory")
#define PG8_BAR __builtin_amdgcn_s_barrier()
#define PG8_SCHED __builtin_amdgcn_sched_barrier(0)
    Unit cur, nxt; int ui = 0;
    if (!S.next(0, cur)) return;
    if (INIT) {
#pragma unroll
    for (int a = 0; a < 2; ++a)
#pragma unroll
        for (int b = 0; b < 2; ++b)
#pragma unroll
            for (int m = 0; m < 4; ++m)
#pragma unroll
                for (int n = 0; n < 2; ++n) acc[a][b][m][n] = (f32x4){0.f, 0.f, 0.f, 0.f};
    }
    bf16x8 At[4][2], B0[2][2], B1[2][2];
    const char* cA = (const char*)g.A + (size_t)cur.pm * tstepA; const char* cB = (const char*)g.Bt + (size_t)cur.pn * tstepB;
    PG8_STAGE(PG8_SB(0, 0), cB, voffB); PG8_STAGE(PG8_SB(0, 1), cB + hstepB, voffB); PG8_STAGE(PG8_SA(0, 0), cA, voffA); PG8_STAGE(PG8_SA(0, 1), cA + hstepA, voffA);
    if (wr == 1) PG8_BAR;
    PG8_WAIT_V(2); PG8_BAR;
    PG8_STAGE(PG8_SB(1, 0), cB + kstep, voffB); PG8_STAGE(PG8_SA(1, 0), cA + kstep, voffA); PG8_STAGE(PG8_SB(1, 1), cB + hstepB + kstep, voffB);
    PG8_WAIT_V(6); PG8_BAR;
    for (;;) {
        const bool has_next = S.next(ui + 1, nxt);
        const char* nA = has_next ? (const char*)g.A + (size_t)nxt.pm * tstepA : cA; const char* nB = has_next ? (const char*)g.Bt + (size_t)nxt.pn * tstepB : cB;
#pragma unroll 1
        for (int t = 0; t < nt; t += 2) {
            const bool last = (t == nt - 2);
            const char* a1 = cA + (size_t)(t + 1) * kstep;
            const char* a2 = last ? nA : cA + (size_t)(t + 2) * kstep; const char* b2 = last ? nB : cB + (size_t)(t + 2) * kstep;
            const char* a3 = a2 + kstep; const char* b3 = b2 + kstep;
            PG8_LDB(B0, 0, 0); PG8_LDB(B1, 0, 1); PG8_SCHED; PG8_LDA(At, 0, 0); PG8_STAGE(PG8_SA(1, 1), a1 + hstepA, voffA);
            PG8_WAIT_V(8); PG8_WAIT_L(0); PG8_BAR; PG8_MMA(0, 0, At, B0); PG8_MMA(0, 1, At, B1); PG8_BAR; PG8_SCHED;
            PG8_LDA(At, 0, 1); PG8_STAGE(PG8_SB(0, 0), b2, voffB); PG8_STAGE(PG8_SB(0, 1), b2 + hstepB, voffB); PG8_STAGE(PG8_SA(0, 0), a2, voffA);
            PG8_WAIT_V(8); PG8_WAIT_L(0); PG8_BAR; PG8_MMA(1, 0, At, B0); PG8_MMA(1, 1, At, B1); PG8_BAR; PG8_SCHED;
            PG8_LDB(B0, 1, 0); PG8_LDB(B1, 1, 1); PG8_SCHED; PG8_LDA(At, 1, 0); PG8_STAGE(PG8_SA(0, 1), a2 + hstepA, voffA);
            PG8_WAIT_V(8); PG8_WAIT_L(0); PG8_BAR; PG8_MMA(0, 0, At, B0); PG8_MMA(0, 1, At, B1); PG8_BAR; PG8_SCHED;
            PG8_LDA(At, 1, 1); PG8_STAGE(PG8_SB(1, 0), b3, voffB); PG8_STAGE(PG8_SB(1, 1), b3 + hstepB, voffB); PG8_STAGE(PG8_SA(1, 0), a3, voffA);
            PG8_WAIT_V(8); PG8_WAIT_L(0); PG8_BAR; PG8_MMA(1, 0, At, B0); PG8_MMA(1, 1, At, B1); PG8_BAR; PG8_SCHED;
        }
        if (wr == 0) PG8_BAR;
        if constexpr (!Epi::AFTER_DRAIN) E(acc, cur, wr, wc, fr, fq);
        if (!has_next) break;
#pragma unroll
        for (int a = 0; a < 2; ++a)
#pragma unroll
            for (int b = 0; b < 2; ++b)
#pragma unroll
                for (int m = 0; m < 4; ++m)
#pragma unroll
                    for (int n = 0; n < 2; ++n) acc[a][b][m][n] = (f32x4){0.f, 0.f, 0.f, 0.f};
        cur = nxt; cA = nA; cB = nB; ++ui;
        if (wr == 1) PG8_BAR;
    }
    PG8_WAIT_V(0);
    PG8_BAR;
    if constexpr (Epi::AFTER_DRAIN) E(acc, cur, wr, wc, fr, fq);
#undef PG8_SA
#undef PG8_SB
#undef PG8_STAGE
#undef PG8_LDA
#undef PG8_LDB
#undef PG8_MMA
#undef PG8_WAIT_V
#undef PG8_WAIT_L
#undef PG8_BAR
#undef PG8_SCHED
}
template <class Epi, class Sched>
__device__ __forceinline__ void gemm_phase(LAS unsigned char* lds, const Gemm g, const Sched& S, const Epi& E) { AccT acc; gemm_phase_acc<true>(lds, g, S, E, acc); }
}
using pg8::Unit;
typedef f32x4 Acc[2][2][4][2];

#define EPI_ROWS(...) _Pragma("unroll") for (int ai = 0; ai < 2; ++ai) _Pragma("unroll") for (int m = 0; m < 4; ++m) { const int row = row0 + ai * 128 + m * 16; __VA_ARGS__ }

struct EpiG1 {
    static constexpr bool PERM = true, AFTER_DRAIN = false;
    bf16_t *U, *SG, *V, *W, *SR, *SC;
    __device__ __forceinline__ void operator()(const Acc& acc, const Unit& u, int wr, int wc, int fr, int fq) const {
        const int row0 = u.pm * 256 + wr * 64 + fr, cw = wc * 32 + 8 * fq, pn = u.pn;
        if (pn < 2) {
            EPI_ROWS(
                const int c = row >> 5, tt = row & 31;
                _Pragma("unroll") for (int bj = 0; bj < 2; ++bj) { const int col = pn * 256 + bj * 128 + cw; const int g = col >> 4, h0 = col & 15;
                    *(u32x4*)(U + ((size_t)(g * NCH_ + c)) * LDU_ + tt * 16 + h0) = pack8(acc[ai][bj][m][0], acc[ai][bj][m][1]); } )
        } else if (pn < 4) {
            EPI_ROWS(
                _Pragma("unroll") for (int bj = 0; bj < 2; ++bj) { const int col = (pn - 2) * 256 + bj * 128 + cw; const f32x4 a = acc[ai][bj][m][0], b = acc[ai][bj][m][1];
                    *(u32x4*)(SG + (size_t)row * SW_ + col) = pack8(a * sigm4(a), b * sigm4(b)); } )
        } else if (pn < 12) {
            EPI_ROWS(
                const int col = (pn - 4) * 128 + cw;
                *(u32x4*)(V + (size_t)row * CWID_ + col) = pack8(acc[ai][0][m][0] * acc[ai][1][m][0], acc[ai][0][m][1] * acc[ai][1][m][1]); )
        } else if (pn < 20) {
            EPI_ROWS(
                const int col = (pn - 12) * 128 + cw; const f32x4 ga = acc[ai][1][m][0], gb = acc[ai][1][m][1];
                *(u32x4*)(W + (size_t)row * CWID_ + col) = pack8(acc[ai][0][m][0] * (ga * sigm4(ga)), acc[ai][0][m][1] * (gb * sigm4(gb))); )
        } else {
            bf16_t* dst = pn < 24 ? SR : SC; const int pb = pn < 24 ? pn - 20 : pn - 24;
            EPI_ROWS(
                _Pragma("unroll") for (int bj = 0; bj < 2; ++bj) { const int col = pb * 256 + bj * 128 + cw;
                    *(u32x4*)(dst + (size_t)row * D_ + col) = pack8(acc[ai][bj][m][0], acc[ai][bj][m][1]); } )
        }
    }
};
__device__ void carry_group(const Params& P, int g, unsigned char* smem);
struct EpiS1 {
    static constexpr bool PERM = false, AFTER_DRAIN = true;
    float* SLOC; unsigned* gcnt; const Params* P; unsigned char* smem;
    __device__ __forceinline__ void operator()(const Acc& acc, const Unit& u, int wr, int wc, int fr, int fq) const {
        const int row0 = u.pm * 256 + wr * 64 + fr;
        EPI_ROWS(
            float* rp = SLOC + (size_t)row * 128 + wc * 32 + 4 * fq; *(f32x4*)rp = acc[ai][0][m][0]; *(f32x4*)(rp + 16) = acc[ai][0][m][1]; )
        asm volatile("s_waitcnt vmcnt(0)" ::: "memory");
        __syncthreads();
        unsigned* flag = (unsigned*)smem;
        if (threadIdx.x == 0) {
            __builtin_amdgcn_fence(__ATOMIC_RELEASE, "agent");
            asm volatile("s_waitcnt vmcnt(0)" ::: "memory");
            const unsigned old = __hip_atomic_fetch_add(gcnt + 64 * u.pn, 1u, __ATOMIC_RELAXED, __HIP_MEMORY_SCOPE_AGENT);
            if (old == 1u) { __builtin_amdgcn_fence(__ATOMIC_ACQUIRE, "agent"); asm volatile("s_waitcnt vmcnt(0)" ::: "memory"); }
            flag[0] = old;
        }
        __syncthreads();
        const unsigned old = flag[0];
        __syncthreads();
        if (old == 1u) carry_group(*P, u.pn, smem);
    }
};
struct EpiS2 {
    static constexpr bool PERM = true, AFTER_DRAIN = false;
    bf16_t* YG;
    __device__ __forceinline__ void operator()(const Acc& acc, const Unit& u, int wr, int wc, int fr, int fq) const {
        const int g = u.pm >> 1, c0 = (u.pm & 1) * 256 + wr * 64 + fr, n0 = (u.pn & 1) * 256 + wc * 32 + 8 * fq;
#pragma unroll
        for (int ai = 0; ai < 2; ++ai)
#pragma unroll
            for (int m = 0; m < 4; ++m) { const int c = c0 + ai * 128 + m * 16;
#pragma unroll
                for (int bj = 0; bj < 2; ++bj) { const int n = n0 + bj * 128, t = n >> 4, h0 = n & 15;
                    *(u32x4*)(YG + (size_t)(c * T_ + t) * SW_ + g * 16 + h0) = pack8(gelu4(acc[ai][bj][m][0]), gelu4(acc[ai][bj][m][1])); } }
    }
};
struct EpiStore {
    static constexpr bool PERM = true, AFTER_DRAIN = false;
    bf16_t* O; int ldc;
    __device__ __forceinline__ void operator()(const Acc& acc, const Unit& u, int wr, int wc, int fr, int fq) const {
        const int row0 = u.pm * 256 + wr * 64 + fr, col0 = u.pn * 256 + wc * 32 + 8 * fq;
        EPI_ROWS(
            _Pragma("unroll") for (int bj = 0; bj < 2; ++bj) *(u32x4*)(O + (size_t)row * ldc + col0 + bj * 128) = pack8(acc[ai][bj][m][0], acc[ai][bj][m][1]); )
    }
};
struct EpiGlu {
    static constexpr bool PERM = true, AFTER_DRAIN = false;
    const bf16_t *YG, *SG; const float* bglu; bf16_t* Y3;
    __device__ __forceinline__ void operator()(const Acc& acc, const Unit& u, int wr, int wc, int fr, int fq) const {
        const int row0 = u.pm * 256 + wr * 64 + fr, col0 = u.pn * 256 + wc * 32 + 8 * fq;
        f32x4 b0[2], b1[2];
#pragma unroll
        for (int bj = 0; bj < 2; ++bj) { b0[bj] = *(const f32x4*)(bglu + col0 + bj * 128); b1[bj] = *(const f32x4*)(bglu + col0 + bj * 128 + 4); }
#pragma unroll
        for (int ai = 0; ai < 2; ++ai) {
            u32x4 yw[4][2], sw[4][2];
#pragma unroll
            for (int m = 0; m < 4; ++m)
#pragma unroll
                for (int bj = 0; bj < 2; ++bj) { const size_t off = (size_t)(row0 + ai * 128 + m * 16) * SW_ + col0 + bj * 128; yw[m][bj] = *(const u32x4*)(YG + off); sw[m][bj] = *(const u32x4*)(SG + off); }
#pragma unroll
            for (int m = 0; m < 4; ++m)
#pragma unroll
                for (int bj = 0; bj < 2; ++bj) { const size_t off = (size_t)(row0 + ai * 128 + m * 16) * SW_ + col0 + bj * 128;
                    wt16b(Y3, off, pack8(bf4lo(yw[m][bj]) * sigm4(acc[ai][bj][m][0] + b0[bj]) * bf4lo(sw[m][bj]), bf4hi(yw[m][bj]) * sigm4(acc[ai][bj][m][1] + b1[bj]) * bf4hi(sw[m][bj]))); }
        }
    }
};
template <int MODE> struct EpiMerge {
    static constexpr bool PERM = true, AFTER_DRAIN = false;
    const bf16_t *S, *TMPI; bf16_t* O;
    __device__ __forceinline__ void operator()(const Acc& acc, const Unit& u, int wr, int wc, int fr, int fq) const {
        const int row0 = u.pm * 256 + wr * 64 + fr, col0 = u.pn * 256 + wc * 32 + 8 * fq;
#pragma unroll
        for (int ai = 0; ai < 2; ++ai) {
            u32x4 sw[4][2], tw[4][2];
#pragma unroll
            for (int m = 0; m < 4; ++m)
#pragma unroll
                for (int bj = 0; bj < 2; ++bj) { const size_t off = (size_t)(row0 + ai * 128 + m * 16) * D_ + col0 + bj * 128; sw[m][bj] = *(const u32x4*)(S + off); if (MODE == 1) tw[m][bj] = *(const u32x4*)(TMPI + off); }
#pragma unroll
            for (int m = 0; m < 4; ++m)
#pragma unroll
                for (int bj = 0; bj < 2; ++bj) { const size_t off = (size_t)(row0 + ai * 128 + m * 16) * D_ + col0 + bj * 128;
                    f32x4 a = sigm4(bf4lo(sw[m][bj])) * acc[ai][bj][m][0], b = sigm4(bf4hi(sw[m][bj])) * acc[ai][bj][m][1];
                    if (MODE == 1) { a += bf4lo(tw[m][bj]); b += bf4hi(tw[m][bj]); }
                    if (MODE == 1) wt16b(O, off, pack8(a, b)); else *(u32x4*)(O + off) = pack8(a, b); }
        }
    }
};
struct EpiMergeMid {
    static constexpr bool PERM = true, AFTER_DRAIN = false;
    const bf16_t *SR, *SC;
    __device__ __forceinline__ void operator()(Acc& acc, const Unit& u, int wr, int wc, int fr, int fq) const {
        const int row0 = u.pm * 256 + wr * 64 + fr, col0 = u.pn * 256 + wc * 32 + 8 * fq;
#pragma unroll
        for (int ai = 0; ai < 2; ++ai) {
            u32x4 rw[4][2], cw[4][2];
#pragma unroll
            for (int m = 0; m < 4; ++m)
#pragma unroll
                for (int bj = 0; bj < 2; ++bj) { const size_t off = (size_t)(row0 + ai * 128 + m * 16) * D_ + col0 + bj * 128; rw[m][bj] = *(const u32x4*)(SR + off); cw[m][bj] = *(const u32x4*)(SC + off); }
#pragma unroll
            for (int m = 0; m < 4; ++m)
#pragma unroll
                for (int bj = 0; bj < 2; ++bj) { const f32x4 ca = sigm4(bf4lo(cw[m][bj])), cb = sigm4(bf4hi(cw[m][bj])), ra = sigm4(bf4lo(rw[m][bj])), rb = sigm4(bf4hi(rw[m][bj]));
#pragma unroll
                    for (int j = 0; j < 4; ++j) { acc[ai][bj][m][0][j] *= ca[j] * __builtin_amdgcn_rcpf(fmaxf(ra[j], 1e-30f)); acc[ai][bj][m][1][j] *= cb[j] * __builtin_amdgcn_rcpf(fmaxf(rb[j], 1e-30f)); } }
        }
    }
};
struct EpiMergeFin {
    static constexpr bool PERM = true, AFTER_DRAIN = false;
    const bf16_t* SR; bf16_t* O;
    __device__ __forceinline__ void operator()(Acc& acc, const Unit& u, int wr, int wc, int fr, int fq) const {
        const int row0 = u.pm * 256 + wr * 64 + fr, col0 = u.pn * 256 + wc * 32 + 8 * fq;
        u32x4 rw[2][4][2];
#pragma unroll
        for (int ai = 0; ai < 2; ++ai)
#pragma unroll
            for (int m = 0; m < 4; ++m)
#pragma unroll
                for (int bj = 0; bj < 2; ++bj) rw[ai][m][bj] = *(const u32x4*)(SR + (size_t)(row0 + ai * 128 + m * 16) * D_ + col0 + bj * 128);
#pragma unroll
        for (int ai = 0; ai < 2; ++ai)
#pragma unroll
            for (int m = 0; m < 4; ++m)
#pragma unroll
                for (int bj = 0; bj < 2; ++bj) { const f32x4 ra = sigm4(bf4lo(rw[ai][m][bj])), rb = sigm4(bf4hi(rw[ai][m][bj])); f32x4 a = acc[ai][bj][m][0], b = acc[ai][bj][m][1];
#pragma unroll
                    for (int j = 0; j < 4; ++j) { a[j] *= fmaxf(ra[j], 1e-30f); b[j] *= fmaxf(rb[j], 1e-30f); }
                    wt16b(O, (size_t)(row0 + ai * 128 + m * 16) * D_ + col0 + bj * 128, pack8(a, b)); }
    }
};
struct PanelX { float* part; unsigned* cnt; };
__device__ __forceinline__ void panel_rstd(const PanelX& px, const Unit& u, int wr, int wc, int fr, int fq, float (&s)[2][4]) {
    const int row0 = u.pm * 256 + wr * 64 + fr;
    const rsrc_t pr = __builtin_amdgcn_make_buffer_rsrc((void*)px.part, (short)0, L_ * 16 * 4, 0x00020000);
#pragma unroll
    for (int ai = 0; ai < 2; ++ai)
#pragma unroll
        for (int m = 0; m < 4; ++m) { float t = s[ai][m]; t += __shfl_xor(t, 16); t += __shfl_xor(t, 32);
            if (fq == 0) __builtin_amdgcn_raw_buffer_store_b32(__float_as_uint(t), pr, (unsigned)(((row0 + ai * 128 + m * 16) * 16 + u.pn * 4 + wc) * 4), 0, 16); }
    asm volatile("s_waitcnt vmcnt(0)" ::: "memory");
    __builtin_amdgcn_s_barrier();
    if (threadIdx.x == 0) {
        unsigned* c = px.cnt + 64 * u.pm;
        __hip_atomic_fetch_add(c, 1u, __ATOMIC_RELAXED, __HIP_MEMORY_SCOPE_AGENT);
        unsigned spins = 0;
        while (__hip_atomic_load(c, __ATOMIC_RELAXED, __HIP_MEMORY_SCOPE_AGENT) < 4u) { __builtin_amdgcn_s_sleep(4); if (++spins > (1u << 20)) break; }
    }
    asm volatile("s_waitcnt vmcnt(0) lgkmcnt(0)" ::: "memory");
    __builtin_amdgcn_s_barrier();
    asm volatile("" ::: "memory");
    __builtin_amdgcn_fence(__ATOMIC_ACQUIRE, "agent");
    asm volatile("s_waitcnt vmcnt(0)" ::: "memory");
#pragma unroll
    for (int ai = 0; ai < 2; ++ai)
#pragma unroll
        for (int m = 0; m < 4; ++m) { const u32x4 q = __builtin_amdgcn_raw_buffer_load_b128(pr, (unsigned)(((row0 + ai * 128 + m * 16) * 16 + fq * 4) * 4), 0, 16);
            float t = (__uint_as_float(q.x) + __uint_as_float(q.y)) + (__uint_as_float(q.z) + __uint_as_float(q.w)); t += __shfl_xor(t, 16); t += __shfl_xor(t, 32);
            s[ai][m] = rsqrtf(t * (1.0f / D_) + EPS_); }
}
__device__ __forceinline__ float sq8(f32x4 a, f32x4 b) { return ((a[0] * a[0] + a[1] * a[1]) + (a[2] * a[2] + a[3] * a[3])) + ((b[0] * b[0] + b[1] * b[1]) + (b[2] * b[2] + b[3] * b[3])); }
struct EpiX1 {
    static constexpr bool PERM = true, AFTER_DRAIN = true;
    const float *x, *gain; bf16_t* X1B; PanelX px;
    __device__ __forceinline__ void operator()(Acc& acc, const Unit& u, int wr, int wc, int fr, int fq) const {
        const int row0 = u.pm * 256 + wr * 64 + fr, col0 = u.pn * 256 + wc * 32 + 8 * fq;
        float s[2][4];
#pragma unroll
        for (int ai = 0; ai < 2; ++ai)
#pragma unroll
            for (int m = 0; m < 4; ++m) s[ai][m] = sq8(acc[ai][0][m][0], acc[ai][0][m][1]) + sq8(acc[ai][1][m][0], acc[ai][1][m][1]);
        panel_rstd(px, u, wr, wc, fr, fq, s);
        f32x4 g0[2], g1[2];
#pragma unroll
        for (int bj = 0; bj < 2; ++bj) { g0[bj] = *(const f32x4*)(gain + col0 + bj * 128); g1[bj] = *(const f32x4*)(gain + col0 + bj * 128 + 4); }
#pragma unroll
        for (int ai = 0; ai < 2; ++ai) {
            f32x4 xa[4][2], xb[4][2];
#pragma unroll
            for (int m = 0; m < 4; ++m)
#pragma unroll
                for (int bj = 0; bj < 2; ++bj) { const size_t off = (size_t)(row0 + ai * 128 + m * 16) * D_ + col0 + bj * 128; xa[m][bj] = *(const f32x4*)(x + off); xb[m][bj] = *(const f32x4*)(x + off + 4); }
#pragma unroll
            for (int m = 0; m < 4; ++m) { const float rs = s[ai][m];
#pragma unroll
                for (int bj = 0; bj < 2; ++bj) { const size_t off = (size_t)(row0 + ai * 128 + m * 16) * D_ + col0 + bj * 128;
                    const f32x4 ya = xa[m][bj] + acc[ai][bj][m][0] * rs * g0[bj], yb = xb[m][bj] + acc[ai][bj][m][1] * rs * g1[bj];
                    wt16b(X1B, off, pack8(ya, yb)); } }
        }
    }
};
struct EpiOut {
    static constexpr bool PERM = true, AFTER_DRAIN = true;
    const bf16_t *PE, *X1B; const float* gain; float* OUT; PanelX px;
    __device__ __forceinline__ void operator()(Acc& acc, const Unit& u, int wr, int wc, int fr, int fq) const {
        const int row0 = u.pm * 256 + wr * 64 + fr, col0 = u.pn * 256 + wc * 32 + 8 * fq;
        float s[2][4];
#pragma unroll
        for (int ai = 0; ai < 2; ++ai) {
            u32x4 pw[4][2];
#pragma unroll
            for (int m = 0; m < 4; ++m)
#pragma unroll
                for (int bj = 0; bj < 2; ++bj) pw[m][bj] = *(const u32x4*)(PE + (size_t)(row0 + ai * 128 + m * 16) * D_ + col0 + bj * 128);
#pragma unroll
            for (int m = 0; m < 4; ++m) { float t = 0.f;
#pragma unroll
                for (int bj = 0; bj < 2; ++bj) { acc[ai][bj][m][0] = bf4lo(pw[m][bj]) * sigm4(acc[ai][bj][m][0]); acc[ai][bj][m][1] = bf4hi(pw[m][bj]) * sigm4(acc[ai][bj][m][1]);
                    t += sq8(acc[ai][bj][m][0], acc[ai][bj][m][1]); }
                s[ai][m] = t; }
        }
        panel_rstd(px, u, wr, wc, fr, fq, s);
        f32x4 g0[2], g1[2];
#pragma unroll
        for (int bj = 0; bj < 2; ++bj) { g0[bj] = *(const f32x4*)(gain + col0 + bj * 128); g1[bj] = *(const f32x4*)(gain + col0 + bj * 128 + 4); }
#pragma unroll
        for (int ai = 0; ai < 2; ++ai) {
            u32x4 xw[4][2];
#pragma unroll
            for (int m = 0; m < 4; ++m)
#pragma unroll
                for (int bj = 0; bj < 2; ++bj) xw[m][bj] = *(const u32x4*)(X1B + (size_t)(row0 + ai * 128 + m * 16) * D_ + col0 + bj * 128);
#pragma unroll
            for (int m = 0; m < 4; ++m) { const float rs = s[ai][m];
#pragma unroll
                for (int bj = 0; bj < 2; ++bj) { const size_t off = (size_t)(row0 + ai * 128 + m * 16) * D_ + col0 + bj * 128;
                    *(f32x4*)(OUT + off) = bf4lo(xw[m][bj]) + acc[ai][bj][m][0] * rs * g0[bj]; *(f32x4*)(OUT + off + 4) = bf4hi(xw[m][bj]) + acc[ai][bj][m][1] * rs * g1[bj]; } }
        }
    }
};

__device__ __forceinline__ void tconv_tile(const float* __restrict__ src, int lds_, int sc0, int k0, bf16_t* __restrict__ dst, int ldd, int n0, float* tile  ) {
    const int tid = threadIdx.x;
    { const int nn = tid & 63, kb = tid >> 6; const float* pp = src + (size_t)(k0 + kb) * lds_ + sc0 + nn; const size_t step = (size_t)8 * lds_;
#pragma unroll 1
      for (int hb = 0; hb < 2; ++hb) { float v[16];
#pragma unroll
        for (int i = 0; i < 16; ++i) { v[i] = *pp; pp += step; }
#pragma unroll
        for (int i = 0; i < 16; ++i) tile[(kb + 8 * (hb * 16 + i)) * 65 + nn] = v[i]; } }
    __syncthreads();
#pragma unroll
    for (int i = 0; i < 4; ++i) { const int pidx = tid + 512 * i, kk2 = (pidx & 31) * 8, nn2 = pidx >> 5;
      f32x4 a, b;
#pragma unroll
      for (int j = 0; j < 4; ++j) { a[j] = tile[(kk2 + j) * 65 + nn2]; b[j] = tile[(kk2 + 4 + j) * 65 + nn2]; }
      *(u32x4*)(dst + (size_t)(n0 + nn2) * ldd + k0 + kk2) = pack8(a, b); }
    __syncthreads();
}
__device__ __forceinline__ int win_srccol(int n0) {
    const int pn = n0 >> 8, j = n0 & 255;
    if (pn < 2) return 256 * pn + j;
    if (pn < 4) return 512 + 256 * (pn - 2) + j;
    if (pn < 12) { const int i = pn - 4; return j < 128 ? 1024 + 128 * i + j : 3072 + 128 * i + (j - 128); }
    if (pn < 20) { const int i = pn - 12; return j < 128 ? 2048 + 128 * i + j : 4096 + 128 * i + (j - 128); }
    if (pn < 24) return 5120 + 256 * (pn - 20) + j;
    return 6144 + 256 * (pn - 24) + j;
}
__device__ void ssm_prep(const Params& P, int g, int r, unsigned char* smem) {
    float2* s_ab = (float2*)smem;
    float2* s_Bb = s_ab + 64;
    float2* s_C = s_Bb + 1024;
    float2* s_pw = s_C + 1024;
    float* s_Kd = (float*)(s_pw + 64 * 33);
    const int tid = threadIdx.x;
    bf16_t* MC = (bf16_t*)(P.ws + WS_MC); bf16_t* WST = (bf16_t*)(P.ws + WS_WST); float2* abT = (float2*)(P.ws + WS_ABT);
    if (tid < 64) {
        const int p = tid; const float dt = expf(P.log_step[g]); const float ar = P.a_re[g * 64 + p], ai = P.a_im[g * 64 + p];
        const float mag = expf(ar * dt), th = ai * dt; const float abr = mag * cosf(th), abi = mag * sinf(th);
        const float den = ar * ar + ai * ai, nr = abr - 1.0f; const float fr = (nr * ar + abi * ai) / den, fi = (abi * ar - nr * ai) / den;
        s_ab[p] = make_float2(abr, abi);
#pragma unroll 1
        for (int h = 0; h < 16; ++h) { const float br = P.b_re[(g * 64 + p) * 16 + h], bi = P.b_im[(g * 64 + p) * 16 + h]; s_Bb[p * 16 + h] = make_float2(fr * br - fi * bi, fr * bi + fi * br); }
        float cr = 1.f, ci = 0.f;
#pragma unroll 1
        for (int d = 0; d <= T_; ++d) { s_pw[p * 33 + d] = make_float2(cr, ci); const float nr2 = cr * abr - ci * abi, ni2 = cr * abi + ci * abr; cr = nr2; ci = ni2; }
        if (r == 0) abT[g * 64 + p] = s_pw[p * 33 + T_];
    }
    for (int i = tid; i < 1024; i += 512) { const int h = i >> 6, p = i & 63; s_C[i] = make_float2(P.c_re[(g * 16 + h) * 64 + p], P.c_im[(g * 16 + h) * 64 + p]); }
    __syncthreads();
#pragma unroll 1
    for (int i = 0; i < 4; ++i) { const int idx = tid + 512 * i, d = idx >> 6, hh = (idx >> 4) & 3, hp = idx & 15, h = 4 * r + hh; float a = 0.f;
#pragma unroll 4
        for (int p = 0; p < 64; ++p) { const float2 c = s_C[h * 64 + p], w = s_pw[p * 33 + d], b = s_Bb[p * 16 + hp]; const float xr = c.x * w.x - c.y * w.y, xi = c.x * w.y + c.y * w.x; a += xr * b.x - xi * b.y; }
        if (d == 0 && h == hp) a += P.d_skip[g * 16 + h];
        s_Kd[idx] = a; }
    __syncthreads();
#pragma unroll 1
    for (int i = 0; i < 20; ++i) { const int pidx = tid + 512 * i, rowi = pidx / 80, col8 = (pidx % 80) * 8, t = rowi >> 2, hh = rowi & 3, h = 4 * r + hh;
        f32x4 a = {0.f, 0.f, 0.f, 0.f}, b = {0.f, 0.f, 0.f, 0.f};
        if (col8 < KU_) { const int k = col8 >> 4, h0 = col8 & 15;
            if (k <= t) { const float* kd = s_Kd + (t - k) * 64 + hh * 16 + h0; a = (f32x4){kd[0], kd[1], kd[2], kd[3]}; b = (f32x4){kd[4], kd[5], kd[6], kd[7]}; } }
        else { const int q0 = col8 - KU_, im = q0 >= 64, p0 = q0 & 63;
#pragma unroll
            for (int j = 0; j < 8; ++j) { const float2 c = s_C[h * 64 + p0 + j], w = s_pw[(p0 + j) * 33 + t + 1]; const float v = im ? -(c.x * w.y + c.y * w.x) : (c.x * w.x - c.y * w.y); if (j < 4) a[j] = v; else b[j - 4] = v; } }
        *(u32x4*)(MC + ((size_t)(g * KU_ + t * 16 + h)) * LDU_ + col8) = pack8(a, b); }
#pragma unroll 1
    for (int i = 0; i < 4; ++i) { const int pidx = tid + 512 * i, q = 32 * r + (pidx >> 6), col8 = (pidx & 63) * 8, k = col8 >> 4, h0 = col8 & 15, p = q & 63, im = q >= 64;
        const float2 w = s_pw[p * 33 + (T_ - 1 - k)]; f32x4 a, b;
#pragma unroll
        for (int j = 0; j < 8; ++j) { const float2 bb = s_Bb[p * 16 + h0 + j]; const float v = im ? (w.x * bb.y + w.y * bb.x) : (w.x * bb.x - w.y * bb.y); if (j < 4) a[j] = v; else b[j - 4] = v; }
        *(u32x4*)(WST + ((size_t)(g * 256 + q)) * KU_ + col8) = pack8(a, b); }
    __syncthreads();
}

__device__ __forceinline__ void do_job(const Params& P, unsigned char* smem, int job) {
    const int tid = threadIdx.x;
    unsigned char* ws = P.ws;
    constexpr int J_SSM = 128, J_TC = 704, J_RMS = 512;
    {
        int j = job;
        if (j < J_SSM) { ssm_prep(P, j >> 2, j & 3, smem); return; }
        j -= J_SSM;
        if (j < J_TC) {
            const float* src; bf16_t* dst; int K, N, off; bool perm = false;
            if (j < 448) { src = P.w_in; dst = (bf16_t*)(ws + WS_WIN); K = 1024; N = INW_; perm = true; }
            else if ((off = j - 448) < 16) { j = off; src = P.w_glu; dst = (bf16_t*)(ws + WS_WGLU); K = 512; N = 512; }
            else if ((off = j - 464) < 32) { j = off; src = P.w_ssm_out; dst = (bf16_t*)(ws + WS_WSSO); K = 512; N = 1024; }
            else if ((off = j - 496) < 64) { j = off; src = P.w_conv_out; dst = (bf16_t*)(ws + WS_WCO); K = 1024; N = 1024; }
            else if ((off = j - 560) < 64) { j = off; src = P.w_o; dst = (bf16_t*)(ws + WS_WO); K = 1024; N = 1024; }
            else if ((off = j - 624) < 16) { j = off; src = P.w_ple; dst = (bf16_t*)(ws + WS_WPLE); K = 256; N = 1024; }
            else { j = j - 640; src = P.w_ple_gate; dst = (bf16_t*)(ws + WS_WG); K = 1024; N = 1024; }
            const int nkt = K >> 8, ntile = j / nkt, ktile = j % nkt, n0 = ntile * 64, k0 = ktile * 256;
            const int sc0 = perm ? win_srccol(n0) : n0;
            tconv_tile(src, N, sc0, k0, dst, K, n0, (float*)smem);
            return;
        }
        j -= J_TC;
        if (j < J_RMS) {
            const int lane = tid & 63, rowb = j * 32 + (tid >> 6) * 4;
            f32x4 v[4][4]; float s[4];
#pragma unroll
            for (int rr = 0; rr < 4; ++rr)
#pragma unroll
                for (int i = 0; i < 4; ++i) v[rr][i] = *(const f32x4*)(P.x + (size_t)(rowb + rr) * D_ + i * 256 + lane * 4);
#pragma unroll
            for (int rr = 0; rr < 4; ++rr) { float t = 0.f;
#pragma unroll
                for (int i = 0; i < 4; ++i) t += (v[rr][i][0] * v[rr][i][0] + v[rr][i][1] * v[rr][i][1]) + (v[rr][i][2] * v[rr][i][2] + v[rr][i][3] * v[rr][i][3]);
#pragma unroll
                for (int o = 32; o >= 1; o >>= 1) t += __shfl_xor(t, o);
                s[rr] = rsqrtf(t * (1.0f / D_) + EPS_); }
#pragma unroll
            for (int i = 0; i < 4; ++i) { const f32x4 gn = *(const f32x4*)(P.pre_norm + i * 256 + lane * 4);
#pragma unroll
                for (int rr = 0; rr < 4; ++rr) { const f32x4 y = v[rr][i] * s[rr] * gn; u32x2 w; w.x = cvt_pk_bf16(y[0], y[1]); w.y = cvt_pk_bf16(y[2], y[3]);
                    *(u32x2*)((bf16_t*)P.out + (size_t)(rowb + rr) * D_ + i * 256 + lane * 4) = w; } }
            return;
        }
        j -= J_RMS;
        {
            const size_t e0 = (size_t)j * 8192 + tid * 8;
            const f32x4 a0 = *(const f32x4*)(P.p + e0), b0 = *(const f32x4*)(P.p + e0 + 4), a1 = *(const f32x4*)(P.p + e0 + 4096), b1 = *(const f32x4*)(P.p + e0 + 4100);
            *(u32x4*)((bf16_t*)(ws + WS_PBF) + e0) = pack8(a0, b0); *(u32x4*)((bf16_t*)(ws + WS_PBF) + e0 + 4096) = pack8(a1, b1);
        }
    }
}

__device__ void phase_z(const Params& P, int b0, int nbz) {
    const bf16_t* V = (const bf16_t*)P.out + (size_t)L_ * D_;
    const bf16_t* W = (const bf16_t*)(P.ws + WS_W); bf16_t* Z = (bf16_t*)(P.ws + WS_Z);
    const int nthreads = nbz * 512;
    for (int idx = (blockIdx.x - b0) * 512 + threadIdx.x; idx < (L_ / 16) * 128; idx += nthreads) {
        const int oct = idx & 127, tb = idx >> 7, t0 = tb * 16, c0 = oct * 8;
        const f32x4 k0a = *(const f32x4*)(P.conv_w + c0), k0b = *(const f32x4*)(P.conv_w + c0 + 4);
        const f32x4 k1a = *(const f32x4*)(P.conv_w + CWID_ + c0), k1b = *(const f32x4*)(P.conv_w + CWID_ + c0 + 4);
        const f32x4 k2a = *(const f32x4*)(P.conv_w + 2 * CWID_ + c0), k2b = *(const f32x4*)(P.conv_w + 2 * CWID_ + c0 + 4);
        f32x4 m2a = {0.f, 0.f, 0.f, 0.f}, m2b = m2a, m1a = m2a, m1b = m2a;
        if (t0 > 0) { const u32x4 w2 = *(const u32x4*)(V + (size_t)(t0 - 2) * CWID_ + c0), w1 = *(const u32x4*)(V + (size_t)(t0 - 1) * CWID_ + c0);
            m2a = bf4lo(w2); m2b = bf4hi(w2); m1a = bf4lo(w1); m1b = bf4hi(w1); }
#pragma unroll
        for (int t = 0; t < 16; ++t) { const size_t off = (size_t)(t0 + t) * CWID_ + c0;
            const u32x4 vw = *(const u32x4*)(V + off), ww = *(const u32x4*)(W + off);
            const f32x4 va = bf4lo(vw), vb = bf4hi(vw);
            const f32x4 ca = k0a * m2a + k1a * m1a + k2a * va, cb = k0b * m2b + k1b * m1b + k2b * vb;
            *(u32x4*)(Z + off) = pack8(bf4lo(ww) * ca, bf4hi(ww) * cb);
            m2a = m1a; m2b = m1b; m1a = va; m1b = vb; }
    }
}
__device__ void carry_group(const Params& P, int g, unsigned char* smem) {
    const float2* abT = (const float2*)(P.ws + WS_ABT); const float* SLOC = (const float*)(P.ws + WS_SLOC); bf16_t* U = (bf16_t*)(P.ws + WS_U);
    float* sl = (float*)smem; unsigned* slw = (unsigned*)smem;
    float2* seg = (float2*)(smem + pg8::STAGE_BYTES + 64);
    const int tid = threadIdx.x, w = tid >> 6, p = tid & 63;
    const float2 a = abT[g * 64 + p];
    float2 a32 = a;
#pragma unroll
    for (int i = 0; i < 5; ++i) a32 = make_float2(a32.x * a32.x - a32.y * a32.y, 2.f * a32.x * a32.y);
    float sr = 0.f, si = 0.f;
    for (int half = 0; half < 2; ++half) {
        const f32x4* src = (const f32x4*)(SLOC + (size_t)(g * NCH_ + half * 256) * 128);
#pragma unroll
        for (int i = 0; i < 16; ++i) ((f32x4*)sl)[tid + 512 * i] = src[tid + 512 * i];
        __syncthreads();
        {
            float tr = 0.f, ti = 0.f;
#pragma unroll 8
            for (int c = 0; c < 32; ++c) { const float lr = sl[(32 * w + c) * 128 + p], li = sl[(32 * w + c) * 128 + 64 + p];
                const float nr = a.x * tr - a.y * ti + lr, ni = a.x * ti + a.y * tr + li; tr = nr; ti = ni; }
            seg[w * 64 + p] = make_float2(tr, ti);
        }
        __syncthreads();
        float wr_ = sr, wi_ = si;
#pragma unroll
        for (int j = 0; j < 8; ++j) { const float2 t = seg[j * 64 + p];
            const float nr = a32.x * sr - a32.y * si + t.x, ni = a32.x * si + a32.y * sr + t.y; sr = nr; si = ni;
            if (j + 1 == w) { wr_ = sr; wi_ = si; } }
#pragma unroll 8
        for (int c = 0; c < 32; ++c) { const float lr = sl[(32 * w + c) * 128 + p], li = sl[(32 * w + c) * 128 + 64 + p];
            slw[(32 * w + c) * 128 + p] = cvt_pk_bf16(wr_, wi_);
            const float nr = a.x * wr_ - a.y * wi_ + lr, ni = a.x * wi_ + a.y * wr_ + li; wr_ = nr; wi_ = ni; }
        __syncthreads();
#pragma unroll
        for (int i = 0; i < 4; ++i) { const int it = tid + 512 * i, c = it >> 3, p0 = (it & 7) * 8;
            const u32x4 w0 = *(const u32x4*)(slw + c * 128 + p0), w1 = *(const u32x4*)(slw + c * 128 + p0 + 4);
            u32x4 re, im;
            re.x = (w0.x & 0xffffu) | (w0.y << 16); re.y = (w0.z & 0xffffu) | (w0.w << 16); re.z = (w1.x & 0xffffu) | (w1.y << 16); re.w = (w1.z & 0xffffu) | (w1.w << 16);
            im.x = (w0.x >> 16) | (w0.y & 0xffff0000u); im.y = (w0.z >> 16) | (w0.w & 0xffff0000u); im.z = (w1.x >> 16) | (w1.y & 0xffff0000u); im.w = (w1.z >> 16) | (w1.w & 0xffff0000u);
            bf16_t* u = U + (size_t)(g * NCH_ + half * 256 + c) * LDU_ + KU_ + p0;
            *(u32x4*)u = re; *(u32x4*)(u + 64) = im; }
        __syncthreads();
    }
}

__global__ void __launch_bounds__(512, 2) hybrid_fwd(Params P) {
    extern __shared__ __attribute__((aligned(16))) unsigned char smem[];
    LAS unsigned char* lds = (LAS unsigned char*)smem;
    unsigned char* ws = P.ws;
    const int bid = blockIdx.x, nb = gridDim.x;
    const int lo = P.ph_lo, hi = P.ph_hi;
#define IN(k) (lo <= (k) && (k) < hi)
    volatile LAS unsigned* xb_st = (volatile LAS unsigned*)(lds + pg8::STAGE_BYTES);
    XcdBarrier xbar; xbar.bar = (unsigned*)(ws + WS_BAR); xbar.x = 0; xbar.st = xb_st;
    if (hi - lo > 1) {
        if (threadIdx.x < 4) xb_st[threadIdx.x] = 0u;
        __syncthreads();
        xbar = xcd_barrier_post((unsigned*)(ws + WS_BAR), xb_st);
    }
    if (lo == 0x7fffffff) cg::this_grid().sync();
#define SEAM(k) do { if (IN(k) && IN((k) + 1)) { xcd_barrier(xbar); } } while (0)
    bf16_t* H = (bf16_t*)P.out; bf16_t* V = (bf16_t*)P.out + (size_t)L_ * D_;
    bf16_t* YG = (bf16_t*)P.out; bf16_t* Y3 = (bf16_t*)P.out + (size_t)L_ * SW_; bf16_t* TMP = (bf16_t*)P.out + (size_t)L_ * D_;
    bf16_t* U = (bf16_t*)(ws + WS_U);

    if (IN(0)) { for (int idx = bid; idx < 1088; idx += nb) do_job(P, smem, idx < 576 ? idx : idx + 256); } SEAM(0);
    if (IN(1)) {
        pg8::Gemm g{H, (const bf16_t*)(ws + WS_WIN), D_, D_, D_}; pg8::StaticOrder S; S.init(L_, INW_, nb, bid);
        EpiG1 E{U, (bf16_t*)(ws + WS_SG), V, (bf16_t*)(ws + WS_W), (bf16_t*)(ws + WS_SR), (bf16_t*)(ws + WS_SC)};
        pg8::gemm_phase(lds, g, S, E);
    } SEAM(1);
    if (IN(2)) {
        const int nbs = nb >= 128 ? 64 : 0;
        if (bid < nbs || nbs == 0) {
            pg8::Gemm g{U, (const bf16_t*)(ws + WS_WST), LDU_, KU_, KU_}; pg8::BatchOrder S{64, nbs ? nbs : nb, bid, 1};
            EpiS1 E{(float*)(ws + WS_SLOC), (unsigned*)(ws + WS_CNT) + 2 * 64 * 64, &P, smem};
            pg8::gemm_phase(lds, g, S, E);
        }
        if (nbs == 0 || bid >= nbs) { phase_z(P, nbs, nb - nbs); for (int idx = bid - nbs; idx < 528; idx += nb - nbs) do_job(P, smem, idx < 512 ? 1344 + idx : 752 + (idx - 512)); }
    } SEAM(2);
    if (IN(3)) {
        const int nbs = nb >= 256 ? 128 : 0;
        if (bid < nbs || nbs == 0) {
            pg8::Gemm g{U, (const bf16_t*)(ws + WS_MC), LDU_, LDU_, LDU_}; pg8::BatchOrder S{128, nbs ? nbs : nb, bid, 2};
            EpiS2 E{YG};
            pg8::gemm_phase(lds, g, S, E);
        }
        if (bid >= nbs || nbs == 0) {
            pg8::Gemm g{(const bf16_t*)(ws + WS_PBF), (const bf16_t*)(ws + WS_WPLE), PLE_, PLE_, PLE_}; pg8::StaticOrder S; S.init(L_, D_, nbs ? nb - nbs : nb, nbs ? bid - nbs : bid);
            EpiStore E{(bf16_t*)(ws + WS_PE), D_};
            pg8::gemm_phase(lds, g, S, E);
            __syncthreads();
            for (int idx = nbs ? bid - nbs : bid; idx < 240; idx += (nbs ? nb - nbs : nb)) do_job(P, smem, 576 + idx + (idx >= 176 ? 16 : 0));
        }
    } SEAM(3);
    if (IN(4)) {
#define cntY3 ((unsigned*)(P.ws + WS_CNT) + 2 * 64 * 64 + 32 * 64)
#define cntMG (cntY3 + 64 * 64)
#define cntX1 (cntMG + 64 * 64)
        const bool has = (nb == 256);
#define MY_PM (8 * (bid & 7) + ((bid >> 3) & 7))
        { pg8::Gemm g{YG, (const bf16_t*)(ws + WS_WGLU), SW_, SW_, SW_}; pg8::StaticOrder S; S.init(L_, SW_, nb, bid);
          EpiGlu E{YG, (const bf16_t*)(ws + WS_SG), P.b_glu, Y3};
          pg8::gemm_phase(lds, g, S, E);
          if (has && bid < 128) panel_arrive(cntY3, MY_PM); }
        if (has) {
            { pg8::AccT mt;
              { pg8::Gemm g{(const bf16_t*)(ws + WS_Z), (const bf16_t*)(ws + WS_WCO), D_, D_, D_}; pg8::StaticOrder S; S.init(L_, D_, nb, bid);
                EpiMergeMid E{(const bf16_t*)(ws + WS_SR), (const bf16_t*)(ws + WS_SC)}; pg8::gemm_phase_acc<true>(lds, g, S, E, mt); }
              panel_wait(cntY3, MY_PM, 2u);
              { pg8::Gemm g{Y3, (const bf16_t*)(ws + WS_WSSO), SW_, SW_, SW_}; pg8::StaticOrder S; S.init(L_, D_, nb, bid);
                EpiMergeFin E{(const bf16_t*)(ws + WS_SR), (bf16_t*)(ws + WS_MERGED)}; pg8::gemm_phase_acc<false>(lds, g, S, E, mt); } }
            panel_arrive(cntMG, MY_PM);
            panel_wait(cntMG, MY_PM, 4u);
            pg8::Gemm g{(const bf16_t*)(ws + WS_MERGED), (const bf16_t*)(ws + WS_WO), D_, D_, D_}; pg8::StaticOrder S; S.init(L_, D_, nb, bid);
            { EpiX1 E{P.x, P.post_norm, (bf16_t*)(ws + WS_X1BF), PanelX{(float*)(ws + WS_MISC), (unsigned*)(ws + WS_CNT)}}; pg8::gemm_phase(lds, g, S, E); }
            asm volatile("s_waitcnt vmcnt(0)" ::: "memory"); __syncthreads();
            panel_arrive(cntX1, MY_PM);
            if (threadIdx.x < 4) { const int q = MY_PM, p0 = q < 16 ? 4 * q : (q < 32 ? 4 * (q - 16) : 2 * (q - 32)), np = q < 32 ? 4 : 2;
                if ((int)threadIdx.x < np) { unsigned spins = 0;
                    while (__hip_atomic_load(cntMG + 64 * (p0 + (int)threadIdx.x), __ATOMIC_RELAXED, __HIP_MEMORY_SCOPE_AGENT) < 4u) { __builtin_amdgcn_s_sleep(2); if (++spins > (1u << 21)) break; } } }
            panel_wait(cntX1, MY_PM, 4u);
            pg8::Gemm g7{(const bf16_t*)(ws + WS_X1BF), (const bf16_t*)(ws + WS_WG), D_, D_, D_}; pg8::StaticOrder S7; S7.init(L_, D_, nb, bid);
            EpiOut E7{(const bf16_t*)(ws + WS_PE), (const bf16_t*)(ws + WS_X1BF), P.ple_norm, P.out, PanelX{(float*)(ws + WS_MISC + 1 * MiB), (unsigned*)(ws + WS_CNT) + 64 * 64}}; pg8::gemm_phase(lds, g7, S7, E7);
        }
#undef MY_PM
#undef cntY3
#undef cntMG
#undef cntX1
    }
#undef IN
#undef SEAM
}


extern "C" void kernel_launch(void* const* d_in, const int* in_sizes, int n_in, void* d_out, int out_size, void* d_ws, size_t ws_size, hipStream_t stream) {
    constexpr int LDS_BYTES = pg8::STAGE_BYTES + 64 + 4096;
    static int grid = 0;
    if (grid == 0) {
        if (n_in != 22 || out_size != L_ * D_ || ws_size < WS_END) { fprintf(stderr, "kernel_launch: unexpected shapes (n_in %d out %d ws %zu)\n", n_in, out_size, ws_size); grid = -1; return; }
        int dev = 0, cus = 0, per_cu = 0;
        hipGetDevice(&dev); hipDeviceGetAttribute(&cus, hipDeviceAttributeMultiprocessorCount, dev);
        if (hipFuncSetAttribute((const void*)hybrid_fwd, hipFuncAttributeMaxDynamicSharedMemorySize, LDS_BYTES) != hipSuccess) { fprintf(stderr, "kernel_launch: hipFuncSetAttribute failed\n"); grid = -1; return; }
        hipOccupancyMaxActiveBlocksPerMultiprocessor(&per_cu, (const void*)hybrid_fwd, 512, LDS_BYTES);
        (void)hipGetLastError();
        if (per_cu < 1) per_cu = 1;
        grid = cus;
        fprintf(stderr, "kernel_launch: cus %d per_cu %d grid %d\n", cus, per_cu, grid);
    }
    if (grid < 0) return;
    Params P{};
    const float** f = (const float**)&P;
    for (int i = 0; i < 22; ++i) f[i] = (const float*)d_in[i];
    P.out = (float*)d_out; P.ws = (unsigned char*)d_ws;
    (void)hipMemsetAsync((unsigned char*)d_ws + WS_BAR, 0, 16384 + 2 * 64 * 256 + 32 * 256 + 3 * 64 * 256, stream);
#if ONE_LAUNCH
    P.ph_lo = 0; P.ph_hi = NPH;
    void* args[] = {&P};
    hipError_t e = hipLaunchCooperativeKernel((const void*)hybrid_fwd, dim3(grid), dim3(512), args, LDS_BYTES, stream);
    if (e != hipSuccess) fprintf(stderr, "cooperative launch failed: %s (grid %d)\n", hipGetErrorString(e), grid);
#else
    for (int ph = 0; ph < NPH; ++ph) {
        P.ph_lo = ph; P.ph_hi = ph + 1;
        hipLaunchKernelGGL(hybrid_fwd, dim3(grid), dim3(512), LDS_BYTES, stream, P);
    }
#endif
}
```

```cpp
#include <hip/hip_runtime.h>
#include <hip/hip_cooperative_groups.h>
#include <cstdio>
namespace cg = cooperative_groups;

#ifndef ONE_LAUNCH
#define ONE_LAUNCH 1
#endif

#define LAS __attribute__((address_space(3)))
typedef unsigned short bf16_t;
typedef short bf16x8 __attribute__((ext_vector_type(8)));
typedef float f32x4 __attribute__((ext_vector_type(4)));
typedef unsigned u32x4 __attribute__((ext_vector_type(4)));
typedef unsigned u32x2 __attribute__((ext_vector_type(2)));

constexpr int L_ = 16384, D_ = 1024, PLE_ = 256, SW_ = 512, NG_ = 32, CWID_ = 1024, INW_ = 7168;
constexpr int T_ = 32, NCH_ = L_ / T_  , KU_ = T_ * 16  , LDU_ = KU_ + 128  ;
constexpr float EPS_ = 1e-6f;
constexpr size_t MiB = 1024 * 1024;
constexpr size_t WS_WGLU = 0, WS_WSSO = WS_WGLU + 512 * 512 * 2, WS_WCO = WS_WSSO + 1024 * 512 * 2, WS_WO = WS_WCO + 2 * MiB, WS_WPLE = WS_WO + 2 * MiB,
                 WS_WG = WS_WPLE + 1024 * 256 * 2, WS_WIN = 8 * MiB, WS_MC = WS_WIN + 14 * MiB, WS_WST = WS_MC + 20 * MiB, WS_PBF = WS_WST + 8 * MiB,
                 WS_U = WS_PBF + 8 * MiB, WS_SLOC = WS_U + 20 * MiB, WS_SG = WS_SLOC + 8 * MiB, WS_W = WS_SG + 16 * MiB, WS_SR = WS_W + 32 * MiB,
                 WS_SC = WS_SR + 32 * MiB, WS_Z = WS_SC + 32 * MiB, WS_MISC = WS_Z + 32 * MiB, WS_END = WS_MISC + 3 * MiB;
constexpr size_t WS_ABT = WS_MISC + 2 * MiB, WS_BAR = WS_MISC + 2 * MiB + 64 * 1024, WS_CNT = WS_BAR + 16384;
constexpr size_t WS_PE = WS_W, WS_MERGED = WS_MC, WS_O = WS_SR, WS_X1BF = WS_SC, WS_E = WS_Z;
constexpr int NPH = 5;

struct Params {
    const float *x, *p, *pre_norm, *w_in, *a_re, *a_im, *log_step, *b_re, *b_im, *c_re, *c_im, *d_skip, *w_glu, *b_glu, *w_ssm_out, *conv_w, *w_conv_out, *w_o,
        *post_norm, *w_ple, *w_ple_gate, *ple_norm;
    float* out; unsigned char* ws; int ph_lo, ph_hi;
};

typedef __bf16 bf16x2_t __attribute__((ext_vector_type(2)));
typedef float f32x2_t __attribute__((ext_vector_type(2)));
__device__ __forceinline__ unsigned cvt_pk_bf16(float lo, float hi) { f32x2_t v = {lo, hi}; bf16x2_t b = __builtin_convertvector(v, bf16x2_t); return __builtin_bit_cast(unsigned, b); }
__device__ __forceinline__ float bflo(unsigned w) { return __uint_as_float(w << 16); }
__device__ __forceinline__ float bfhi(unsigned w) { return __uint_as_float(w & 0xffff0000u); }
__device__ __forceinline__ f32x4 bf4lo(u32x4 w) { return (f32x4){bflo(w.x), bfhi(w.x), bflo(w.y), bfhi(w.y)}; }
__device__ __forceinline__ f32x4 bf4hi(u32x4 w) { return (f32x4){bflo(w.z), bfhi(w.z), bflo(w.w), bfhi(w.w)}; }
__device__ __forceinline__ u32x4 pack8(f32x4 a, f32x4 b) { u32x4 w; w.x = cvt_pk_bf16(a[0], a[1]); w.y = cvt_pk_bf16(a[2], a[3]); w.z = cvt_pk_bf16(b[0], b[1]); w.w = cvt_pk_bf16(b[2], b[3]); return w; }
typedef __amdgpu_buffer_rsrc_t rsrc_t;
__device__ __forceinline__ void wt16b(const bf16_t* base, size_t elem, u32x4 v) {
    const rsrc_t r = __builtin_amdgcn_make_buffer_rsrc((void*)base, (short)0, 0x7ffffff0, 0x00020000);
    __builtin_amdgcn_raw_buffer_store_b128(v, r, (unsigned)(elem * 2), 0, 16); }
__device__ __forceinline__ void panel_arrive(unsigned* cnt, int pm) { if (threadIdx.x == 0) __hip_atomic_fetch_add(cnt + 64 * pm, 1u, __ATOMIC_RELAXED, __HIP_MEMORY_SCOPE_AGENT); }
__device__ __forceinline__ void panel_wait(unsigned* cnt, int pm, unsigned need) {
    if (threadIdx.x == 0) { unsigned spins = 0;
        while (__hip_atomic_load(cnt + 64 * pm, __ATOMIC_RELAXED, __HIP_MEMORY_SCOPE_AGENT) < need) { __builtin_amdgcn_s_sleep(2); if (++spins > (1u << 21)) break; }
        __builtin_amdgcn_fence(__ATOMIC_ACQUIRE, "agent"); asm volatile("s_waitcnt vmcnt(0)" ::: "memory"); }
    __syncthreads();
}
__device__ __forceinline__ float sigm(float x) { return __builtin_amdgcn_rcpf(1.f + __expf(-x)); }
__device__ __forceinline__ f32x4 sigm4(f32x4 v) { return (f32x4){sigm(v[0]), sigm(v[1]), sigm(v[2]), sigm(v[3])}; }
__device__ __forceinline__ float gelu_t(float x) { return x * sigm(1.5957691216f * (x + 0.044715f * x * x * x)); }
__device__ __forceinline__ f32x4 gelu4(f32x4 v) { return (f32x4){gelu_t(v[0]), gelu_t(v[1]), gelu_t(v[2]), gelu_t(v[3])}; }

#define XB_TMO      128
#define XB_XCNT(j)  (256  + 64 * (j))
#define XB_XSUB(j)  (1280 + 64 * (j))
#define XB_XGEN(j)  (2304 + 64 * (j))
#define XB_TOP      3328
#define XB_TOPGEN   3392
#define XCD_BAR_WORDS 3456
#define XB_SPIN_CAP (1u << 18)
__device__ __forceinline__ unsigned xb_ld(unsigned* p)              { return __hip_atomic_load(p, __ATOMIC_RELAXED, __HIP_MEMORY_SCOPE_AGENT); }
__device__ __forceinline__ unsigned xb_add(unsigned* p, unsigned v) { return __hip_atomic_fetch_add(p, v, __ATOMIC_RELAXED, __HIP_MEMORY_SCOPE_AGENT); }
__device__ __forceinline__ unsigned xb_xcc_id() { return (unsigned)__builtin_amdgcn_s_getreg((3 << 11) | 20) & 0xFu; }
#define XB_SPIN(cond, bar) do { unsigned _sp = 0; while (cond) { __builtin_amdgcn_s_sleep(1); \
    if ((++_sp & 255u) == 0u) { if (xb_ld(&(bar)[XB_TMO])) break; if (_sp > XB_SPIN_CAP) { atomicAdd(&(bar)[XB_TMO], 1u); break; } } } } while (0)

struct XcdBarrier {
    unsigned* bar; unsigned x;
    volatile LAS unsigned* st;
};

__device__ __forceinline__ XcdBarrier xcd_barrier_post(unsigned* bar, volatile LAS unsigned* st) {
    XcdBarrier b; b.bar = bar; b.x = xb_xcc_id(); b.st = st;
    if (threadIdx.x == 0) (void)xb_add(&bar[XB_XCNT(b.x)], 1u);
    return b;
}
__device__ __forceinline__ void xcd_barrier_complete(unsigned* bar, unsigned x, unsigned& nloc, unsigned& nx) {
    const unsigned G = gridDim.x * gridDim.y * gridDim.z;
    unsigned sum, cnt, mine, sp = 0u;
    for (;;) {
        sum = 0u; cnt = 0u; mine = 0u;
#pragma unroll
        for (unsigned j = 0; j < 16; ++j) { const unsigned c = xb_ld(&bar[XB_XCNT(j)]); sum += c; cnt += (c > 0u) ? 1u : 0u; mine = (j == x) ? c : mine; }
        if (sum == G) break;
        __builtin_amdgcn_s_sleep(1);
        if ((++sp & 255u) == 0u) { if (xb_ld(&bar[XB_TMO])) break; if (sp > XB_SPIN_CAP) { atomicAdd(&bar[XB_TMO], 1u); break; } }
    }
    nloc = mine > 0u ? mine : 1u; nx = cnt > 0u ? cnt : 1u;
}

__device__ __forceinline__ void xcd_barrier(const XcdBarrier& b) {
    asm volatile("s_waitcnt vmcnt(0)" ::: "memory");
    __syncthreads();
    if (threadIdx.x == 0) {
        unsigned* bar = b.bar;
        __builtin_amdgcn_s_waitcnt(0);
        unsigned nloc = b.st[0], nx = b.st[1];
        if (nloc == 0u) { xcd_barrier_complete(bar, b.x, nloc, nx); b.st[0] = nloc; b.st[1] = nx; }
        const unsigned old = xb_add(&bar[XB_XSUB(b.x)], 1u);
        const unsigned gen = old / nloc;
        if (old + 1u == (gen + 1u) * nloc) {
            __builtin_amdgcn_fence(__ATOMIC_RELEASE, "agent");
            asm volatile("s_waitcnt vmcnt(0)" ::: "memory");
            const unsigned og = xb_add(&bar[XB_TOP], 1u);
            const unsigned tg = og / nx;
            if (og + 1u == (tg + 1u) * nx) xb_add(&bar[XB_TOPGEN], 1u);
            else XB_SPIN(xb_ld(&bar[XB_TOPGEN]) == tg, bar);
            __builtin_amdgcn_fence(__ATOMIC_ACQUIRE, "agent");
            xb_add(&bar[XB_XGEN(b.x)], 1u);
            asm volatile("s_waitcnt vmcnt(0)" ::: "memory");
        } else {
            XB_SPIN(xb_ld(&bar[XB_XGEN(b.x)]) == gen, bar);
            __builtin_amdgcn_fence(__ATOMIC_ACQUIRE, "agent");
            asm volatile("s_waitcnt vmcnt(0)" ::: "memory");
        }
    }
    __syncthreads();
}

namespace pg8 {
constexpr int BM = 256, BK = 64, HALF = 128, HTB = HALF * BK * 2, STAGE_BYTES = 8 * HTB, NXCD = 8, WGM = 8;
__device__ __forceinline__ int lds_byte(int r, int c) { const int st = (r >> 4) * 2 + (c >> 5), rr = r & 15, cc = c & 31, ob = rr * 64 + cc * 2; return st * 1024 + (ob ^ (((ob >> 9) & 1) << 5)); }
__device__ __forceinline__ void stage_rc(int b, int& R, int& C) { const int st = b / 1024, sb = b % 1024, swz = sb ^ (((sb >> 9) & 1) << 5); R = (st >> 1) * 16 + swz / 64; C = (st & 1) * 32 + (swz % 64) / 2; }
__device__ __forceinline__ int perm32(int rho) { const int n = rho >> 4, i = rho & 15; return 8 * (i >> 2) + 4 * n + (i & 3); }
struct Unit { int pm, pn; };
struct Gemm { const bf16_t* A; const bf16_t* Bt; int lda, ldb, K; };

struct StaticOrder {
    int nM, nN, nwg, G, c;
    __device__ void init(int M, int N, int G_, int c_) { nM = M / BM; nN = N / BM; nwg = nM * nN; G = G_; c = c_; }
    __device__ bool next(int i, Unit& u) const {
        const long Lx = (long)i * G + c; if (c < 0 || Lx >= nwg) return false;
        int wgid = (int)Lx; { const int q = nwg / NXCD, r = nwg % NXCD, xcd = wgid % NXCD, off = wgid / NXCD; wgid = (xcd < r ? xcd * (q + 1) : r * (q + 1) + (xcd - r) * q) + off; }
        const int nig = WGM * nN, gid = wgid / nig, fm = gid * WGM, gsz = (nM - fm) < WGM ? (nM - fm) : WGM;
        u.pm = fm + ((wgid % nig) % gsz); u.pn = (wgid % nig) / gsz; return true;
    }
};
struct BatchOrder {
    int nunits, G, c, mode;
    __device__ bool next(int i, Unit& u) const {
        const int Lx = i * G + c; if (c < 0 || Lx >= nunits) return false;
        const int xcd = Lx & 7, slot = Lx >> 3;
        if (mode == 1) { const int g = xcd * 4 + (slot >> 1); u.pm = 2 * g + (slot & 1); u.pn = g; }
        else { const int g = xcd * 4 + (slot >> 2); u.pm = 2 * g + ((slot >> 1) & 1); u.pn = 2 * g + (slot & 1); }
        return true;
    }
};

typedef f32x4 AccT[2][2][4][2];
template <bool INIT, class Epi, class Sched>
__device__ __forceinline__ void gemm_phase_acc(LAS unsigned char* lds, const Gemm g, const Sched& S, const Epi& E, AccT& acc) {
    const int tid = threadIdx.x, wid = __builtin_amdgcn_readfirstlane(tid >> 6), lane = tid & 63, wr = wid >> 2, wc = wid & 3, fr = lane & 15, fq = lane >> 4;
    const int K = g.K, nt = K / BK;
    unsigned voffA[2], voffB[2];
#pragma unroll
    for (int i = 0; i < 2; ++i) { int R, C; stage_rc(tid * 16 + i * 8192, R, C); const int Rb = Epi::PERM ? ((R & ~31) + perm32(R & 31)) : R;
        voffA[i] = (unsigned)(R * g.lda + C) * 2u; voffB[i] = (unsigned)(Rb * g.ldb + C) * 2u; }
    const size_t kstep = (size_t)(BK * 2);
    const size_t hstepA = (size_t)HALF * g.lda * 2, hstepB = (size_t)HALF * g.ldb * 2;
    const size_t tstepA = 2 * hstepA, tstepB = 2 * hstepB;
    const unsigned ldsw = (unsigned)wid * 1024u;
    const int aoff = lds_byte(wr * 64 + fr, fq * 8), boff = lds_byte(wc * 32 + fr, fq * 8);
#define PG8_SA(b, h) (((b) * 2 + (h)) * HTB)
#define PG8_SB(b, h) ((4 + (b) * 2 + (h)) * HTB)
#define PG8_STAGE(bufoff, gbase, voff) do { _Pragma("unroll") for (int _i = 0; _i < 2; ++_i) \
        __builtin_amdgcn_global_load_lds((const unsigned*)((const char*)(gbase) + (voff)[_i]), (LAS unsigned*)(lds + (bufoff) + ldsw + _i * 8192), 16, 0, 0); } while (0)
#define PG8_LDA(dst, b, h) do { _Pragma("unroll") for (int m = 0; m < 4; ++m) _Pragma("unroll") for (int k = 0; k < 2; ++k) dst[m][k] = *(const LAS bf16x8*)(lds + PG8_SA(b, h) + aoff + m * 2048 + k * 1024); } while (0)
#define PG8_LDB(dst, b, h) do { _Pragma("unroll") for (int n = 0; n < 2; ++n) _Pragma("unroll") for (int k = 0; k < 2; ++k) dst[n][k] = *(const LAS bf16x8*)(lds + PG8_SB(b, h) + boff + n * 2048 + k * 1024); } while (0)
#define PG8_MMA(ai, bj, At, Bt) do { __builtin_amdgcn_s_setprio(1); _Pragma("unroll") for (int m = 0; m < 4; ++m) _Pragma("unroll") for (int n = 0; n < 2; ++n) _Pragma("unroll") for (int k = 0; k < 2; ++k) \
        acc[ai][bj][m][n] = __builtin_amdgcn_mfma_f32_16x16x32_bf16(Bt[n][k], At[m][k], acc[ai][bj][m][n], 0, 0, 0); __builtin_amdgcn_s_setprio(0); } while (0)
#define PG8_WAIT_V(n) asm volatile("s_waitcnt vmcnt(" #n ")" ::: "memory")
#define PG8_WAIT_L(n) asm volatile("s_waitcnt lgkmcnt(" #n ")" ::: "memory")
#define PG8_BAR __builtin_amdgcn_s_barrier()
#define PG8_SCHED __builtin_amdgcn_sched_barrier(0)
    Unit cur, nxt; int ui = 0;
    if (!S.next(0, cur)) return;
    if (INIT) {
#pragma unroll
    for (int a = 0; a < 2; ++a)
#pragma unroll
        for (int b = 0; b < 2; ++b)
#pragma unroll
            for (int m = 0; m < 4; ++m)
#pragma unroll
                for (int n = 0; n < 2; ++n) acc[a][b][m][n] = (f32x4){0.f, 0.f, 0.f, 0.f};
    }
    bf16x8 At[4][2], B0[2][2], B1[2][2];
    const char* cA = (const char*)g.A + (size_t)cur.pm * tstepA; const char* cB = (const char*)g.Bt + (size_t)cur.pn * tstepB;
    PG8_STAGE(PG8_SB(0, 0), cB, voffB); PG8_STAGE(PG8_SB(0, 1), cB + hstepB, voffB); PG8_STAGE(PG8_SA(0, 0), cA, voffA); PG8_STAGE(PG8_SA(0, 1), cA + hstepA, voffA);
    if (wr == 1) PG8_BAR;
    PG8_WAIT_V(2); PG8_BAR;
    PG8_STAGE(PG8_SB(1, 0), cB + kstep, voffB); PG8_STAGE(PG8_SA(1, 0), cA + kstep, voffA); PG8_STAGE(PG8_SB(1, 1), cB + hstepB + kstep, voffB);
    PG8_WAIT_V(6); PG8_BAR;
    for (;;) {
        const bool has_next = S.next(ui + 1, nxt);
        const char* nA = has_next ? (const char*)g.A + (size_t)nxt.pm * tstepA : cA; const char* nB = has_next ? (const char*)g.Bt + (size_t)nxt.pn * tstepB : cB;
#pragma unroll 1
        for (int t = 0; t < nt; t += 2) {
            const bool last = (t == nt - 2);
            const char* a1 = cA + (size_t)(t + 1) * kstep;
            const char* a2 = last ? nA : cA + (size_t)(t + 2) * kstep; const char* b2 = last ? nB : cB + (size_t)(t + 2) * kstep;
            const char* a3 = a2 + kstep; const char* b3 = b2 + kstep;
            PG8_LDB(B0, 0, 0); PG8_LDB(B1, 0, 1); PG8_SCHED; PG8_LDA(At, 0, 0); PG8_STAGE(PG8_SA(1, 1), a1 + hstepA, voffA);
            PG8_WAIT_V(8); PG8_WAIT_L(0); PG8_BAR; PG8_MMA(0, 0, At, B0); PG8_MMA(0, 1, At, B1); PG8_BAR; PG8_SCHED;
            PG8_LDA(At, 0, 1); PG8_STAGE(PG8_SB(0, 0), b2, voffB); PG8_STAGE(PG8_SB(0, 1), b2 + hstepB, voffB); PG8_STAGE(PG8_SA(0, 0), a2, voffA);
            PG8_WAIT_V(8); PG8_WAIT_L(0); PG8_BAR; PG8_MMA(1, 0, At, B0); PG8_MMA(1, 1, At, B1); PG8_BAR; PG8_SCHED;
            PG8_LDB(B0, 1, 0); PG8_LDB(B1, 1, 1); PG8_SCHED; PG8_LDA(At, 1, 0); PG8_STAGE(PG8_SA(0, 1), a2 + hstepA, voffA);
            PG8_WAIT_V(8); PG8_WAIT_L(0); PG8_BAR; PG8_MMA(0, 0, At, B0); PG8_MMA(0, 1, At, B1); PG8_BAR; PG8_SCHED;
            PG8_LDA(At, 1, 1); PG8_STAGE(PG8_SB(1, 0), b3, voffB); PG8_STAGE(PG8_SB(1, 1), b3 + hstepB, voffB); PG8_STAGE(PG8_SA(1, 0), a3, voffA);
            PG8_WAIT_V(8); PG8_WAIT_L(0); PG8_BAR; PG8_MMA(1, 0, At, B0); PG8_MMA(1, 1, At, B1); PG8_BAR; PG8_SCHED;
        }
        if (wr == 0) PG8_BAR;
        if constexpr (!Epi::AFTER_DRAIN) E(acc, cur, wr, wc, fr, fq);
        if (!has_next) break;
#pragma unroll
        for (int a = 0; a < 2; ++a)
#pragma unroll
            for (int b = 0; b < 2; ++b)
#pragma unroll
                for (int m = 0; m < 4; ++m)
#pragma unroll
                    for (int n = 0; n < 2; ++n) acc[a][b][m][n] = (f32x4){0.f, 0.f, 0.f, 0.f};
        cur = nxt; cA = nA; cB = nB; ++ui;
        if (wr == 1) PG8_BAR;
    }
    PG8_WAIT_V(0);
    PG8_BAR;
    if constexpr (Epi::AFTER_DRAIN) E(acc, cur, wr, wc, fr, fq);
#undef PG8_SA
#undef PG8_SB
#undef PG8_STAGE
#undef PG8_LDA
#undef PG8_LDB
#undef PG8_MMA
#undef PG8_WAIT_V
#undef PG8_WAIT_L
#undef PG8_BAR
#undef PG8_SCHED
}
template <class Epi, class Sched>
__device__ __forceinline__ void gemm_phase(LAS unsigned char* lds, const Gemm g, const Sched& S, const Epi& E) { AccT acc; gemm_phase_acc<true>(lds, g, S, E, acc); }
}
using pg8::Unit;
typedef f32x4 Acc[2][2][4][2];

#define EPI_ROWS(...) _Pragma("unroll") for (int ai = 0; ai < 2; ++ai) _Pragma("unroll") for (int m = 0; m < 4; ++m) { const int row = row0 + ai * 128 + m * 16; __VA_ARGS__ }

struct EpiG1 {
    static constexpr bool PERM = true, AFTER_DRAIN = false;
    bf16_t *U, *SG, *V, *W, *SR, *SC;
    __device__ __forceinline__ void operator()(const Acc& acc, const Unit& u, int wr, int wc, int fr, int fq) const {
        const int row0 = u.pm * 256 + wr * 64 + fr, cw = wc * 32 + 8 * fq, pn = u.pn;
        if (pn < 2) {
            EPI_ROWS(
                const int c = row >> 5, tt = row & 31;
                _Pragma("unroll") for (int bj = 0; bj < 2; ++bj) { const int col = pn * 256 + bj * 128 + cw; const int g = col >> 4, h0 = col & 15;
                    *(u32x4*)(U + ((size_t)(g * NCH_ + c)) * LDU_ + tt * 16 + h0) = pack8(acc[ai][bj][m][0], acc[ai][bj][m][1]); } )
        } else if (pn < 4) {
            EPI_ROWS(
                _Pragma("unroll") for (int bj = 0; bj < 2; ++bj) { const int col = (pn - 2) * 256 + bj * 128 + cw; const f32x4 a = acc[ai][bj][m][0], b = acc[ai][bj][m][1];
                    *(u32x4*)(SG + (size_t)row * SW_ + col) = pack8(a * sigm4(a), b * sigm4(b)); } )
        } else if (pn < 12) {
            EPI_ROWS(
                const int col = (pn - 4) * 128 + cw;
                *(u32x4*)(V + (size_t)row * CWID_ + col) = pack8(acc[ai][0][m][0] * acc[ai][1][m][0], acc[ai][0][m][1] * acc[ai][1][m][1]); )
        } else if (pn < 20) {
            EPI_ROWS(
                const int col = (pn - 12) * 128 + cw; const f32x4 ga = acc[ai][1][m][0], gb = acc[ai][1][m][1];
                *(u32x4*)(W + (size_t)row * CWID_ + col) = pack8(acc[ai][0][m][0] * (ga * sigm4(ga)), acc[ai][0][m][1] * (gb * sigm4(gb))); )
        } else {
            bf16_t* dst = pn < 24 ? SR : SC; const int pb = pn < 24 ? pn - 20 : pn - 24;
            EPI_ROWS(
                _Pragma("unroll") for (int bj = 0; bj < 2; ++bj) { const int col = pb * 256 + bj * 128 + cw;
                    *(u32x4*)(dst + (size_t)row * D_ + col) = pack8(acc[ai][bj][m][0], acc[ai][bj][m][1]); } )
        }
    }
};
__device__ void carry_group(const Params& P, int g, unsigned char* smem);
struct EpiS1 {
    static constexpr bool PERM = false, AFTER_DRAIN = true;
    float* SLOC; unsigned* gcnt; const Params* P; unsigned char* smem;
    __device__ __forceinline__ void operator()(const Acc& acc, const Unit& u, int wr, int wc, int fr, int fq) const {
        const int row0 = u.pm * 256 + wr * 64 + fr;
        EPI_ROWS(
            float* rp = SLOC + (size_t)row * 128 + wc * 32 + 4 * fq; *(f32x4*)rp = acc[ai][0][m][0]; *(f32x4*)(rp + 16) = acc[ai][0][m][1]; )
        asm volatile("s_waitcnt vmcnt(0)" ::: "memory");
        __syncthreads();
        unsigned* flag = (unsigned*)smem;
        if (threadIdx.x == 0) {
            __builtin_amdgcn_fence(__ATOMIC_RELEASE, "agent");
            asm volatile("s_waitcnt vmcnt(0)" ::: "memory");
            const unsigned old = __hip_atomic_fetch_add(gcnt + 64 * u.pn, 1u, __ATOMIC_RELAXED, __HIP_MEMORY_SCOPE_AGENT);
            if (old == 1u) { __builtin_amdgcn_fence(__ATOMIC_ACQUIRE, "agent"); asm volatile("s_waitcnt vmcnt(0)" ::: "memory"); }
            flag[0] = old;
        }
        __syncthreads();
        const unsigned old = flag[0];
        __syncthreads();
        if (old == 1u) carry_group(*P, u.pn, smem);
    }
};
struct EpiS2 {
    static constexpr bool PERM = true, AFTER_DRAIN = false;
    bf16_t* YG;
    __device__ __forceinline__ void operator()(const Acc& acc, const Unit& u, int wr, int wc, int fr, int fq) const {
        const int g = u.pm >> 1, c0 = (u.pm & 1) * 256 + wr * 64 + fr, n0 = (u.pn & 1) * 256 + wc * 32 + 8 * fq;
#pragma unroll
        for (int ai = 0; ai < 2; ++ai)
#pragma unroll
            for (int m = 0; m < 4; ++m) { const int c = c0 + ai * 128 + m * 16;
#pragma unroll
                for (int bj = 0; bj < 2; ++bj) { const int n = n0 + bj * 128, t = n >> 4, h0 = n & 15;
                    *(u32x4*)(YG + (size_t)(c * T_ + t) * SW_ + g * 16 + h0) = pack8(gelu4(acc[ai][bj][m][0]), gelu4(acc[ai][bj][m][1])); } }
    }
};
struct EpiStore {
    static constexpr bool PERM = true, AFTER_DRAIN = false;
    bf16_t* O; int ldc;
    __device__ __forceinline__ void operator()(const Acc& acc, const Unit& u, int wr, int wc, int fr, int fq) const {
        const int row0 = u.pm * 256 + wr * 64 + fr, col0 = u.pn * 256 + wc * 32 + 8 * fq;
        EPI_ROWS(
            _Pragma("unroll") for (int bj = 0; bj < 2; ++bj) *(u32x4*)(O + (size_t)row * ldc + col0 + bj * 128) = pack8(acc[ai][bj][m][0], acc[ai][bj][m][1]); )
    }
};
struct EpiGlu {
    static constexpr bool PERM = true, AFTER_DRAIN = false;
    const bf16_t *YG, *SG; const float* bglu; bf16_t* Y3;
    __device__ __forceinline__ void operator()(const Acc& acc, const Unit& u, int wr, int wc, int fr, int fq) const {
        const int row0 = u.pm * 256 + wr * 64 + fr, col0 = u.pn * 256 + wc * 32 + 8 * fq;
        f32x4 b0[2], b1[2];
#pragma unroll
        for (int bj = 0; bj < 2; ++bj) { b0[bj] = *(const f32x4*)(bglu + col0 + bj * 128); b1[bj] = *(const f32x4*)(bglu + col0 + bj * 128 + 4); }
#pragma unroll
        for (int ai = 0; ai < 2; ++ai) {
            u32x4 yw[4][2], sw[4][2];
#pragma unroll
            for (int m = 0; m < 4; ++m)
#pragma unroll
                for (int bj = 0; bj < 2; ++bj) { const size_t off = (size_t)(row0 + ai * 128 + m * 16) * SW_ + col0 + bj * 128; yw[m][bj] = *(const u32x4*)(YG + off); sw[m][bj] = *(const u32x4*)(SG + off); }
#pragma unroll
            for (int m = 0; m < 4; ++m)
#pragma unroll
                for (int bj = 0; bj < 2; ++bj) { const size_t off = (size_t)(row0 + ai * 128 + m * 16) * SW_ + col0 + bj * 128;
                    wt16b(Y3, off, pack8(bf4lo(yw[m][bj]) * sigm4(acc[ai][bj][m][0] + b0[bj]) * bf4lo(sw[m][bj]), bf4hi(yw[m][bj]) * sigm4(acc[ai][bj][m][1] + b1[bj]) * bf4hi(sw[m][bj]))); }
        }
    }
};
template <int MODE> struct EpiMerge {
    static constexpr bool PERM = true, AFTER_DRAIN = false;
    const bf16_t *S, *TMPI; bf16_t* O;
    __device__ __forceinline__ void operator()(const Acc& acc, const Unit& u, int wr, int wc, int fr, int fq) const {
        const int row0 = u.pm * 256 + wr * 64 + fr, col0 = u.pn * 256 + wc * 32 + 8 * fq;
#pragma unroll
        for (int ai = 0; ai < 2; ++ai) {
            u32x4 sw[4][2], tw[4][2];
#pragma unroll
            for (int m = 0; m < 4; ++m)
#pragma unroll
                for (int bj = 0; bj < 2; ++bj) { const size_t off = (size_t)(row0 + ai * 128 + m * 16) * D_ + col0 + bj * 128; sw[m][bj] = *(const u32x4*)(S + off); if (MODE == 1) tw[m][bj] = *(const u32x4*)(TMPI + off); }
#pragma unroll
            for (int m = 0; m < 4; ++m)
#pragma unroll
                for (int bj = 0; bj < 2; ++bj) { const size_t off = (size_t)(row0 + ai * 128 + m * 16) * D_ + col0 + bj * 128;
                    f32x4 a = sigm4(bf4lo(sw[m][bj])) * acc[ai][bj][m][0], b = sigm4(bf4hi(sw[m][bj])) * acc[ai][bj][m][1];
                    if (MODE == 1) { a += bf4lo(tw[m][bj]); b += bf4hi(tw[m][bj]); }
                    if (MODE == 1) wt16b(O, off, pack8(a, b)); else *(u32x4*)(O + off) = pack8(a, b); }
        }
    }
};
struct EpiMergeMid {
    static constexpr bool PERM = true, AFTER_DRAIN = false;
    const bf16_t *SR, *SC;
    __device__ __forceinline__ void operator()(Acc& acc, const Unit& u, int wr, int wc, int fr, int fq) const {
        const int row0 = u.pm * 256 + wr * 64 + fr, col0 = u.pn * 256 + wc * 32 + 8 * fq;
#pragma unroll
        for (int ai = 0; ai < 2; ++ai) {
            u32x4 rw[4][2], cw[4][2];
#pragma unroll
            for (int m = 0; m < 4; ++m)
#pragma unroll
                for (int bj = 0; bj < 2; ++bj) { const size_t off = (size_t)(row0 + ai * 128 + m * 16) * D_ + col0 + bj * 128; rw[m][bj] = *(const u32x4*)(SR + off); cw[m][bj] = *(const u32x4*)(SC + off); }
#pragma unroll
            for (int m = 0; m < 4; ++m)
#pragma unroll
                for (int bj = 0; bj < 2; ++bj) { const f32x4 ca = sigm4(bf4lo(cw[m][bj])), cb = sigm4(bf4hi(cw[m][bj])), ra = sigm4(bf4lo(rw[m][bj])), rb = sigm4(bf4hi(rw[m][bj]));
#pragma unroll
                    for (int j = 0; j < 4; ++j) { acc[ai][bj][m][0][j] *= ca[j] * __builtin_amdgcn_rcpf(fmaxf(ra[j], 1e-30f)); acc[ai][bj][m][1][j] *= cb[j] * __builtin_amdgcn_rcpf(fmaxf(rb[j], 1e-30f)); } }
        }
    }
};
struct EpiMergeFin {
    static constexpr bool PERM = true, AFTER_DRAIN = false;
    const bf16_t* SR; bf16_t* O;
    __device__ __forceinline__ void operator()(Acc& acc, const Unit& u, int wr, int wc, int fr, int fq) const {
        const int row0 = u.pm * 256 + wr * 64 + fr, col0 = u.pn * 256 + wc * 32 + 8 * fq;
        u32x4 rw[2][4][2];
#pragma unroll
        for (int ai = 0; ai < 2; ++ai)
#pragma unroll
            for (int m = 0; m < 4; ++m)
#pragma unroll
                for (int bj = 0; bj < 2; ++bj) rw[ai][m][bj] = *(const u32x4*)(SR + (size_t)(row0 + ai * 128 + m * 16) * D_ + col0 + bj * 128);
#pragma unroll
        for (int ai = 0; ai < 2; ++ai)
#pragma unroll
            for (int m = 0; m < 4; ++m)
#pragma unroll
                for (int bj = 0; bj < 2; ++bj) { const f32x4 ra = sigm4(bf4lo(rw[ai][m][bj])), rb = sigm4(bf4hi(rw[ai][m][bj])); f32x4 a = acc[ai][bj][m][0], b = acc[ai][bj][m][1];
#pragma unroll
                    for (int j = 0; j < 4; ++j) { a[j] *= fmaxf(ra[j], 1e-30f); b[j] *= fmaxf(rb[j], 1e-30f); }
                    wt16b(O, (size_t)(row0 + ai * 128 + m * 16) * D_ + col0 + bj * 128, pack8(a, b)); }
    }
};
struct PanelX { float* part; unsigned* cnt; };
__device__ __forceinline__ void panel_rstd(const PanelX& px, const Unit& u, int wr, int wc, int fr, int fq, float (&s)[2][4]) {
    const int row0 = u.pm * 256 + wr * 64 + fr;
    const rsrc_t pr = __builtin_amdgcn_make_buffer_rsrc((void*)px.part, (short)0, L_ * 16 * 4, 0x00020000);
#pragma unroll
    for (int ai = 0; ai < 2; ++ai)
#pragma unroll
        for (int m = 0; m < 4; ++m) { float t = s[ai][m]; t += __shfl_xor(t, 16); t += __shfl_xor(t, 32);
            if (fq == 0) __builtin_amdgcn_raw_buffer_store_b32(__float_as_uint(t), pr, (unsigned)(((row0 + ai * 128 + m * 16) * 16 + u.pn * 4 + wc) * 4), 0, 16); }
    u32x4 q[2][4];
    for (unsigned spins = 0;; ++spins) {
        bool ok = true;
#pragma unroll
        for (int ai = 0; ai < 2; ++ai)
#pragma unroll
            for (int m = 0; m < 4; ++m) { q[ai][m] = __builtin_amdgcn_raw_buffer_load_b128(pr, (unsigned)(((row0 + ai * 128 + m * 16) * 16 + fq * 4) * 4), 0, 16);
                ok = ok && (q[ai][m].x != 0xFFFFFFFFu) && (q[ai][m].y != 0xFFFFFFFFu) && (q[ai][m].z != 0xFFFFFFFFu) && (q[ai][m].w != 0xFFFFFFFFu); }
        if (__all(ok) || spins > (1u << 18)) break;
        __builtin_amdgcn_s_sleep(2);
    }
#pragma unroll
    for (int ai = 0; ai < 2; ++ai)
#pragma unroll
        for (int m = 0; m < 4; ++m) { float t = (__uint_as_float(q[ai][m].x) + __uint_as_float(q[ai][m].y)) + (__uint_as_float(q[ai][m].z) + __uint_as_float(q[ai][m].w)); t += __shfl_xor(t, 16); t += __shfl_xor(t, 32);
            s[ai][m] = rsqrtf(t * (1.0f / D_) + EPS_); }
}
__device__ __forceinline__ float sq8(f32x4 a, f32x4 b) { return ((a[0] * a[0] + a[1] * a[1]) + (a[2] * a[2] + a[3] * a[3])) + ((b[0] * b[0] + b[1] * b[1]) + (b[2] * b[2] + b[3] * b[3])); }
struct EpiX1 {
    static constexpr bool PERM = true, AFTER_DRAIN = true;
    const float *x, *gain; bf16_t* X1B; PanelX px;
    __device__ __forceinline__ void operator()(Acc& acc, const Unit& u, int wr, int wc, int fr, int fq) const {
        const int row0 = u.pm * 256 + wr * 64 + fr, col0 = u.pn * 256 + wc * 32 + 8 * fq;
        float s[2][4];
#pragma unroll
        for (int ai = 0; ai < 2; ++ai)
#pragma unroll
            for (int m = 0; m < 4; ++m) s[ai][m] = sq8(acc[ai][0][m][0], acc[ai][0][m][1]) + sq8(acc[ai][1][m][0], acc[ai][1][m][1]);
        panel_rstd(px, u, wr, wc, fr, fq, s);
        f32x4 g0[2], g1[2];
#pragma unroll
        for (int bj = 0; bj < 2; ++bj) { g0[bj] = *(const f32x4*)(gain + col0 + bj * 128); g1[bj] = *(const f32x4*)(gain + col0 + bj * 128 + 4); }
#pragma unroll
        for (int ai = 0; ai < 2; ++ai) {
            f32x4 xa[4][2], xb[4][2];
#pragma unroll
            for (int m = 0; m < 4; ++m)
#pragma unroll
                for (int bj = 0; bj < 2; ++bj) { const size_t off = (size_t)(row0 + ai * 128 + m * 16) * D_ + col0 + bj * 128; xa[m][bj] = *(const f32x4*)(x + off); xb[m][bj] = *(const f32x4*)(x + off + 4); }
#pragma unroll
            for (int m = 0; m < 4; ++m) { const float rs = s[ai][m];
#pragma unroll
                for (int bj = 0; bj < 2; ++bj) { const size_t off = (size_t)(row0 + ai * 128 + m * 16) * D_ + col0 + bj * 128;
                    const f32x4 ya = xa[m][bj] + acc[ai][bj][m][0] * rs * g0[bj], yb = xb[m][bj] + acc[ai][bj][m][1] * rs * g1[bj];
                    wt16b(X1B, off, pack8(ya, yb)); } }
        }
    }
};
struct EpiOut {
    static constexpr bool PERM = true, AFTER_DRAIN = true;
    const bf16_t *PE, *X1B; const float* gain; float* OUT; PanelX px;
    __device__ __forceinline__ void operator()(Acc& acc, const Unit& u, int wr, int wc, int fr, int fq) const {
        const int row0 = u.pm * 256 + wr * 64 + fr, col0 = u.pn * 256 + wc * 32 + 8 * fq;
        float s[2][4];
#pragma unroll
        for (int ai = 0; ai < 2; ++ai) {
            u32x4 pw[4][2];
#pragma unroll
            for (int m = 0; m < 4; ++m)
#pragma unroll
                for (int bj = 0; bj < 2; ++bj) pw[m][bj] = *(const u32x4*)(PE + (size_t)(row0 + ai * 128 + m * 16) * D_ + col0 + bj * 128);
#pragma unroll
            for (int m = 0; m < 4; ++m) { float t = 0.f;
#pragma unroll
                for (int bj = 0; bj < 2; ++bj) { acc[ai][bj][m][0] = bf4lo(pw[m][bj]) * sigm4(acc[ai][bj][m][0]); acc[ai][bj][m][1] = bf4hi(pw[m][bj]) * sigm4(acc[ai][bj][m][1]);
                    t += sq8(acc[ai][bj][m][0], acc[ai][bj][m][1]); }
                s[ai][m] = t; }
        }
        panel_rstd(px, u, wr, wc, fr, fq, s);
        f32x4 g0[2], g1[2];
#pragma unroll
        for (int bj = 0; bj < 2; ++bj) { g0[bj] = *(const f32x4*)(gain + col0 + bj * 128); g1[bj] = *(const f32x4*)(gain + col0 + bj * 128 + 4); }
#pragma unroll
        for (int ai = 0; ai < 2; ++ai) {
            u32x4 xw[4][2];
#pragma unroll
            for (int m = 0; m < 4; ++m)
#pragma unroll
                for (int bj = 0; bj < 2; ++bj) xw[m][bj] = *(const u32x4*)(X1B + (size_t)(row0 + ai * 128 + m * 16) * D_ + col0 + bj * 128);
#pragma unroll
            for (int m = 0; m < 4; ++m) { const float rs = s[ai][m];
#pragma unroll
                for (int bj = 0; bj < 2; ++bj) { const size_t off = (size_t)(row0 + ai * 128 + m * 16) * D_ + col0 + bj * 128;
                    *(f32x4*)(OUT + off) = bf4lo(xw[m][bj]) + acc[ai][bj][m][0] * rs * g0[bj]; *(f32x4*)(OUT + off + 4) = bf4hi(xw[m][bj]) + acc[ai][bj][m][1] * rs * g1[bj]; } }
        }
    }
};

__device__ __forceinline__ void tconv_tile(const float* __restrict__ src, int lds_, int sc0, int k0, bf16_t* __restrict__ dst, int ldd, int n0, float* tile  ) {
    const int tid = threadIdx.x;
    { const int nn = tid & 63, kb = tid >> 6; const float* pp = src + (size_t)(k0 + kb) * lds_ + sc0 + nn; const size_t step = (size_t)8 * lds_;
#pragma unroll 1
      for (int hb = 0; hb < 2; ++hb) { float v[16];
#pragma unroll
        for (int i = 0; i < 16; ++i) { v[i] = *pp; pp += step; }
#pragma unroll
        for (int i = 0; i < 16; ++i) tile[(kb + 8 * (hb * 16 + i)) * 65 + nn] = v[i]; } }
    __syncthreads();
#pragma unroll
    for (int i = 0; i < 4; ++i) { const int pidx = tid + 512 * i, kk2 = (pidx & 31) * 8, nn2 = pidx >> 5;
      f32x4 a, b;
#pragma unroll
      for (int j = 0; j < 4; ++j) { a[j] = tile[(kk2 + j) * 65 + nn2]; b[j] = tile[(kk2 + 4 + j) * 65 + nn2]; }
      *(u32x4*)(dst + (size_t)(n0 + nn2) * ldd + k0 + kk2) = pack8(a, b); }
    __syncthreads();
}
__device__ __forceinline__ int win_srccol(int n0) {
    const int pn = n0 >> 8, j = n0 & 255;
    if (pn < 2) return 256 * pn + j;
    if (pn < 4) return 512 + 256 * (pn - 2) + j;
    if (pn < 12) { const int i = pn - 4; return j < 128 ? 1024 + 128 * i + j : 3072 + 128 * i + (j - 128); }
    if (pn < 20) { const int i = pn - 12; return j < 128 ? 2048 + 128 * i + j : 4096 + 128 * i + (j - 128); }
    if (pn < 24) return 5120 + 256 * (pn - 20) + j;
    return 6144 + 256 * (pn - 24) + j;
}
__device__ void ssm_prep(const Params& P, int g, int r, unsigned char* smem) {
    float2* s_ab = (float2*)smem;
    float2* s_Bb = s_ab + 64;
    float2* s_C = s_Bb + 1024;
    float2* s_pw = s_C + 1024;
    float* s_Kd = (float*)(s_pw + 64 * 33);
    const int tid = threadIdx.x;
    bf16_t* MC = (bf16_t*)(P.ws + WS_MC); bf16_t* WST = (bf16_t*)(P.ws + WS_WST); float2* abT = (float2*)(P.ws + WS_ABT);
    if (tid < 64) {
        const int p = tid; const float dt = expf(P.log_step[g]); const float ar = P.a_re[g * 64 + p], ai = P.a_im[g * 64 + p];
        const float mag = expf(ar * dt), th = ai * dt; const float abr = mag * cosf(th), abi = mag * sinf(th);
        const float den = ar * ar + ai * ai, nr = abr - 1.0f; const float fr = (nr * ar + abi * ai) / den, fi = (abi * ar - nr * ai) / den;
        s_ab[p] = make_float2(abr, abi);
#pragma unroll 1
        for (int h = 0; h < 16; ++h) { const float br = P.b_re[(g * 64 + p) * 16 + h], bi = P.b_im[(g * 64 + p) * 16 + h]; s_Bb[p * 16 + h] = make_float2(fr * br - fi * bi, fr * bi + fi * br); }
        float cr = 1.f, ci = 0.f;
#pragma unroll 1
        for (int d = 0; d <= T_; ++d) { s_pw[p * 33 + d] = make_float2(cr, ci); const float nr2 = cr * abr - ci * abi, ni2 = cr * abi + ci * abr; cr = nr2; ci = ni2; }
        if (r == 0) abT[g * 64 + p] = s_pw[p * 33 + T_];
    }
    for (int i = tid; i < 1024; i += 512) { const int h = i >> 6, p = i & 63; s_C[i] = make_float2(P.c_re[(g * 16 + h) * 64 + p], P.c_im[(g * 16 + h) * 64 + p]); }
    __syncthreads();
#pragma unroll 1
    for (int i = 0; i < 4; ++i) { const int idx = tid + 512 * i, d = idx >> 6, hh = (idx >> 4) & 3, hp = idx & 15, h = 4 * r + hh; float a = 0.f;
#pragma unroll 4
        for (int p = 0; p < 64; ++p) { const float2 c = s_C[h * 64 + p], w = s_pw[p * 33 + d], b = s_Bb[p * 16 + hp]; const float xr = c.x * w.x - c.y * w.y, xi = c.x * w.y + c.y * w.x; a += xr * b.x - xi * b.y; }
        if (d == 0 && h == hp) a += P.d_skip[g * 16 + h];
        s_Kd[idx] = a; }
    __syncthreads();
#pragma unroll 1
    for (int i = 0; i < 20; ++i) { const int pidx = tid + 512 * i, rowi = pidx / 80, col8 = (pidx % 80) * 8, t = rowi >> 2, hh = rowi & 3, h = 4 * r + hh;
        f32x4 a = {0.f, 0.f, 0.f, 0.f}, b = {0.f, 0.f, 0.f, 0.f};
        if (col8 < KU_) { const int k = col8 >> 4, h0 = col8 & 15;
            if (k <= t) { const float* kd = s_Kd + (t - k) * 64 + hh * 16 + h0; a = (f32x4){kd[0], kd[1], kd[2], kd[3]}; b = (f32x4){kd[4], kd[5], kd[6], kd[7]}; } }
        else { const int q0 = col8 - KU_, im = q0 >= 64, p0 = q0 & 63;
#pragma unroll
            for (int j = 0; j < 8; ++j) { const float2 c = s_C[h * 64 + p0 + j], w = s_pw[(p0 + j) * 33 + t + 1]; const float v = im ? -(c.x * w.y + c.y * w.x) : (c.x * w.x - c.y * w.y); if (j < 4) a[j] = v; else b[j - 4] = v; } }
        *(u32x4*)(MC + ((size_t)(g * KU_ + t * 16 + h)) * LDU_ + col8) = pack8(a, b); }
#pragma unroll 1
    for (int i = 0; i < 4; ++i) { const int pidx = tid + 512 * i, q = 32 * r + (pidx >> 6), col8 = (pidx & 63) * 8, k = col8 >> 4, h0 = col8 & 15, p = q & 63, im = q >= 64;
        const float2 w = s_pw[p * 33 + (T_ - 1 - k)]; f32x4 a, b;
#pragma unroll
        for (int j = 0; j < 8; ++j) { const float2 bb = s_Bb[p * 16 + h0 + j]; const float v = im ? (w.x * bb.y + w.y * bb.x) : (w.x * bb.x - w.y * bb.y); if (j < 4) a[j] = v; else b[j - 4] = v; }
        *(u32x4*)(WST + ((size_t)(g * 256 + q)) * KU_ + col8) = pack8(a, b); }
    __syncthreads();
}

__device__ __forceinline__ void do_job(const Params& P, unsigned char* smem, int job) {
    const int tid = threadIdx.x;
    unsigned char* ws = P.ws;
    constexpr int J_SSM = 128, J_TC = 704, J_RMS = 512;
    {
        int j = job;
        if (j < J_SSM) { ssm_prep(P, j >> 2, j & 3, smem); return; }
        j -= J_SSM;
        if (j < J_TC) {
            const float* src; bf16_t* dst; int K, N, off; bool perm = false;
            if (j < 448) { src = P.w_in; dst = (bf16_t*)(ws + WS_WIN); K = 1024; N = INW_; perm = true; }
            else if ((off = j - 448) < 16) { j = off; src = P.w_glu; dst = (bf16_t*)(ws + WS_WGLU); K = 512; N = 512; }
            else if ((off = j - 464) < 32) { j = off; src = P.w_ssm_out; dst = (bf16_t*)(ws + WS_WSSO); K = 512; N = 1024; }
            else if ((off = j - 496) < 64) { j = off; src = P.w_conv_out; dst = (bf16_t*)(ws + WS_WCO); K = 1024; N = 1024; }
            else if ((off = j - 560) < 64) { j = off; src = P.w_o; dst = (bf16_t*)(ws + WS_WO); K = 1024; N = 1024; }
            else if ((off = j - 624) < 16) { j = off; src = P.w_ple; dst = (bf16_t*)(ws + WS_WPLE); K = 256; N = 1024; }
            else { j = j - 640; src = P.w_ple_gate; dst = (bf16_t*)(ws + WS_WG); K = 1024; N = 1024; }
            const int nkt = K >> 8, ntile = j / nkt, ktile = j % nkt, n0 = ntile * 64, k0 = ktile * 256;
            const int sc0 = perm ? win_srccol(n0) : n0;
            tconv_tile(src, N, sc0, k0, dst, K, n0, (float*)smem);
            return;
        }
        j -= J_TC;
        if (j < J_RMS) {
            const int lane = tid & 63, rowb = j * 32 + (tid >> 6) * 4;
            f32x4 v[4][4]; float s[4];
#pragma unroll
            for (int rr = 0; rr < 4; ++rr)
#pragma unroll
                for (int i = 0; i < 4; ++i) v[rr][i] = *(const f32x4*)(P.x + (size_t)(rowb + rr) * D_ + i * 256 + lane * 4);
#pragma unroll
            for (int rr = 0; rr < 4; ++rr) { float t = 0.f;
#pragma unroll
                for (int i = 0; i < 4; ++i) t += (v[rr][i][0] * v[rr][i][0] + v[rr][i][1] * v[rr][i][1]) + (v[rr][i][2] * v[rr][i][2] + v[rr][i][3] * v[rr][i][3]);
#pragma unroll
                for (int o = 32; o >= 1; o >>= 1) t += __shfl_xor(t, o);
                s[rr] = rsqrtf(t * (1.0f / D_) + EPS_); }
#pragma unroll
            for (int i = 0; i < 4; ++i) { const f32x4 gn = *(const f32x4*)(P.pre_norm + i * 256 + lane * 4);
#pragma unroll
                for (int rr = 0; rr < 4; ++rr) { const f32x4 y = v[rr][i] * s[rr] * gn; u32x2 w; w.x = cvt_pk_bf16(y[0], y[1]); w.y = cvt_pk_bf16(y[2], y[3]);
                    *(u32x2*)((bf16_t*)P.out + (size_t)(rowb + rr) * D_ + i * 256 + lane * 4) = w; } }
            return;
        }
        j -= J_RMS;
        {
            const size_t e0 = (size_t)j * 8192 + tid * 8;
            const f32x4 a0 = *(const f32x4*)(P.p + e0), b0 = *(const f32x4*)(P.p + e0 + 4), a1 = *(const f32x4*)(P.p + e0 + 4096), b1 = *(const f32x4*)(P.p + e0 + 4100);
            *(u32x4*)((bf16_t*)(ws + WS_PBF) + e0) = pack8(a0, b0); *(u32x4*)((bf16_t*)(ws + WS_PBF) + e0 + 4096) = pack8(a1, b1);
        }
    }
}

__device__ void phase_z(const Params& P, int b0, int nbz) {
    const bf16_t* V = (const bf16_t*)P.out + (size_t)L_ * D_;
    const bf16_t* W = (const bf16_t*)(P.ws + WS_W); bf16_t* Z = (bf16_t*)(P.ws + WS_Z);
    const int nthreads = nbz * 512;
    for (int idx = (blockIdx.x - b0) * 512 + threadIdx.x; idx < (L_ / 16) * 128; idx += nthreads) {
        const int oct = idx & 127, tb = idx >> 7, t0 = tb * 16, c0 = oct * 8;
        const f32x4 k0a = *(const f32x4*)(P.conv_w + c0), k0b = *(const f32x4*)(P.conv_w + c0 + 4);
        const f32x4 k1a = *(const f32x4*)(P.conv_w + CWID_ + c0), k1b = *(const f32x4*)(P.conv_w + CWID_ + c0 + 4);
        const f32x4 k2a = *(const f32x4*)(P.conv_w + 2 * CWID_ + c0), k2b = *(const f32x4*)(P.conv_w + 2 * CWID_ + c0 + 4);
        f32x4 m2a = {0.f, 0.f, 0.f, 0.f}, m2b = m2a, m1a = m2a, m1b = m2a;
        if (t0 > 0) { const u32x4 w2 = *(const u32x4*)(V + (size_t)(t0 - 2) * CWID_ + c0), w1 = *(const u32x4*)(V + (size_t)(t0 - 1) * CWID_ + c0);
            m2a = bf4lo(w2); m2b = bf4hi(w2); m1a = bf4lo(w1); m1b = bf4hi(w1); }
#pragma unroll
        for (int t = 0; t < 16; ++t) { const size_t off = (size_t)(t0 + t) * CWID_ + c0;
            const u32x4 vw = *(const u32x4*)(V + off), ww = *(const u32x4*)(W + off);
            const f32x4 va = bf4lo(vw), vb = bf4hi(vw);
            const f32x4 ca = k0a * m2a + k1a * m1a + k2a * va, cb = k0b * m2b + k1b * m1b + k2b * vb;
            *(u32x4*)(Z + off) = pack8(bf4lo(ww) * ca, bf4hi(ww) * cb);
            m2a = m1a; m2b = m1b; m1a = va; m1b = vb; }
    }
}
__device__ void carry_group(const Params& P, int g, unsigned char* smem) {
    const float2* abT = (const float2*)(P.ws + WS_ABT); const float* SLOC = (const float*)(P.ws + WS_SLOC); bf16_t* U = (bf16_t*)(P.ws + WS_U);
    float* sl = (float*)smem; unsigned* slw = (unsigned*)smem;
    float2* seg = (float2*)(smem + pg8::STAGE_BYTES + 64);
    const int tid = threadIdx.x, w = tid >> 6, p = tid & 63;
    const float2 a = abT[g * 64 + p];
    float2 a32 = a;
#pragma unroll
    for (int i = 0; i < 5; ++i) a32 = make_float2(a32.x * a32.x - a32.y * a32.y, 2.f * a32.x * a32.y);
    float sr = 0.f, si = 0.f;
    for (int half = 0; half < 2; ++half) {
        const f32x4* src = (const f32x4*)(SLOC + (size_t)(g * NCH_ + half * 256) * 128);
#pragma unroll
        for (int i = 0; i < 16; ++i) ((f32x4*)sl)[tid + 512 * i] = src[tid + 512 * i];
        __syncthreads();
        {
            float tr = 0.f, ti = 0.f;
#pragma unroll 8
            for (int c = 0; c < 32; ++c) { const float lr = sl[(32 * w + c) * 128 + p], li = sl[(32 * w + c) * 128 + 64 + p];
                const float nr = a.x * tr - a.y * ti + lr, ni = a.x * ti + a.y * tr + li; tr = nr; ti = ni; }
            seg[w * 64 + p] = make_float2(tr, ti);
        }
        __syncthreads();
        float wr_ = sr, wi_ = si;
#pragma unroll
        for (int j = 0; j < 8; ++j) { const float2 t = seg[j * 64 + p];
            const float nr = a32.x * sr - a32.y * si + t.x, ni = a32.x * si + a32.y * sr + t.y; sr = nr; si = ni;
            if (j + 1 == w) { wr_ = sr; wi_ = si; } }
#pragma unroll 8
        for (int c = 0; c < 32; ++c) { const float lr = sl[(32 * w + c) * 128 + p], li = sl[(32 * w + c) * 128 + 64 + p];
            slw[(32 * w + c) * 128 + p] = cvt_pk_bf16(wr_, wi_);
            const float nr = a.x * wr_ - a.y * wi_ + lr, ni = a.x * wi_ + a.y * wr_ + li; wr_ = nr; wi_ = ni; }
        __syncthreads();
#pragma unroll
        for (int i = 0; i < 4; ++i) { const int it = tid + 512 * i, c = it >> 3, p0 = (it & 7) * 8;
            const u32x4 w0 = *(const u32x4*)(slw + c * 128 + p0), w1 = *(const u32x4*)(slw + c * 128 + p0 + 4);
            u32x4 re, im;
            re.x = (w0.x & 0xffffu) | (w0.y << 16); re.y = (w0.z & 0xffffu) | (w0.w << 16); re.z = (w1.x & 0xffffu) | (w1.y << 16); re.w = (w1.z & 0xffffu) | (w1.w << 16);
            im.x = (w0.x >> 16) | (w0.y & 0xffff0000u); im.y = (w0.z >> 16) | (w0.w & 0xffff0000u); im.z = (w1.x >> 16) | (w1.y & 0xffff0000u); im.w = (w1.z >> 16) | (w1.w & 0xffff0000u);
            bf16_t* u = U + (size_t)(g * NCH_ + half * 256 + c) * LDU_ + KU_ + p0;
            *(u32x4*)u = re; *(u32x4*)(u + 64) = im; }
        __syncthreads();
    }
}

__global__ void __launch_bounds__(512, 2) hybrid_fwd(Params P) {
    extern __shared__ __attribute__((aligned(16))) unsigned char smem[];
    LAS unsigned char* lds = (LAS unsigned char*)smem;
    unsigned char* ws = P.ws;
    const int bid = blockIdx.x, nb = gridDim.x;
    const int lo = P.ph_lo, hi = P.ph_hi;
#define IN(k) (lo <= (k) && (k) < hi)
    volatile LAS unsigned* xb_st = (volatile LAS unsigned*)(lds + pg8::STAGE_BYTES);
    XcdBarrier xbar; xbar.bar = (unsigned*)(ws + WS_BAR); xbar.x = 0; xbar.st = xb_st;
    if (hi - lo > 1) {
        if (threadIdx.x < 4) xb_st[threadIdx.x] = 0u;
        __syncthreads();
        xbar = xcd_barrier_post((unsigned*)(ws + WS_BAR), xb_st);
    }
    if (lo == 0x7fffffff) cg::this_grid().sync();
#define SEAM(k) do { if (IN(k) && IN((k) + 1)) { xcd_barrier(xbar); } } while (0)
    bf16_t* H = (bf16_t*)P.out; bf16_t* V = (bf16_t*)P.out + (size_t)L_ * D_;
    bf16_t* YG = (bf16_t*)P.out; bf16_t* Y3 = (bf16_t*)P.out + (size_t)L_ * SW_; bf16_t* TMP = (bf16_t*)P.out + (size_t)L_ * D_;
    bf16_t* U = (bf16_t*)(ws + WS_U);

    if (IN(0)) { for (int idx = bid; idx < 1088; idx += nb) do_job(P, smem, idx < 576 ? idx : idx + 256); } SEAM(0);
    if (IN(1)) {
        pg8::Gemm g{H, (const bf16_t*)(ws + WS_WIN), D_, D_, D_}; pg8::StaticOrder S; S.init(L_, INW_, nb, bid);
        EpiG1 E{U, (bf16_t*)(ws + WS_SG), V, (bf16_t*)(ws + WS_W), (bf16_t*)(ws + WS_SR), (bf16_t*)(ws + WS_SC)};
        pg8::gemm_phase(lds, g, S, E);
    } SEAM(1);
    if (IN(2)) {
        const int nbs = nb >= 128 ? 64 : 0;
        if (bid < nbs || nbs == 0) {
            pg8::Gemm g{U, (const bf16_t*)(ws + WS_WST), LDU_, KU_, KU_}; pg8::BatchOrder S{64, nbs ? nbs : nb, bid, 1};
            EpiS1 E{(float*)(ws + WS_SLOC), (unsigned*)(ws + WS_CNT) + 2 * 64 * 64, &P, smem};
            pg8::gemm_phase(lds, g, S, E);
        }
        if (nbs == 0 || bid >= nbs) { phase_z(P, nbs, nb - nbs); for (int idx = bid - nbs; idx < 528; idx += nb - nbs) do_job(P, smem, idx < 512 ? 1344 + idx : 752 + (idx - 512)); }
    } SEAM(2);
    if (IN(3)) {
        const int nbs = nb >= 256 ? 128 : 0;
        if (bid < nbs || nbs == 0) {
            pg8::Gemm g{U, (const bf16_t*)(ws + WS_MC), LDU_, LDU_, LDU_}; pg8::BatchOrder S{128, nbs ? nbs : nb, bid, 2};
            EpiS2 E{YG};
            pg8::gemm_phase(lds, g, S, E);
        }
        if (bid >= nbs || nbs == 0) {
            pg8::Gemm g{(const bf16_t*)(ws + WS_PBF), (const bf16_t*)(ws + WS_WPLE), PLE_, PLE_, PLE_}; pg8::StaticOrder S; S.init(L_, D_, nbs ? nb - nbs : nb, nbs ? bid - nbs : bid);
            EpiStore E{(bf16_t*)(ws + WS_PE), D_};
            pg8::gemm_phase(lds, g, S, E);
            __syncthreads();
            for (int idx = nbs ? bid - nbs : bid; idx < 240; idx += (nbs ? nb - nbs : nb)) do_job(P, smem, 576 + idx + (idx >= 176 ? 16 : 0));
        }
    } SEAM(3);
    if (IN(4)) {
#define cntY3 ((unsigned*)(P.ws + WS_CNT) + 2 * 64 * 64 + 32 * 64)
#define cntMG (cntY3 + 64 * 64)
#define cntX1 (cntMG + 64 * 64)
        const bool has = (nb == 256);
#define MY_PM (8 * (bid & 7) + ((bid >> 3) & 7))
        { pg8::Gemm g{YG, (const bf16_t*)(ws + WS_WGLU), SW_, SW_, SW_}; pg8::StaticOrder S; S.init(L_, SW_, nb, bid);
          EpiGlu E{YG, (const bf16_t*)(ws + WS_SG), P.b_glu, Y3};
          pg8::gemm_phase(lds, g, S, E);
          if (has && bid < 128) panel_arrive(cntY3, MY_PM); }
        if (has) {
            { pg8::AccT mt;
              { pg8::Gemm g{(const bf16_t*)(ws + WS_Z), (const bf16_t*)(ws + WS_WCO), D_, D_, D_}; pg8::StaticOrder S; S.init(L_, D_, nb, bid);
                EpiMergeMid E{(const bf16_t*)(ws + WS_SR), (const bf16_t*)(ws + WS_SC)}; pg8::gemm_phase_acc<true>(lds, g, S, E, mt); }
              panel_wait(cntY3, MY_PM, 2u);
              { pg8::Gemm g{Y3, (const bf16_t*)(ws + WS_WSSO), SW_, SW_, SW_}; pg8::StaticOrder S; S.init(L_, D_, nb, bid);
                EpiMergeFin E{(const bf16_t*)(ws + WS_SR), (bf16_t*)(ws + WS_MERGED)}; pg8::gemm_phase_acc<false>(lds, g, S, E, mt); } }
            panel_arrive(cntMG, MY_PM);
            panel_wait(cntMG, MY_PM, 4u);
            pg8::Gemm g{(const bf16_t*)(ws + WS_MERGED), (const bf16_t*)(ws + WS_WO), D_, D_, D_}; pg8::StaticOrder S; S.init(L_, D_, nb, bid);
            { EpiX1 E{P.x, P.post_norm, (bf16_t*)(ws + WS_X1BF), PanelX{(float*)(ws + WS_MISC), (unsigned*)(ws + WS_CNT)}}; pg8::gemm_phase(lds, g, S, E); }
            asm volatile("s_waitcnt vmcnt(0)" ::: "memory"); __syncthreads();
            panel_arrive(cntX1, MY_PM);
            if (threadIdx.x < 4) { const int q = MY_PM, p0 = q < 16 ? 4 * q : (q < 32 ? 4 * (q - 16) : 2 * (q - 32)), np = q < 32 ? 4 : 2;
                if ((int)threadIdx.x < np) { unsigned spins = 0;
                    while (__hip_atomic_load(cntMG + 64 * (p0 + (int)threadIdx.x), __ATOMIC_RELAXED, __HIP_MEMORY_SCOPE_AGENT) < 4u) { __builtin_amdgcn_s_sleep(2); if (++spins > (1u << 21)) break; } } }
            panel_wait(cntX1, MY_PM, 4u);
            pg8::Gemm g7{(const bf16_t*)(ws + WS_X1BF), (const bf16_t*)(ws + WS_WG), D_, D_, D_}; pg8::StaticOrder S7; S7.init(L_, D_, nb, bid);
            EpiOut E7{(const bf16_t*)(ws + WS_PE), (const bf16_t*)(ws + WS_X1BF), P.ple_norm, P.out, PanelX{(float*)(ws + WS_MISC + 1 * MiB), (unsigned*)(ws + WS_CNT) + 64 * 64}}; pg8::gemm_phase(lds, g7, S7, E7);
        }
#undef MY_PM
#undef cntY3
#undef cntMG
#undef cntX1
    }
#undef IN
#undef SEAM
}


extern "C" void kernel_launch(void* const* d_in, const int* in_sizes, int n_in, void* d_out, int out_size, void* d_ws, size_t ws_size, hipStream_t stream) {
    constexpr int LDS_BYTES = pg8::STAGE_BYTES + 64 + 4096;
    static int grid = 0;
    if (grid == 0) {
        if (n_in != 22 || out_size != L_ * D_ || ws_size < WS_END) { fprintf(stderr, "kernel_launch: unexpected shapes (n_in %d out %d ws %zu)\n", n_in, out_size, ws_size); grid = -1; return; }
        int dev = 0, cus = 0, per_cu = 0;
        hipGetDevice(&dev); hipDeviceGetAttribute(&cus, hipDeviceAttributeMultiprocessorCount, dev);
        if (hipFuncSetAttribute((const void*)hybrid_fwd, hipFuncAttributeMaxDynamicSharedMemorySize, LDS_BYTES) != hipSuccess) { fprintf(stderr, "kernel_launch: hipFuncSetAttribute failed\n"); grid = -1; return; }
        hipOccupancyMaxActiveBlocksPerMultiprocessor(&per_cu, (const void*)hybrid_fwd, 512, LDS_BYTES);
        (void)hipGetLastError();
        if (per_cu < 1) per_cu = 1;
        grid = cus;
        fprintf(stderr, "kernel_launch: cus %d per_cu %d grid %d\n", cus, per_cu, grid);
    }
    if (grid < 0) return;
    Params P{};
    const float** f = (const float**)&P;
    for (int i = 0; i < 22; ++i) f[i] = (const float*)d_in[i];
    P.out = (float*)d_out; P.ws = (unsigned char*)d_ws;
    (void)hipMemsetAsync((unsigned char*)d_ws + WS_MISC, 0xFF, 2 * MiB, stream);
    (void)hipMemsetAsync((unsigned char*)d_ws + WS_BAR, 0, 16384 + 2 * 64 * 256 + 32 * 256 + 3 * 64 * 256, stream);
#if ONE_LAUNCH
    P.ph_lo = 0; P.ph_hi = NPH;
    void* args[] = {&P};
    hipError_t e = hipLaunchCooperativeKernel((const void*)hybrid_fwd, dim3(grid), dim3(512), args, LDS_BYTES, stream);
    if (e != hipSuccess) fprintf(stderr, "cooperative launch failed: %s (grid %d)\n", hipGetErrorString(e), grid);
#else
    for (int ph = 0; ph < NPH; ++ph) {
        P.ph_lo = ph; P.ph_hi = ph + 1;
        hipLaunchKernelGGL(hybrid_fwd, dim3(grid), dim3(512), LDS_BYTES, stream, P);
    }
#endif
}
```

```cpp
#include <hip/hip_runtime.h>
#include <hip/hip_cooperative_groups.h>
#include <cstdio>
namespace cg = cooperative_groups;

#ifndef ONE_LAUNCH
#define ONE_LAUNCH 1
#endif

#define LAS __attribute__((address_space(3)))
typedef unsigned short bf16_t;
typedef short bf16x8 __attribute__((ext_vector_type(8)));
typedef float f32x4 __attribute__((ext_vector_type(4)));
typedef unsigned u32x4 __attribute__((ext_vector_type(4)));
typedef unsigned u32x2 __attribute__((ext_vector_type(2)));

constexpr int L_ = 16384, D_ = 1024, PLE_ = 256, SW_ = 512, NG_ = 32, CWID_ = 1024, INW_ = 7168;
constexpr int T_ = 32, NCH_ = L_ / T_  , KU_ = T_ * 16  , LDU_ = KU_ + 128  ;
constexpr float EPS_ = 1e-6f;
constexpr size_t MiB = 1024 * 1024;
constexpr size_t WS_WGLU = 0, WS_WSSO = WS_WGLU + 512 * 512 * 2, WS_WCO = WS_WSSO + 1024 * 512 * 2, WS_WO = WS_WCO + 2 * MiB, WS_WPLE = WS_WO + 2 * MiB,
                 WS_WG = WS_WPLE + 1024 * 256 * 2, WS_WIN = 8 * MiB, WS_MC = WS_WIN + 14 * MiB, WS_WST = WS_MC + 20 * MiB, WS_PBF = WS_WST + 8 * MiB,
                 WS_U = WS_PBF + 8 * MiB, WS_SLOC = WS_U + 20 * MiB, WS_SG = WS_SLOC + 8 * MiB, WS_W = WS_SG + 16 * MiB, WS_SR = WS_W + 32 * MiB,
                 WS_SC = WS_SR + 32 * MiB, WS_Z = WS_SC + 32 * MiB, WS_MISC = WS_Z + 32 * MiB, WS_END = WS_MISC + 3 * MiB;
constexpr size_t WS_ABT = WS_MISC + 2 * MiB, WS_BAR = WS_MISC + 2 * MiB + 64 * 1024, WS_CNT = WS_BAR + 16384;
constexpr size_t WS_PE = WS_W, WS_MERGED = WS_MC, WS_O = WS_SR, WS_X1BF = WS_SC, WS_E = WS_Z;
constexpr int NPH = 5;

struct Params {
    const float *x, *p, *pre_norm, *w_in, *a_re, *a_im, *log_step, *b_re, *b_im, *c_re, *c_im, *d_skip, *w_glu, *b_glu, *w_ssm_out, *conv_w, *w_conv_out, *w_o,
        *post_norm, *w_ple, *w_ple_gate, *ple_norm;
    float* out; unsigned char* ws; int ph_lo, ph_hi;
};

typedef __bf16 bf16x2_t __attribute__((ext_vector_type(2)));
typedef float f32x2_t __attribute__((ext_vector_type(2)));
__device__ __forceinline__ unsigned cvt_pk_bf16(float lo, float hi) { f32x2_t v = {lo, hi}; bf16x2_t b = __builtin_convertvector(v, bf16x2_t); return __builtin_bit_cast(unsigned, b); }
__device__ __forceinline__ float bflo(unsigned w) { return __uint_as_float(w << 16); }
__device__ __forceinline__ float bfhi(unsigned w) { return __uint_as_float(w & 0xffff0000u); }
__device__ __forceinline__ f32x4 bf4lo(u32x4 w) { return (f32x4){bflo(w.x), bfhi(w.x), bflo(w.y), bfhi(w.y)}; }
__device__ __forceinline__ f32x4 bf4hi(u32x4 w) { return (f32x4){bflo(w.z), bfhi(w.z), bflo(w.w), bfhi(w.w)}; }
__device__ __forceinline__ u32x4 pack8(f32x4 a, f32x4 b) { u32x4 w; w.x = cvt_pk_bf16(a[0], a[1]); w.y = cvt_pk_bf16(a[2], a[3]); w.z = cvt_pk_bf16(b[0], b[1]); w.w = cvt_pk_bf16(b[2], b[3]); return w; }
typedef __amdgpu_buffer_rsrc_t rsrc_t;
__device__ __forceinline__ void wt16b(const bf16_t* base, size_t elem, u32x4 v) {
    const rsrc_t r = __builtin_amdgcn_make_buffer_rsrc((void*)base, (short)0, 0x7ffffff0, 0x00020000);
    __builtin_amdgcn_raw_buffer_store_b128(v, r, (unsigned)(elem * 2), 0, 16); }
__device__ __forceinline__ void panel_arrive(unsigned* cnt, int pm) { if (threadIdx.x == 0) __hip_atomic_fetch_add(cnt + 64 * pm, 1u, __ATOMIC_RELAXED, __HIP_MEMORY_SCOPE_AGENT); }
__device__ __forceinline__ void panel_wait(unsigned* cnt, int pm, unsigned need) {
    if (threadIdx.x == 0) { unsigned spins = 0;
        while (__hip_atomic_load(cnt + 64 * pm, __ATOMIC_RELAXED, __HIP_MEMORY_SCOPE_AGENT) < need) { __builtin_amdgcn_s_sleep(2); if (++spins > (1u << 21)) break; }
        __builtin_amdgcn_fence(__ATOMIC_ACQUIRE, "agent"); asm volatile("s_waitcnt vmcnt(0)" ::: "memory"); }
    __syncthreads();
}
__device__ __forceinline__ float sigm(float x) { return __builtin_amdgcn_rcpf(1.f + __expf(-x)); }
__device__ __forceinline__ f32x4 sigm4(f32x4 v) { return (f32x4){sigm(v[0]), sigm(v[1]), sigm(v[2]), sigm(v[3])}; }
__device__ __forceinline__ float gelu_t(float x) { return x * sigm(1.5957691216f * (x + 0.044715f * x * x * x)); }
__device__ __forceinline__ f32x4 gelu4(f32x4 v) { return (f32x4){gelu_t(v[0]), gelu_t(v[1]), gelu_t(v[2]), gelu_t(v[3])}; }

#define XB_TMO      128
#define XB_XCNT(j)  (256  + 64 * (j))
#define XB_XSUB(j)  (1280 + 64 * (j))
#define XB_XGEN(j)  (2304 + 64 * (j))
#define XB_TOP      3328
#define XB_TOPGEN   3392
#define XCD_BAR_WORDS 3456
#define XB_SPIN_CAP (1u << 18)
__device__ __forceinline__ unsigned xb_ld(unsigned* p)              { return __hip_atomic_load(p, __ATOMIC_RELAXED, __HIP_MEMORY_SCOPE_AGENT); }
__device__ __forceinline__ unsigned xb_add(unsigned* p, unsigned v) { return __hip_atomic_fetch_add(p, v, __ATOMIC_RELAXED, __HIP_MEMORY_SCOPE_AGENT); }
__device__ __forceinline__ unsigned xb_xcc_id() { return (unsigned)__builtin_amdgcn_s_getreg((3 << 11) | 20) & 0xFu; }
#define XB_SPIN(cond, bar) do { unsigned _sp = 0; while (cond) { __builtin_amdgcn_s_sleep(1); \
    if ((++_sp & 255u) == 0u) { if (xb_ld(&(bar)[XB_TMO])) break; if (_sp > XB_SPIN_CAP) { atomicAdd(&(bar)[XB_TMO], 1u); break; } } } } while (0)

struct XcdBarrier {
    unsigned* bar; unsigned x;
    volatile LAS unsigned* st;
};

__device__ __forceinline__ XcdBarrier xcd_barrier_post(unsigned* bar, volatile LAS unsigned* st) {
    XcdBarrier b; b.bar = bar; b.x = xb_xcc_id(); b.st = st;
    if (threadIdx.x == 0) (void)xb_add(&bar[XB_XCNT(b.x)], 1u);
    return b;
}
__device__ __forceinline__ void xcd_barrier_complete(unsigned* bar, unsigned x, unsigned& nloc, unsigned& nx) {
    const unsigned G = gridDim.x * gridDim.y * gridDim.z;
    unsigned sum, cnt, mine, sp = 0u;
    for (;;) {
        sum = 0u; cnt = 0u; mine = 0u;
#pragma unroll
        for (unsigned j = 0; j < 16; ++j) { const unsigned c = xb_ld(&bar[XB_XCNT(j)]); sum += c; cnt += (c > 0u) ? 1u : 0u; mine = (j == x) ? c : mine; }
        if (sum == G) break;
        __builtin_amdgcn_s_sleep(1);
        if ((++sp & 255u) == 0u) { if (xb_ld(&bar[XB_TMO])) break; if (sp > XB_SPIN_CAP) { atomicAdd(&bar[XB_TMO], 1u); break; } }
    }
    nloc = mine > 0u ? mine : 1u; nx = cnt > 0u ? cnt : 1u;
}

__device__ __forceinline__ void xcd_barrier(const XcdBarrier& b) {
    asm volatile("s_waitcnt vmcnt(0)" ::: "memory");
    __syncthreads();
    if (threadIdx.x == 0) {
        unsigned* bar = b.bar;
        __builtin_amdgcn_s_waitcnt(0);
        unsigned nloc = b.st[0], nx = b.st[1];
        if (nloc == 0u) { xcd_barrier_complete(bar, b.x, nloc, nx); b.st[0] = nloc; b.st[1] = nx; }
        const unsigned old = xb_add(&bar[XB_XSUB(b.x)], 1u);
        const unsigned gen = old / nloc;
        if (old + 1u == (gen + 1u) * nloc) {
            __builtin_amdgcn_fence(__ATOMIC_RELEASE, "agent");
            asm volatile("s_waitcnt vmcnt(0)" ::: "memory");
            const unsigned og = xb_add(&bar[XB_TOP], 1u);
            const unsigned tg = og / nx;
            if (og + 1u == (tg + 1u) * nx) xb_add(&bar[XB_TOPGEN], 1u);
            else XB_SPIN(xb_ld(&bar[XB_TOPGEN]) == tg, bar);
            __builtin_amdgcn_fence(__ATOMIC_ACQUIRE, "agent");
            xb_add(&bar[XB_XGEN(b.x)], 1u);
            asm volatile("s_waitcnt vmcnt(0)" ::: "memory");
        } else {
            XB_SPIN(xb_ld(&bar[XB_XGEN(b.x)]) == gen, bar);
            __builtin_amdgcn_fence(__ATOMIC_ACQUIRE, "agent");
            asm volatile("s_waitcnt vmcnt(0)" ::: "memory");
        }
    }
    __syncthreads();
}

namespace pg8 {
constexpr int BM = 256, BK = 64, HALF = 128, HTB = HALF * BK * 2, STAGE_BYTES = 8 * HTB, NXCD = 8, WGM = 8;
__device__ __forceinline__ int lds_byte(int r, int c) { const int st = (r >> 4) * 2 + (c >> 5), rr = r & 15, cc = c & 31, ob = rr * 64 + cc * 2; return st * 1024 + (ob ^ (((ob >> 9) & 1) << 5)); }
__device__ __forceinline__ void stage_rc(int b, int& R, int& C) { const int st = b / 1024, sb = b % 1024, swz = sb ^ (((sb >> 9) & 1) << 5); R = (st >> 1) * 16 + swz / 64; C = (st & 1) * 32 + (swz % 64) / 2; }
__device__ __forceinline__ int perm32(int rho) { const int n = rho >> 4, i = rho & 15; return 8 * (i >> 2) + 4 * n + (i & 3); }
struct Unit { int pm, pn; };
struct Gemm { const bf16_t* A; const bf16_t* Bt; int lda, ldb, K; };

struct StaticOrder {
    int nM, nN, nwg, G, c;
    __device__ void init(int M, int N, int G_, int c_) { nM = M / BM; nN = N / BM; nwg = nM * nN; G = G_; c = c_; }
    __device__ bool next(int i, Unit& u) const {
        const long Lx = (long)i * G + c; if (c < 0 || Lx >= nwg) return false;
        int wgid = (int)Lx; { const int q = nwg / NXCD, r = nwg % NXCD, xcd = wgid % NXCD, off = wgid / NXCD; wgid = (xcd < r ? xcd * (q + 1) : r * (q + 1) + (xcd - r) * q) + off; }
        const int nig = WGM * nN, gid = wgid / nig, fm = gid * WGM, gsz = (nM - fm) < WGM ? (nM - fm) : WGM;
        u.pm = fm + ((wgid % nig) % gsz); u.pn = (wgid % nig) / gsz; return true;
    }
};
struct BatchOrder {
    int nunits, G, c, mode;
    __device__ bool next(int i, Unit& u) const {
        const int Lx = i * G + c; if (c < 0 || Lx >= nunits) return false;
        const int xcd = Lx & 7, slot = Lx >> 3;
        if (mode == 1) { const int g = xcd * 4 + (slot >> 1); u.pm = 2 * g + (slot & 1); u.pn = g; }
        else { const int g = xcd * 4 + (slot >> 2); u.pm = 2 * g + ((slot >> 1) & 1); u.pn = 2 * g + (slot & 1); }
        return true;
    }
};

typedef f32x4 AccT[2][2][4][2];
template <bool INIT, class Epi, class Sched>
__device__ __forceinline__ void gemm_phase_acc(LAS unsigned char* lds, const Gemm g, const Sched& S, const Epi& E, AccT& acc) {
    const int tid = threadIdx.x, wid = __builtin_amdgcn_readfirstlane(tid >> 6), lane = tid & 63, wr = wid >> 2, wc = wid & 3, fr = lane & 15, fq = lane >> 4;
    const int K = g.K, nt = K / BK;
    unsigned voffA[2], voffB[2];
#pragma unroll
    for (int i = 0; i < 2; ++i) { int R, C; stage_rc(tid * 16 + i * 8192, R, C); const int Rb = Epi::PERM ? ((R & ~31) + perm32(R & 31)) : R;
        voffA[i] = (unsigned)(R * g.lda + C) * 2u; voffB[i] = (unsigned)(Rb * g.ldb + C) * 2u; }
    const size_t kstep = (size_t)(BK * 2);
    const size_t hstepA = (size_t)HALF * g.lda * 2, hstepB = (size_t)HALF * g.ldb * 2;
    const size_t tstepA = 2 * hstepA, tstepB = 2 * hstepB;
    const unsigned ldsw = (unsigned)wid * 1024u;
    const int aoff = lds_byte(wr * 64 + fr, fq * 8), boff = lds_byte(wc * 32 + fr, fq * 8);
#define PG8_SA(b, h) (((b) * 2 + (h)) * HTB)
#define PG8_SB(b, h) ((4 + (b) * 2 + (h)) * HTB)
#define PG8_STAGE(bufoff, gbase, voff) do { _Pragma("unroll") for (int _i = 0; _i < 2; ++_i) \
        __builtin_amdgcn_global_load_lds((const unsigned*)((const char*)(gbase) + (voff)[_i]), (LAS unsigned*)(lds + (bufoff) + ldsw + _i * 8192), 16, 0, 0); } while (0)
#define PG8_LDA(dst, b, h) do { _Pragma("unroll") for (int m = 0; m < 4; ++m) _Pragma("unroll") for (int k = 0; k < 2; ++k) dst[m][k] = *(const LAS bf16x8*)(lds + PG8_SA(b, h) + aoff + m * 2048 + k * 1024); } while (0)
#define PG8_LDB(dst, b, h) do { _Pragma("unroll") for (int n = 0; n < 2; ++n) _Pragma("unroll") for (int k = 0; k < 2; ++k) dst[n][k] = *(const LAS bf16x8*)(lds + PG8_SB(b, h) + boff + n * 2048 + k * 1024); } while (0)
#define PG8_MMA(ai, bj, At, Bt) do { __builtin_amdgcn_s_setprio(1); _Pragma("unroll") for (int m = 0; m < 4; ++m) _Pragma("unroll") for (int n = 0; n < 2; ++n) _Pragma("unroll") for (int k = 0; k < 2; ++k) \
        acc[ai][bj][m][n] = __builtin_amdgcn_mfma_f32_16x16x32_bf16(Bt[n][k], At[m][k], acc[ai][bj][m][n], 0, 0, 0); __builtin_amdgcn_s_setprio(0); } while (0)
#define PG8_WAIT_V(n) asm volatile("s_waitcnt vmcnt(" #n ")" ::: "memory")
#define PG8_WAIT_L(n) asm volatile("s_waitcnt lgkmcnt(" #n ")" ::: "memory")
#define PG8_BAR __builtin_amdgcn_s_barrier()
#define PG8_SCHED __builtin_amdgcn_sched_barrier(0)
    Unit cur, nxt; int ui = 0;
    if (!S.next(0, cur)) return;
    if (INIT) {
#pragma unroll
    for (int a = 0; a < 2; ++a)
#pragma unroll
        for (int b = 0; b < 2; ++b)
#pragma unroll
            for (int m = 0; m < 4; ++m)
#pragma unroll
                for (int n = 0; n < 2; ++n) acc[a][b][m][n] = (f32x4){0.f, 0.f, 0.f, 0.f};
    }
    bf16x8 At[4][2], B0[2][2], B1[2][2];
    const char* cA = (const char*)g.A + (size_t)cur.pm * tstepA; const char* cB = (const char*)g.Bt + (size_t)cur.pn * tstepB;
    PG8_STAGE(PG8_SB(0, 0), cB, voffB); PG8_STAGE(PG8_SB(0, 1), cB + hstepB, voffB); PG8_STAGE(PG8_SA(0, 0), cA, voffA); PG8_STAGE(PG8_SA(0, 1), cA + hstepA, voffA);
    if (wr == 1) PG8_BAR;
    PG8_WAIT_V(2); PG8_BAR;
    PG8_STAGE(PG8_SB(1, 0), cB + kstep, voffB); PG8_STAGE(PG8_SA(1, 0), cA + kstep, voffA); PG8_STAGE(PG8_SB(1, 1), cB + hstepB + kstep, voffB);
    PG8_WAIT_V(6); PG8_BAR;
    for (;;) {
        const bool has_next = S.next(ui + 1, nxt);
        const char* nA = has_next ? (const char*)g.A + (size_t)nxt.pm * tstepA : cA; const char* nB = has_next ? (const char*)g.Bt + (size_t)nxt.pn * tstepB : cB;
#pragma unroll 1
        for (int t = 0; t < nt; t += 2) {
            const bool last = (t == nt - 2);
            const char* a1 = cA + (size_t)(t + 1) * kstep;
            const char* a2 = last ? nA : cA + (size_t)(t + 2) * kstep; const char* b2 = last ? nB : cB + (size_t)(t + 2) * kstep;
            const char* a3 = a2 + kstep; const char* b3 = b2 + kstep;
            PG8_LDB(B0, 0, 0); PG8_LDB(B1, 0, 1); PG8_SCHED; PG8_LDA(At, 0, 0); PG8_STAGE(PG8_SA(1, 1), a1 + hstepA, voffA);
            PG8_WAIT_V(8); PG8_WAIT_L(0); PG8_BAR; PG8_MMA(0, 0, At, B0); PG8_MMA(0, 1, At, B1); PG8_BAR; PG8_SCHED;
            PG8_LDA(At, 0, 1); PG8_STAGE(PG8_SB(0, 0), b2, voffB); PG8_STAGE(PG8_SB(0, 1), b2 + hstepB, voffB); PG8_STAGE(PG8_SA(0, 0), a2, voffA);
            PG8_WAIT_V(8); PG8_WAIT_L(0); PG8_BAR; PG8_MMA(1, 0, At, B0); PG8_MMA(1, 1, At, B1); PG8_BAR; PG8_SCHED;
            PG8_LDB(B0, 1, 0); PG8_LDB(B1, 1, 1); PG8_SCHED; PG8_LDA(At, 1, 0); PG8_STAGE(PG8_SA(0, 1), a2 + hstepA, voffA);
            PG8_WAIT_V(8); PG8_WAIT_L(0); PG8_BAR; PG8_MMA(0, 0, At, B0); PG8_MMA(0, 1, At, B1); PG8_BAR; PG8_SCHED;
            PG8_LDA(At, 1, 1); PG8_STAGE(PG8_SB(1, 0), b3, voffB); PG8_STAGE(PG8_SB(1, 1), b3 + hstepB, voffB); PG8_STAGE(PG8_SA(1, 0), a3, voffA);
            PG8_WAIT_V(8); PG8_WAIT_L(0); PG8_BAR; PG8_MMA(1, 0, At, B0); PG8_MMA(1, 1, At, B1); PG8_BAR; PG8_SCHED;
        }
        if (wr == 0) PG8_BAR;
        if constexpr (!Epi::AFTER_DRAIN) E(acc, cur, wr, wc, fr, fq);
        if (!has_next) break;
#pragma unroll
        for (int a = 0; a < 2; ++a)
#pragma unroll
            for (int b = 0; b < 2; ++b)
#pragma unroll
                for (int m = 0; m < 4; ++m)
#pragma unroll
                    for (int n = 0; n < 2; ++n) acc[a][b][m][n] = (f32x4){0.f, 0.f, 0.f, 0.f};
        cur = nxt; cA = nA; cB = nB; ++ui;
        if (wr == 1) PG8_BAR;
    }
    PG8_WAIT_V(0);
    PG8_BAR;
    if constexpr (Epi::AFTER_DRAIN) E(acc, cur, wr, wc, fr, fq);
#undef PG8_SA
#undef PG8_SB
#undef PG8_STAGE
#undef PG8_LDA
#undef PG8_LDB
#undef PG8_MMA
#undef PG8_WAIT_V
#undef PG8_WAIT_L
#undef PG8_BAR
#undef PG8_SCHED
}
template <class Epi, class Sched>
__device__ __forceinline__ void gemm_phase(LAS unsigned char* lds, const Gemm g, const Sched& S, const Epi& E) { AccT acc; gemm_phase_acc<true>(lds, g, S, E, acc); }
}
using pg8::Unit;
typedef f32x4 Acc[2][2][4][2];

#define EPI_ROWS(...) _Pragma("unroll") for (int ai = 0; ai < 2; ++ai) _Pragma("unroll") for (int m = 0; m < 4; ++m) { const int row = row0 + ai * 128 + m * 16; __VA_ARGS__ }

struct EpiG1 {
    static constexpr bool PERM = true, AFTER_DRAIN = false;
    bf16_t *U, *SG, *V, *W, *SR, *SC;
    __device__ __forceinline__ void operator()(const Acc& acc, const Unit& u, int wr, int wc, int fr, int fq) const {
        const int row0 = u.pm * 256 + wr * 64 + fr, cw = wc * 32 + 8 * fq, pn = u.pn;
        if (pn < 2) {
            EPI_ROWS(
                const int c = row >> 5, tt = row & 31;
                _Pragma("unroll") for (int bj = 0; bj < 2; ++bj) { const int col = pn * 256 + bj * 128 + cw; const int g = col >> 4, h0 = col & 15;
                    *(u32x4*)(U + ((size_t)(g * NCH_ + c)) * LDU_ + tt * 16 + h0) = pack8(acc[ai][bj][m][0], acc[ai][bj][m][1]); } )
        } else if (pn < 4) {
            EPI_ROWS(
                _Pragma("unroll") for (int bj = 0; bj < 2; ++bj) { const int col = (pn - 2) * 256 + bj * 128 + cw; const f32x4 a = acc[ai][bj][m][0], b = acc[ai][bj][m][1];
                    *(u32x4*)(SG + (size_t)row * SW_ + col) = pack8(a * sigm4(a), b * sigm4(b)); } )
        } else if (pn < 12) {
            EPI_ROWS(
                const int col = (pn - 4) * 128 + cw;
                *(u32x4*)(V + (size_t)row * CWID_ + col) = pack8(acc[ai][0][m][0] * acc[ai][1][m][0], acc[ai][0][m][1] * acc[ai][1][m][1]); )
        } else if (pn < 20) {
            EPI_ROWS(
                const int col = (pn - 12) * 128 + cw; const f32x4 ga = acc[ai][1][m][0], gb = acc[ai][1][m][1];
                *(u32x4*)(W + (size_t)row * CWID_ + col) = pack8(acc[ai][0][m][0] * (ga * sigm4(ga)), acc[ai][0][m][1] * (gb * sigm4(gb))); )
        } else {
            bf16_t* dst = pn < 24 ? SR : SC; const int pb = pn < 24 ? pn - 20 : pn - 24;
            EPI_ROWS(
                _Pragma("unroll") for (int bj = 0; bj < 2; ++bj) { const int col = pb * 256 + bj * 128 + cw;
                    *(u32x4*)(dst + (size_t)row * D_ + col) = pack8(acc[ai][bj][m][0], acc[ai][bj][m][1]); } )
        }
    }
};
__device__ void carry_group(const Params& P, int g, unsigned char* smem);
struct EpiS1 {
    static constexpr bool PERM = false, AFTER_DRAIN = true;
    float* SLOC; unsigned* gcnt; const Params* P; unsigned char* smem;
    __device__ __forceinline__ void operator()(const Acc& acc, const Unit& u, int wr, int wc, int fr, int fq) const {
        const int row0 = u.pm * 256 + wr * 64 + fr;
        EPI_ROWS(
const size_t ro = ((size_t)row * 128 + wc * 32 + 4 * fq) * 2; wt16b((const bf16_t*)SLOC, ro, __builtin_bit_cast(u32x4, acc[ai][0][m][0])); wt16b((const bf16_t*)SLOC, ro + 32, __builtin_bit_cast(u32x4, acc[ai][0][m][1])); )
        asm volatile("s_waitcnt vmcnt(0)" ::: "memory");
        __syncthreads();
        unsigned* flag = (unsigned*)smem;
        if (threadIdx.x == 0) {
            const unsigned old = __hip_atomic_fetch_add(gcnt + 64 * u.pn, 1u, __ATOMIC_RELAXED, __HIP_MEMORY_SCOPE_AGENT);
            if (old == 1u) { __builtin_amdgcn_fence(__ATOMIC_ACQUIRE, "agent"); asm volatile("s_waitcnt vmcnt(0)" ::: "memory"); }
            flag[0] = old;
        }
        __syncthreads();
        const unsigned old = flag[0];
        __syncthreads();
        if (old == 1u) carry_group(*P, u.pn, smem);
    }
};
struct EpiS2 {
    static constexpr bool PERM = true, AFTER_DRAIN = false;
    bf16_t* YG;
    __device__ __forceinline__ void operator()(const Acc& acc, const Unit& u, int wr, int wc, int fr, int fq) const {
        const int g = u.pm >> 1, c0 = (u.pm & 1) * 256 + wr * 64 + fr, n0 = (u.pn & 1) * 256 + wc * 32 + 8 * fq;
#pragma unroll
        for (int ai = 0; ai < 2; ++ai)
#pragma unroll
            for (int m = 0; m < 4; ++m) { const int c = c0 + ai * 128 + m * 16;
#pragma unroll
                for (int bj = 0; bj < 2; ++bj) { const int n = n0 + bj * 128, t = n >> 4, h0 = n & 15;
                    *(u32x4*)(YG + (size_t)(c * T_ + t) * SW_ + g * 16 + h0) = pack8(gelu4(acc[ai][bj][m][0]), gelu4(acc[ai][bj][m][1])); } }
    }
};
struct EpiStore {
    static constexpr bool PERM = true, AFTER_DRAIN = false;
    bf16_t* O; int ldc;
    __device__ __forceinline__ void operator()(const Acc& acc, const Unit& u, int wr, int wc, int fr, int fq) const {
        const int row0 = u.pm * 256 + wr * 64 + fr, col0 = u.pn * 256 + wc * 32 + 8 * fq;
        EPI_ROWS(
            _Pragma("unroll") for (int bj = 0; bj < 2; ++bj) *(u32x4*)(O + (size_t)row * ldc + col0 + bj * 128) = pack8(acc[ai][bj][m][0], acc[ai][bj][m][1]); )
    }
};
struct EpiGlu {
    static constexpr bool PERM = true, AFTER_DRAIN = false;
    const bf16_t *YG, *SG; const float* bglu; bf16_t* Y3;
    __device__ __forceinline__ void operator()(const Acc& acc, const Unit& u, int wr, int wc, int fr, int fq) const {
        const int row0 = u.pm * 256 + wr * 64 + fr, col0 = u.pn * 256 + wc * 32 + 8 * fq;
        f32x4 b0[2], b1[2];
#pragma unroll
        for (int bj = 0; bj < 2; ++bj) { b0[bj] = *(const f32x4*)(bglu + col0 + bj * 128); b1[bj] = *(const f32x4*)(bglu + col0 + bj * 128 + 4); }
#pragma unroll
        for (int ai = 0; ai < 2; ++ai) {
            u32x4 yw[4][2], sw[4][2];
#pragma unroll
            for (int m = 0; m < 4; ++m)
#pragma unroll
                for (int bj = 0; bj < 2; ++bj) { const size_t off = (size_t)(row0 + ai * 128 + m * 16) * SW_ + col0 + bj * 128; yw[m][bj] = *(const u32x4*)(YG + off); sw[m][bj] = *(const u32x4*)(SG + off); }
#pragma unroll
            for (int m = 0; m < 4; ++m)
#pragma unroll
                for (int bj = 0; bj < 2; ++bj) { const size_t off = (size_t)(row0 + ai * 128 + m * 16) * SW_ + col0 + bj * 128;
                    wt16b(Y3, off, pack8(bf4lo(yw[m][bj]) * sigm4(acc[ai][bj][m][0] + b0[bj]) * bf4lo(sw[m][bj]), bf4hi(yw[m][bj]) * sigm4(acc[ai][bj][m][1] + b1[bj]) * bf4hi(sw[m][bj]))); }
        }
    }
};
template <int MODE> struct EpiMerge {
    static constexpr bool PERM = true, AFTER_DRAIN = false;
    const bf16_t *S, *TMPI; bf16_t* O;
    __device__ __forceinline__ void operator()(const Acc& acc, const Unit& u, int wr, int wc, int fr, int fq) const {
        const int row0 = u.pm * 256 + wr * 64 + fr, col0 = u.pn * 256 + wc * 32 + 8 * fq;
#pragma unroll
        for (int ai = 0; ai < 2; ++ai) {
            u32x4 sw[4][2], tw[4][2];
#pragma unroll
            for (int m = 0; m < 4; ++m)
#pragma unroll
                for (int bj = 0; bj < 2; ++bj) { const size_t off = (size_t)(row0 + ai * 128 + m * 16) * D_ + col0 + bj * 128; sw[m][bj] = *(const u32x4*)(S + off); if (MODE == 1) tw[m][bj] = *(const u32x4*)(TMPI + off); }
#pragma unroll
            for (int m = 0; m < 4; ++m)
#pragma unroll
                for (int bj = 0; bj < 2; ++bj) { const size_t off = (size_t)(row0 + ai * 128 + m * 16) * D_ + col0 + bj * 128;
                    f32x4 a = sigm4(bf4lo(sw[m][bj])) * acc[ai][bj][m][0], b = sigm4(bf4hi(sw[m][bj])) * acc[ai][bj][m][1];
                    if (MODE == 1) { a += bf4lo(tw[m][bj]); b += bf4hi(tw[m][bj]); }
                    if (MODE == 1) wt16b(O, off, pack8(a, b)); else *(u32x4*)(O + off) = pack8(a, b); }
        }
    }
};
struct EpiMergeMid {
    static constexpr bool PERM = true, AFTER_DRAIN = false;
    const bf16_t *SR, *SC;
    __device__ __forceinline__ void operator()(Acc& acc, const Unit& u, int wr, int wc, int fr, int fq) const {
        const int row0 = u.pm * 256 + wr * 64 + fr, col0 = u.pn * 256 + wc * 32 + 8 * fq;
#pragma unroll
        for (int ai = 0; ai < 2; ++ai) {
            u32x4 rw[4][2], cw[4][2];
#pragma unroll
            for (int m = 0; m < 4; ++m)
#pragma unroll
                for (int bj = 0; bj < 2; ++bj) { const size_t off = (size_t)(row0 + ai * 128 + m * 16) * D_ + col0 + bj * 128; rw[m][bj] = *(const u32x4*)(SR + off); cw[m][bj] = *(const u32x4*)(SC + off); }
#pragma unroll
            for (int m = 0; m < 4; ++m)
#pragma unroll
                for (int bj = 0; bj < 2; ++bj) { const f32x4 ca = sigm4(bf4lo(cw[m][bj])), cb = sigm4(bf4hi(cw[m][bj])), ra = sigm4(bf4lo(rw[m][bj])), rb = sigm4(bf4hi(rw[m][bj]));
#pragma unroll
                    for (int j = 0; j < 4; ++j) { acc[ai][bj][m][0][j] *= ca[j] * __builtin_amdgcn_rcpf(fmaxf(ra[j], 1e-30f)); acc[ai][bj][m][1][j] *= cb[j] * __builtin_amdgcn_rcpf(fmaxf(rb[j], 1e-30f)); } }
        }
    }
};
struct EpiMergeFin {
    static constexpr bool PERM = true, AFTER_DRAIN = false;
    const bf16_t* SR; bf16_t* O;
    __device__ __forceinline__ void operator()(Acc& acc, const Unit& u, int wr, int wc, int fr, int fq) const {
        const int row0 = u.pm * 256 + wr * 64 + fr, col0 = u.pn * 256 + wc * 32 + 8 * fq;
        u32x4 rw[2][4][2];
#pragma unroll
        for (int ai = 0; ai < 2; ++ai)
#pragma unroll
            for (int m = 0; m < 4; ++m)
#pragma unroll
                for (int bj = 0; bj < 2; ++bj) rw[ai][m][bj] = *(const u32x4*)(SR + (size_t)(row0 + ai * 128 + m * 16) * D_ + col0 + bj * 128);
#pragma unroll
        for (int ai = 0; ai < 2; ++ai)
#pragma unroll
            for (int m = 0; m < 4; ++m)
#pragma unroll
                for (int bj = 0; bj < 2; ++bj) { const f32x4 ra = sigm4(bf4lo(rw[ai][m][bj])), rb = sigm4(bf4hi(rw[ai][m][bj])); f32x4 a = acc[ai][bj][m][0], b = acc[ai][bj][m][1];
#pragma unroll
                    for (int j = 0; j < 4; ++j) { a[j] *= fmaxf(ra[j], 1e-30f); b[j] *= fmaxf(rb[j], 1e-30f); }
                    wt16b(O, (size_t)(row0 + ai * 128 + m * 16) * D_ + col0 + bj * 128, pack8(a, b)); }
    }
};
struct PanelX { float* part; unsigned* cnt; };
__device__ __forceinline__ void panel_rstd(const PanelX& px, const Unit& u, int wr, int wc, int fr, int fq, float (&s)[2][4]) {
    const int row0 = u.pm * 256 + wr * 64 + fr;
    const rsrc_t pr = __builtin_amdgcn_make_buffer_rsrc((void*)px.part, (short)0, L_ * 16 * 4, 0x00020000);
#pragma unroll
    for (int ai = 0; ai < 2; ++ai)
#pragma unroll
        for (int m = 0; m < 4; ++m) { float t = s[ai][m]; t += __shfl_xor(t, 16); t += __shfl_xor(t, 32);
            if (fq == 0) __builtin_amdgcn_raw_buffer_store_b32(__float_as_uint(t), pr, (unsigned)(((row0 + ai * 128 + m * 16) * 16 + u.pn * 4 + wc) * 4), 0, 16); }
    u32x4 q[2][4];
    for (unsigned spins = 0;; ++spins) {
        bool ok = true;
#pragma unroll
        for (int ai = 0; ai < 2; ++ai)
#pragma unroll
            for (int m = 0; m < 4; ++m) { q[ai][m] = __builtin_amdgcn_raw_buffer_load_b128(pr, (unsigned)(((row0 + ai * 128 + m * 16) * 16 + fq * 4) * 4), 0, 16);
                ok = ok && (q[ai][m].x != 0xFFFFFFFFu) && (q[ai][m].y != 0xFFFFFFFFu) && (q[ai][m].z != 0xFFFFFFFFu) && (q[ai][m].w != 0xFFFFFFFFu); }
        if (__all(ok) || spins > (1u << 18)) break;
        __builtin_amdgcn_s_sleep(2);
    }
#pragma unroll
    for (int ai = 0; ai < 2; ++ai)
#pragma unroll
        for (int m = 0; m < 4; ++m) { float t = (__uint_as_float(q[ai][m].x) + __uint_as_float(q[ai][m].y)) + (__uint_as_float(q[ai][m].z) + __uint_as_float(q[ai][m].w)); t += __shfl_xor(t, 16); t += __shfl_xor(t, 32);
            s[ai][m] = rsqrtf(t * (1.0f / D_) + EPS_); }
}
__device__ __forceinline__ float sq8(f32x4 a, f32x4 b) { return ((a[0] * a[0] + a[1] * a[1]) + (a[2] * a[2] + a[3] * a[3])) + ((b[0] * b[0] + b[1] * b[1]) + (b[2] * b[2] + b[3] * b[3])); }
struct EpiX1 {
    static constexpr bool PERM = true, AFTER_DRAIN = true;
    const float *x, *gain; bf16_t* X1B; PanelX px;
    __device__ __forceinline__ void operator()(Acc& acc, const Unit& u, int wr, int wc, int fr, int fq) const {
        const int row0 = u.pm * 256 + wr * 64 + fr, col0 = u.pn * 256 + wc * 32 + 8 * fq;
        float s[2][4];
#pragma unroll
        for (int ai = 0; ai < 2; ++ai)
#pragma unroll
            for (int m = 0; m < 4; ++m) s[ai][m] = sq8(acc[ai][0][m][0], acc[ai][0][m][1]) + sq8(acc[ai][1][m][0], acc[ai][1][m][1]);
        panel_rstd(px, u, wr, wc, fr, fq, s);
        f32x4 g0[2], g1[2];
#pragma unroll
        for (int bj = 0; bj < 2; ++bj) { g0[bj] = *(const f32x4*)(gain + col0 + bj * 128); g1[bj] = *(const f32x4*)(gain + col0 + bj * 128 + 4); }
#pragma unroll
        for (int ai = 0; ai < 2; ++ai) {
            f32x4 xa[4][2], xb[4][2];
#pragma unroll
            for (int m = 0; m < 4; ++m)
#pragma unroll
                for (int bj = 0; bj < 2; ++bj) { const size_t off = (size_t)(row0 + ai * 128 + m * 16) * D_ + col0 + bj * 128; xa[m][bj] = *(const f32x4*)(x + off); xb[m][bj] = *(const f32x4*)(x + off + 4); }
#pragma unroll
            for (int m = 0; m < 4; ++m) { const float rs = s[ai][m];
#pragma unroll
                for (int bj = 0; bj < 2; ++bj) { const size_t off = (size_t)(row0 + ai * 128 + m * 16) * D_ + col0 + bj * 128;
                    const f32x4 ya = xa[m][bj] + acc[ai][bj][m][0] * rs * g0[bj], yb = xb[m][bj] + acc[ai][bj][m][1] * rs * g1[bj];
                    wt16b(X1B, off, pack8(ya, yb)); } }
        }
    }
};
struct EpiOut {
    static constexpr bool PERM = true, AFTER_DRAIN = true;
    const bf16_t *PE, *X1B; const float* gain; float* OUT; PanelX px;
    __device__ __forceinline__ void operator()(Acc& acc, const Unit& u, int wr, int wc, int fr, int fq) const {
        const int row0 = u.pm * 256 + wr * 64 + fr, col0 = u.pn * 256 + wc * 32 + 8 * fq;
        float s[2][4];
#pragma unroll
        for (int ai = 0; ai < 2; ++ai) {
            u32x4 pw[4][2];
#pragma unroll
            for (int m = 0; m < 4; ++m)
#pragma unroll
                for (int bj = 0; bj < 2; ++bj) pw[m][bj] = *(const u32x4*)(PE + (size_t)(row0 + ai * 128 + m * 16) * D_ + col0 + bj * 128);
#pragma unroll
            for (int m = 0; m < 4; ++m) { float t = 0.f;
#pragma unroll
                for (int bj = 0; bj < 2; ++bj) { acc[ai][bj][m][0] = bf4lo(pw[m][bj]) * sigm4(acc[ai][bj][m][0]); acc[ai][bj][m][1] = bf4hi(pw[m][bj]) * sigm4(acc[ai][bj][m][1]);
                    t += sq8(acc[ai][bj][m][0], acc[ai][bj][m][1]); }
                s[ai][m] = t; }
        }
        panel_rstd(px, u, wr, wc, fr, fq, s);
        f32x4 g0[2], g1[2];
#pragma unroll
        for (int bj = 0; bj < 2; ++bj) { g0[bj] = *(const f32x4*)(gain + col0 + bj * 128); g1[bj] = *(const f32x4*)(gain + col0 + bj * 128 + 4); }
#pragma unroll
        for (int ai = 0; ai < 2; ++ai) {
            u32x4 xw[4][2];
#pragma unroll
            for (int m = 0; m < 4; ++m)
#pragma unroll
                for (int bj = 0; bj < 2; ++bj) xw[m][bj] = *(const u32x4*)(X1B + (size_t)(row0 + ai * 128 + m * 16) * D_ + col0 + bj * 128);
#pragma unroll
            for (int m = 0; m < 4; ++m) { const float rs = s[ai][m];
#pragma unroll
                for (int bj = 0; bj < 2; ++bj) { const size_t off = (size_t)(row0 + ai * 128 + m * 16) * D_ + col0 + bj * 128;
                    *(f32x4*)(OUT + off) = bf4lo(xw[m][bj]) + acc[ai][bj][m][0] * rs * g0[bj]; *(f32x4*)(OUT + off + 4) = bf4hi(xw[m][bj]) + acc[ai][bj][m][1] * rs * g1[bj]; } }
        }
    }
};

__device__ __forceinline__ void tconv_tile(const float* __restrict__ src, int lds_, int sc0, int k0, bf16_t* __restrict__ dst, int ldd, int n0, float* tile  ) {
    const int tid = threadIdx.x;
    { const int nn = tid & 63, kb = tid >> 6; const float* pp = src + (size_t)(k0 + kb) * lds_ + sc0 + nn; const size_t step = (size_t)8 * lds_;
#pragma unroll 1
      for (int hb = 0; hb < 2; ++hb) { float v[16];
#pragma unroll
        for (int i = 0; i < 16; ++i) { v[i] = *pp; pp += step; }
#pragma unroll
        for (int i = 0; i < 16; ++i) tile[(kb + 8 * (hb * 16 + i)) * 65 + nn] = v[i]; } }
    __syncthreads();
#pragma unroll
    for (int i = 0; i < 4; ++i) { const int pidx = tid + 512 * i, kk2 = (pidx & 31) * 8, nn2 = pidx >> 5;
      f32x4 a, b;
#pragma unroll
      for (int j = 0; j < 4; ++j) { a[j] = tile[(kk2 + j) * 65 + nn2]; b[j] = tile[(kk2 + 4 + j) * 65 + nn2]; }
      *(u32x4*)(dst + (size_t)(n0 + nn2) * ldd + k0 + kk2) = pack8(a, b); }
    __syncthreads();
}
__device__ __forceinline__ int win_srccol(int n0) {
    const int pn = n0 >> 8, j = n0 & 255;
    if (pn < 2) return 256 * pn + j;
    if (pn < 4) return 512 + 256 * (pn - 2) + j;
    if (pn < 12) { const int i = pn - 4; return j < 128 ? 1024 + 128 * i + j : 3072 + 128 * i + (j - 128); }
    if (pn < 20) { const int i = pn - 12; return j < 128 ? 2048 + 128 * i + j : 4096 + 128 * i + (j - 128); }
    if (pn < 24) return 5120 + 256 * (pn - 20) + j;
    return 6144 + 256 * (pn - 24) + j;
}
__device__ void ssm_prep(const Params& P, int g, int r, unsigned char* smem) {
    float2* s_ab = (float2*)smem;
    float2* s_Bb = s_ab + 64;
    float2* s_C = s_Bb + 1024;
    float2* s_pw = s_C + 1024;
    float* s_Kd = (float*)(s_pw + 64 * 33);
    const int tid = threadIdx.x;
    bf16_t* MC = (bf16_t*)(P.ws + WS_MC); bf16_t* WST = (bf16_t*)(P.ws + WS_WST); float2* abT = (float2*)(P.ws + WS_ABT);
    if (tid < 64) {
        const int p = tid; const float dt = expf(P.log_step[g]); const float ar = P.a_re[g * 64 + p], ai = P.a_im[g * 64 + p];
        const float mag = expf(ar * dt), th = ai * dt; const float abr = mag * cosf(th), abi = mag * sinf(th);
        const float den = ar * ar + ai * ai, nr = abr - 1.0f; const float fr = (nr * ar + abi * ai) / den, fi = (abi * ar - nr * ai) / den;
        s_ab[p] = make_float2(abr, abi);
#pragma unroll 1
        for (int h = 0; h < 16; ++h) { const float br = P.b_re[(g * 64 + p) * 16 + h], bi = P.b_im[(g * 64 + p) * 16 + h]; s_Bb[p * 16 + h] = make_float2(fr * br - fi * bi, fr * bi + fi * br); }
        float cr = 1.f, ci = 0.f;
#pragma unroll 1
        for (int d = 0; d <= T_; ++d) { s_pw[p * 33 + d] = make_float2(cr, ci); const float nr2 = cr * abr - ci * abi, ni2 = cr * abi + ci * abr; cr = nr2; ci = ni2; }
        if (r == 0) abT[g * 64 + p] = s_pw[p * 33 + T_];
    }
    for (int i = tid; i < 1024; i += 512) { const int h = i >> 6, p = i & 63; s_C[i] = make_float2(P.c_re[(g * 16 + h) * 64 + p], P.c_im[(g * 16 + h) * 64 + p]); }
    __syncthreads();
#pragma unroll 1
    for (int i = 0; i < 4; ++i) { const int idx = tid + 512 * i, d = idx >> 6, hh = (idx >> 4) & 3, hp = idx & 15, h = 4 * r + hh; float a = 0.f;
#pragma unroll 4
        for (int p = 0; p < 64; ++p) { const float2 c = s_C[h * 64 + p], w = s_pw[p * 33 + d], b = s_Bb[p * 16 + hp]; const float xr = c.x * w.x - c.y * w.y, xi = c.x * w.y + c.y * w.x; a += xr * b.x - xi * b.y; }
        if (d == 0 && h == hp) a += P.d_skip[g * 16 + h];
        s_Kd[idx] = a; }
    __syncthreads();
#pragma unroll 1
    for (int i = 0; i < 20; ++i) { const int pidx = tid + 512 * i, rowi = pidx / 80, col8 = (pidx % 80) * 8, t = rowi >> 2, hh = rowi & 3, h = 4 * r + hh;
        f32x4 a = {0.f, 0.f, 0.f, 0.f}, b = {0.f, 0.f, 0.f, 0.f};
        if (col8 < KU_) { const int k = col8 >> 4, h0 = col8 & 15;
            if (k <= t) { const float* kd = s_Kd + (t - k) * 64 + hh * 16 + h0; a = (f32x4){kd[0], kd[1], kd[2], kd[3]}; b = (f32x4){kd[4], kd[5], kd[6], kd[7]}; } }
        else { const int q0 = col8 - KU_, im = q0 >= 64, p0 = q0 & 63;
#pragma unroll
            for (int j = 0; j < 8; ++j) { const float2 c = s_C[h * 64 + p0 + j], w = s_pw[(p0 + j) * 33 + t + 1]; const float v = im ? -(c.x * w.y + c.y * w.x) : (c.x * w.x - c.y * w.y); if (j < 4) a[j] = v; else b[j - 4] = v; } }
        *(u32x4*)(MC + ((size_t)(g * KU_ + t * 16 + h)) * LDU_ + col8) = pack8(a, b); }
#pragma unroll 1
    for (int i = 0; i < 4; ++i) { const int pidx = tid + 512 * i, q = 32 * r + (pidx >> 6), col8 = (pidx & 63) * 8, k = col8 >> 4, h0 = col8 & 15, p = q & 63, im = q >= 64;
        const float2 w = s_pw[p * 33 + (T_ - 1 - k)]; f32x4 a, b;
#pragma unroll
        for (int j = 0; j < 8; ++j) { const float2 bb = s_Bb[p * 16 + h0 + j]; const float v = im ? (w.x * bb.y + w.y * bb.x) : (w.x * bb.x - w.y * bb.y); if (j < 4) a[j] = v; else b[j - 4] = v; }
        *(u32x4*)(WST + ((size_t)(g * 256 + q)) * KU_ + col8) = pack8(a, b); }
    __syncthreads();
}

__device__ __forceinline__ void do_job(const Params& P, unsigned char* smem, int job) {
    const int tid = threadIdx.x;
    unsigned char* ws = P.ws;
    constexpr int J_SSM = 128, J_TC = 704, J_RMS = 512;
    {
        int j = job;
        if (j < J_SSM) { ssm_prep(P, j >> 2, j & 3, smem); return; }
        j -= J_SSM;
        if (j < J_TC) {
            const float* src; bf16_t* dst; int K, N, off; bool perm = false;
            if (j < 448) { src = P.w_in; dst = (bf16_t*)(ws + WS_WIN); K = 1024; N = INW_; perm = true; }
            else if ((off = j - 448) < 16) { j = off; src = P.w_glu; dst = (bf16_t*)(ws + WS_WGLU); K = 512; N = 512; }
            else if ((off = j - 464) < 32) { j = off; src = P.w_ssm_out; dst = (bf16_t*)(ws + WS_WSSO); K = 512; N = 1024; }
            else if ((off = j - 496) < 64) { j = off; src = P.w_conv_out; dst = (bf16_t*)(ws + WS_WCO); K = 1024; N = 1024; }
            else if ((off = j - 560) < 64) { j = off; src = P.w_o; dst = (bf16_t*)(ws + WS_WO); K = 1024; N = 1024; }
            else if ((off = j - 624) < 16) { j = off; src = P.w_ple; dst = (bf16_t*)(ws + WS_WPLE); K = 256; N = 1024; }
            else { j = j - 640; src = P.w_ple_gate; dst = (bf16_t*)(ws + WS_WG); K = 1024; N = 1024; }
            const int nkt = K >> 8, ntile = j / nkt, ktile = j % nkt, n0 = ntile * 64, k0 = ktile * 256;
            const int sc0 = perm ? win_srccol(n0) : n0;
            tconv_tile(src, N, sc0, k0, dst, K, n0, (float*)smem);
            return;
        }
        j -= J_TC;
        if (j < J_RMS) {
            const int lane = tid & 63, rowb = j * 32 + (tid >> 6) * 4;
            f32x4 v[4][4]; float s[4];
#pragma unroll
            for (int rr = 0; rr < 4; ++rr)
#pragma unroll
                for (int i = 0; i < 4; ++i) v[rr][i] = *(const f32x4*)(P.x + (size_t)(rowb + rr) * D_ + i * 256 + lane * 4);
#pragma unroll
            for (int rr = 0; rr < 4; ++rr) { float t = 0.f;
#pragma unroll
                for (int i = 0; i < 4; ++i) t += (v[rr][i][0] * v[rr][i][0] + v[rr][i][1] * v[rr][i][1]) + (v[rr][i][2] * v[rr][i][2] + v[rr][i][3] * v[rr][i][3]);
#pragma unroll
                for (int o = 32; o >= 1; o >>= 1) t += __shfl_xor(t, o);
                s[rr] = rsqrtf(t * (1.0f / D_) + EPS_); }
#pragma unroll
            for (int i = 0; i < 4; ++i) { const f32x4 gn = *(const f32x4*)(P.pre_norm + i * 256 + lane * 4);
#pragma unroll
                for (int rr = 0; rr < 4; ++rr) { const f32x4 y = v[rr][i] * s[rr] * gn; u32x2 w; w.x = cvt_pk_bf16(y[0], y[1]); w.y = cvt_pk_bf16(y[2], y[3]);
                    *(u32x2*)((bf16_t*)P.out + (size_t)(rowb + rr) * D_ + i * 256 + lane * 4) = w; } }
            return;
        }
        j -= J_RMS;
        {
            const size_t e0 = (size_t)j * 8192 + tid * 8;
            const f32x4 a0 = *(const f32x4*)(P.p + e0), b0 = *(const f32x4*)(P.p + e0 + 4), a1 = *(const f32x4*)(P.p + e0 + 4096), b1 = *(const f32x4*)(P.p + e0 + 4100);
            *(u32x4*)((bf16_t*)(ws + WS_PBF) + e0) = pack8(a0, b0); *(u32x4*)((bf16_t*)(ws + WS_PBF) + e0 + 4096) = pack8(a1, b1);
        }
    }
}

__device__ void phase_z(const Params& P, int b0, int nbz) {
    const bf16_t* V = (const bf16_t*)P.out + (size_t)L_ * D_;
    const bf16_t* W = (const bf16_t*)(P.ws + WS_W); bf16_t* Z = (bf16_t*)(P.ws + WS_Z);
    const int nthreads = nbz * 512;
    for (int idx = (blockIdx.x - b0) * 512 + threadIdx.x; idx < (L_ / 16) * 128; idx += nthreads) {
        const int oct = idx & 127, tb = idx >> 7, t0 = tb * 16, c0 = oct * 8;
        const f32x4 k0a = *(const f32x4*)(P.conv_w + c0), k0b = *(const f32x4*)(P.conv_w + c0 + 4);
        const f32x4 k1a = *(const f32x4*)(P.conv_w + CWID_ + c0), k1b = *(const f32x4*)(P.conv_w + CWID_ + c0 + 4);
        const f32x4 k2a = *(const f32x4*)(P.conv_w + 2 * CWID_ + c0), k2b = *(const f32x4*)(P.conv_w + 2 * CWID_ + c0 + 4);
        f32x4 m2a = {0.f, 0.f, 0.f, 0.f}, m2b = m2a, m1a = m2a, m1b = m2a;
        if (t0 > 0) { const u32x4 w2 = *(const u32x4*)(V + (size_t)(t0 - 2) * CWID_ + c0), w1 = *(const u32x4*)(V + (size_t)(t0 - 1) * CWID_ + c0);
            m2a = bf4lo(w2); m2b = bf4hi(w2); m1a = bf4lo(w1); m1b = bf4hi(w1); }
#pragma unroll
        for (int t = 0; t < 16; ++t) { const size_t off = (size_t)(t0 + t) * CWID_ + c0;
            const u32x4 vw = *(const u32x4*)(V + off), ww = *(const u32x4*)(W + off);
            const f32x4 va = bf4lo(vw), vb = bf4hi(vw);
            const f32x4 ca = k0a * m2a + k1a * m1a + k2a * va, cb = k0b * m2b + k1b * m1b + k2b * vb;
            *(u32x4*)(Z + off) = pack8(bf4lo(ww) * ca, bf4hi(ww) * cb);
            m2a = m1a; m2b = m1b; m1a = va; m1b = vb; }
    }
}
__device__ void carry_group(const Params& P, int g, unsigned char* smem) {
    const float2* abT = (const float2*)(P.ws + WS_ABT); const float* SLOC = (const float*)(P.ws + WS_SLOC); bf16_t* U = (bf16_t*)(P.ws + WS_U);
    float* sl = (float*)smem; unsigned* slw = (unsigned*)smem;
    float2* seg = (float2*)(smem + pg8::STAGE_BYTES + 64);
    const int tid = threadIdx.x, w = tid >> 6, p = tid & 63;
    const float2 a = abT[g * 64 + p];
    float2 a32 = a;
#pragma unroll
    for (int i = 0; i < 5; ++i) a32 = make_float2(a32.x * a32.x - a32.y * a32.y, 2.f * a32.x * a32.y);
    float sr = 0.f, si = 0.f;
    for (int half = 0; half < 2; ++half) {
        const f32x4* src = (const f32x4*)(SLOC + (size_t)(g * NCH_ + half * 256) * 128);
#pragma unroll
        for (int i = 0; i < 16; ++i) ((f32x4*)sl)[tid + 512 * i] = src[tid + 512 * i];
        __syncthreads();
        {
            float tr = 0.f, ti = 0.f;
#pragma unroll 8
            for (int c = 0; c < 32; ++c) { const float lr = sl[(32 * w + c) * 128 + p], li = sl[(32 * w + c) * 128 + 64 + p];
                const float nr = a.x * tr - a.y * ti + lr, ni = a.x * ti + a.y * tr + li; tr = nr; ti = ni; }
            seg[w * 64 + p] = make_float2(tr, ti);
        }
        __syncthreads();
        float wr_ = sr, wi_ = si;
#pragma unroll
        for (int j = 0; j < 8; ++j) { const float2 t = seg[j * 64 + p];
            const float nr = a32.x * sr - a32.y * si + t.x, ni = a32.x * si + a32.y * sr + t.y; sr = nr; si = ni;
            if (j + 1 == w) { wr_ = sr; wi_ = si; } }
#pragma unroll 8
        for (int c = 0; c < 32; ++c) { const float lr = sl[(32 * w + c) * 128 + p], li = sl[(32 * w + c) * 128 + 64 + p];
            slw[(32 * w + c) * 128 + p] = cvt_pk_bf16(wr_, wi_);
            const float nr = a.x * wr_ - a.y * wi_ + lr, ni = a.x * wi_ + a.y * wr_ + li; wr_ = nr; wi_ = ni; }
        __syncthreads();
#pragma unroll
        for (int i = 0; i < 4; ++i) { const int it = tid + 512 * i, c = it >> 3, p0 = (it & 7) * 8;
            const u32x4 w0 = *(const u32x4*)(slw + c * 128 + p0), w1 = *(const u32x4*)(slw + c * 128 + p0 + 4);
            u32x4 re, im;
            re.x = (w0.x & 0xffffu) | (w0.y << 16); re.y = (w0.z & 0xffffu) | (w0.w << 16); re.z = (w1.x & 0xffffu) | (w1.y << 16); re.w = (w1.z & 0xffffu) | (w1.w << 16);
            im.x = (w0.x >> 16) | (w0.y & 0xffff0000u); im.y = (w0.z >> 16) | (w0.w & 0xffff0000u); im.z = (w1.x >> 16) | (w1.y & 0xffff0000u); im.w = (w1.z >> 16) | (w1.w & 0xffff0000u);
            bf16_t* u = U + (size_t)(g * NCH_ + half * 256 + c) * LDU_ + KU_ + p0;
            *(u32x4*)u = re; *(u32x4*)(u + 64) = im; }
        __syncthreads();
    }
}

__global__ void __launch_bounds__(512, 2) hybrid_fwd(Params P) {
    extern __shared__ __attribute__((aligned(16))) unsigned char smem[];
    LAS unsigned char* lds = (LAS unsigned char*)smem;
    unsigned char* ws = P.ws;
    const int bid = blockIdx.x, nb = gridDim.x;
    const int lo = P.ph_lo, hi = P.ph_hi;
#define IN(k) (lo <= (k) && (k) < hi)
    volatile LAS unsigned* xb_st = (volatile LAS unsigned*)(lds + pg8::STAGE_BYTES);
    XcdBarrier xbar; xbar.bar = (unsigned*)(ws + WS_BAR); xbar.x = 0; xbar.st = xb_st;
    if (hi - lo > 1) {
        if (threadIdx.x < 4) xb_st[threadIdx.x] = 0u;
        __syncthreads();
        xbar = xcd_barrier_post((unsigned*)(ws + WS_BAR), xb_st);
    }
    if (lo == 0x7fffffff) cg::this_grid().sync();
#define SEAM(k) do { if (IN(k) && IN((k) + 1)) { xcd_barrier(xbar); } } while (0)
    bf16_t* H = (bf16_t*)P.out; bf16_t* V = (bf16_t*)P.out + (size_t)L_ * D_;
    bf16_t* YG = (bf16_t*)P.out; bf16_t* Y3 = (bf16_t*)P.out + (size_t)L_ * SW_; bf16_t* TMP = (bf16_t*)P.out + (size_t)L_ * D_;
    bf16_t* U = (bf16_t*)(ws + WS_U);

    if (IN(0)) { for (int idx = bid; idx < 1088; idx += nb) do_job(P, smem, idx < 576 ? idx : idx + 256); } SEAM(0);
    if (IN(1)) {
        pg8::Gemm g{H, (const bf16_t*)(ws + WS_WIN), D_, D_, D_}; pg8::StaticOrder S; S.init(L_, INW_, nb, bid);
        EpiG1 E{U, (bf16_t*)(ws + WS_SG), V, (bf16_t*)(ws + WS_W), (bf16_t*)(ws + WS_SR), (bf16_t*)(ws + WS_SC)};
        pg8::gemm_phase(lds, g, S, E);
    } SEAM(1);
    if (IN(2)) {
        const int nbs = nb >= 128 ? 64 : 0;
        if (bid < nbs || nbs == 0) {
            pg8::Gemm g{U, (const bf16_t*)(ws + WS_WST), LDU_, KU_, KU_}; pg8::BatchOrder S{64, nbs ? nbs : nb, bid, 1};
            EpiS1 E{(float*)(ws + WS_SLOC), (unsigned*)(ws + WS_CNT) + 2 * 64 * 64, &P, smem};
            pg8::gemm_phase(lds, g, S, E);
        }
        if (nbs == 0 || bid >= nbs) { phase_z(P, nbs, nb - nbs); for (int idx = bid - nbs; idx < 528; idx += nb - nbs) do_job(P, smem, idx < 512 ? 1344 + idx : 752 + (idx - 512)); }
    } SEAM(2);
    if (IN(3)) {
        const int nbs = nb >= 256 ? 128 : 0;
        if (bid < nbs || nbs == 0) {
            pg8::Gemm g{U, (const bf16_t*)(ws + WS_MC), LDU_, LDU_, LDU_}; pg8::BatchOrder S{128, nbs ? nbs : nb, bid, 2};
            EpiS2 E{YG};
            pg8::gemm_phase(lds, g, S, E);
        }
        if (bid >= nbs || nbs == 0) {
            pg8::Gemm g{(const bf16_t*)(ws + WS_PBF), (const bf16_t*)(ws + WS_WPLE), PLE_, PLE_, PLE_}; pg8::StaticOrder S; S.init(L_, D_, nbs ? nb - nbs : nb, nbs ? bid - nbs : bid);
            EpiStore E{(bf16_t*)(ws + WS_PE), D_};
            pg8::gemm_phase(lds, g, S, E);
            __syncthreads();
            for (int idx = nbs ? bid - nbs : bid; idx < 240; idx += (nbs ? nb - nbs : nb)) do_job(P, smem, 576 + idx + (idx >= 176 ? 16 : 0));
        }
    } SEAM(3);
    if (IN(4)) {
#define cntY3 ((unsigned*)(P.ws + WS_CNT) + 2 * 64 * 64 + 32 * 64)
#define cntMG (cntY3 + 64 * 64)
#define cntX1 (cntMG + 64 * 64)
        const bool has = (nb == 256);
#define MY_PM (8 * (bid & 7) + ((bid >> 3) & 7))
        { pg8::Gemm g{YG, (const bf16_t*)(ws + WS_WGLU), SW_, SW_, SW_}; pg8::StaticOrder S; S.init(L_, SW_, nb, bid);
          EpiGlu E{YG, (const bf16_t*)(ws + WS_SG), P.b_glu, Y3};
          pg8::gemm_phase(lds, g, S, E);
          if (has && bid < 128) panel_arrive(cntY3, MY_PM); }
        if (has) {
            { pg8::AccT mt;
              { pg8::Gemm g{(const bf16_t*)(ws + WS_Z), (const bf16_t*)(ws + WS_WCO), D_, D_, D_}; pg8::StaticOrder S; S.init(L_, D_, nb, bid);
                EpiMergeMid E{(const bf16_t*)(ws + WS_SR), (const bf16_t*)(ws + WS_SC)}; pg8::gemm_phase_acc<true>(lds, g, S, E, mt); }
              panel_wait(cntY3, MY_PM, 2u);
              { pg8::Gemm g{Y3, (const bf16_t*)(ws + WS_WSSO), SW_, SW_, SW_}; pg8::StaticOrder S; S.init(L_, D_, nb, bid);
                EpiMergeFin E{(const bf16_t*)(ws + WS_SR), (bf16_t*)(ws + WS_MERGED)}; pg8::gemm_phase_acc<false>(lds, g, S, E, mt); } }
            panel_arrive(cntMG, MY_PM);
            panel_wait(cntMG, MY_PM, 4u);
            pg8::Gemm g{(const bf16_t*)(ws + WS_MERGED), (const bf16_t*)(ws + WS_WO), D_, D_, D_}; pg8::StaticOrder S; S.init(L_, D_, nb, bid);
            { EpiX1 E{P.x, P.post_norm, (bf16_t*)(ws + WS_X1BF), PanelX{(float*)(ws + WS_MISC), (unsigned*)(ws + WS_CNT)}}; pg8::gemm_phase(lds, g, S, E); }
            asm volatile("s_waitcnt vmcnt(0)" ::: "memory"); __syncthreads();
            panel_arrive(cntX1, MY_PM);
            if (threadIdx.x < 4) { const int q = MY_PM, p0 = q < 16 ? 4 * q : (q < 32 ? 4 * (q - 16) : 2 * (q - 32)), np = q < 32 ? 4 : 2;
                if ((int)threadIdx.x < np) { unsigned spins = 0;
                    while (__hip_atomic_load(cntMG + 64 * (p0 + (int)threadIdx.x), __ATOMIC_RELAXED, __HIP_MEMORY_SCOPE_AGENT) < 4u) { __builtin_amdgcn_s_sleep(2); if (++spins > (1u << 21)) break; } } }
            panel_wait(cntX1, MY_PM, 4u);
            pg8::Gemm g7{(const bf16_t*)(ws + WS_X1BF), (const bf16_t*)(ws + WS_WG), D_, D_, D_}; pg8::StaticOrder S7; S7.init(L_, D_, nb, bid);
            EpiOut E7{(const bf16_t*)(ws + WS_PE), (const bf16_t*)(ws + WS_X1BF), P.ple_norm, P.out, PanelX{(float*)(ws + WS_MISC + 1 * MiB), (unsigned*)(ws + WS_CNT) + 64 * 64}}; pg8::gemm_phase(lds, g7, S7, E7);
        }
#undef MY_PM
#undef cntY3
#undef cntMG
#undef cntX1
    }
#undef IN
#undef SEAM
}


extern "C" void kernel_launch(void* const* d_in, const int* in_sizes, int n_in, void* d_out, int out_size, void* d_ws, size_t ws_size, hipStream_t stream) {
    constexpr int LDS_BYTES = pg8::STAGE_BYTES + 64 + 4096;
    static int grid = 0;
    if (grid == 0) {
        if (n_in != 22 || out_size != L_ * D_ || ws_size < WS_END) { fprintf(stderr, "kernel_launch: unexpected shapes (n_in %d out %d ws %zu)\n", n_in, out_size, ws_size); grid = -1; return; }
        int dev = 0, cus = 0, per_cu = 0;
        hipGetDevice(&dev); hipDeviceGetAttribute(&cus, hipDeviceAttributeMultiprocessorCount, dev);
        if (hipFuncSetAttribute((const void*)hybrid_fwd, hipFuncAttributeMaxDynamicSharedMemorySize, LDS_BYTES) != hipSuccess) { fprintf(stderr, "kernel_launch: hipFuncSetAttribute failed\n"); grid = -1; return; }
        hipOccupancyMaxActiveBlocksPerMultiprocessor(&per_cu, (const void*)hybrid_fwd, 512, LDS_BYTES);
        (void)hipGetLastError();
        if (per_cu < 1) per_cu = 1;
        grid = cus;
        fprintf(stderr, "kernel_launch: cus %d per_cu %d grid %d\n", cus, per_cu, grid);
    }
    if (grid < 0) return;
    Params P{};
    const float** f = (const float**)&P;
    for (int i = 0; i < 22; ++i) f[i] = (const float*)d_in[i];
    P.out = (float*)d_out; P.ws = (unsigned char*)d_ws;
    (void)hipMemsetAsync((unsigned char*)d_ws + WS_MISC, 0xFF, 2 * MiB, stream);
    (void)hipMemsetAsync((unsigned char*)d_ws + WS_BAR, 0, 16384 + 2 * 64 * 256 + 32 * 256 + 3 * 64 * 256, stream);
#if ONE_LAUNCH
    P.ph_lo = 0; P.ph_hi = NPH;
    void* args[] = {&P};
    hipError_t e = hipLaunchCooperativeKernel((const void*)hybrid_fwd, dim3(grid), dim3(512), args, LDS_BYTES, stream);
    if (e != hipSuccess) fprintf(stderr, "cooperative launch failed: %s (grid %d)\n", hipGetErrorString(e), grid);
#else
    for (int ph = 0; ph < NPH; ++ph) {
        P.ph_lo = ph; P.ph_hi = ph + 1;
        hipLaunchKernelGGL(hybrid_fwd, dim3(grid), dim3(512), LDS_BYTES, stream, P);
    }
#endif
}
```
